# Optimizing an MI355X kernel written in HIP

```python
import math
import jax, jax.numpy as jnp
from jax import lax
import numpy as np

D_MODEL = 1024
BATCH = 4
SEQ = 8192
DEPTH = 2

MEM_LEN = 256
RMS_EPS = 1e-6
ROPE_THETA = 500000.0
ROPE_FRACTION = 4
Q_BLOCK = 128
MOBA_HEADS = 6
MOBA_DIM = 64
MOBA_BLOCK = 256
MOBA_TOPK = 3
MOBA_Q_BLOCK = 64
DIFF_HEADS = 4
DIFF_QK_DIM = 32
DIFF_V_DIM = 64
SB_HEADS = 6
SB_DIM = 64
XATTN_HEADS = 4
XATTN_DIM = 128

MOBA_W = MOBA_HEADS * MOBA_DIM
DIFF_QK_W = DIFF_HEADS * 2 * DIFF_QK_DIM
DIFF_W = DIFF_HEADS * DIFF_V_DIM
SB_W = SB_HEADS * SB_DIM
D_MIX = MOBA_W + DIFF_W + SB_W
IN_SPLIT_SIZES = (MOBA_W, MOBA_W, MOBA_W, MOBA_W,
                  DIFF_QK_W, DIFF_QK_W, DIFF_W, DIFF_W,
                  SB_W, SB_W, SB_W, SB_W)
D_IN = 4 * MOBA_W + 2 * DIFF_QK_W + 2 * DIFF_W + 4 * SB_W
XATTN_W = XATTN_HEADS * XATTN_DIM

kernel_name = "hybrid_moba_diff_stickbreak_memxattn"


def rms_norm(x, g):
    xf = x.astype(jnp.float32)
    y = xf * lax.rsqrt(jnp.mean(xf * xf, axis=-1, keepdims=True) + RMS_EPS)
    return (y * g.astype(jnp.float32)).astype(x.dtype)


def to_heads(t, n_heads, d):
    b, s, _ = t.shape
    return t.reshape(b, s, n_heads, d).transpose(0, 2, 1, 3)


def from_heads(t):
    b, h, s, d = t.shape
    return t.transpose(0, 2, 1, 3).reshape(b, s, h * d)


def rope_tables(positions, head_dim):
    rot = head_dim // ROPE_FRACTION
    inv = 1.0 / (ROPE_THETA ** (jnp.arange(0, rot, 2, dtype=jnp.float32) / rot))
    ang = positions.astype(jnp.float32)[..., None] * inv
    return jnp.cos(ang)[:, None], jnp.sin(ang)[:, None]


def apply_partial_rope(x, cos, sin):
    r2 = cos.shape[-1]
    c = cos.astype(x.dtype)
    s = sin.astype(x.dtype)
    x1 = x[..., :r2]
    x2 = x[..., r2:2 * r2]
    return jnp.concatenate([x1 * c - x2 * s, x2 * c + x1 * s, x[..., 2 * r2:]], axis=-1)


def sweep_blocks(fn, seq, qb):
    out = lax.map(fn, jnp.arange(seq // qb))
    n, b, h, _, d = out.shape
    return out.transpose(1, 2, 0, 3, 4).reshape(b, h, n * qb, d)


def moba_attention(q, k, v):
    b, h, s, d = q.shape
    nb = -(-s // MOBA_BLOCK)
    pad = nb * MOBA_BLOCK - s
    kp = jnp.pad(k, ((0, 0), (0, 0), (0, pad), (0, 0)))
    vp = jnp.pad(v, ((0, 0), (0, 0), (0, pad), (0, 0)))
    kb = kp.reshape(b, h, nb, MOBA_BLOCK, d)
    vb = vp.reshape(b, h, nb, MOBA_BLOCK, d)
    k_mean = jnp.mean(kb.astype(jnp.float32), axis=3)
    n_sel = min(MOBA_TOPK, nb)
    scale = d ** -0.5
    bi = jnp.arange(b)[:, None, None, None]
    hi = jnp.arange(h)[None, :, None, None]

    def block(i):
        q0 = i * MOBA_Q_BLOCK
        qi = lax.dynamic_slice_in_dim(q, q0, MOBA_Q_BLOCK, axis=2)
        own = q0 // MOBA_BLOCK
        tq = q0 + jnp.arange(MOBA_Q_BLOCK)
        gate = jnp.einsum('bhqd,bhnd->bhqn', qi.astype(jnp.float32), k_mean)
        gate = jnp.where(jnp.arange(nb) < own, gate, -jnp.inf)
        _, idx = lax.top_k(gate, n_sel)
        valid = idx < own
        ks = kb[bi, hi, idx]
        vs = vb[bi, hi, idx]
        s_sel = jnp.einsum('bhqd,bhqnld->bhqnl', qi, ks).astype(jnp.float32) * scale
        s_sel = jnp.where(valid[..., None], s_sel, -jnp.inf)
        s_sel = s_sel.reshape(b, h, MOBA_Q_BLOCK, n_sel * MOBA_BLOCK)
        ko = lax.dynamic_slice_in_dim(kp, own * MOBA_BLOCK, MOBA_BLOCK, axis=2)
        vo = lax.dynamic_slice_in_dim(vp, own * MOBA_BLOCK, MOBA_BLOCK, axis=2)
        s_own = jnp.einsum('bhqd,bhld->bhql', qi, ko).astype(jnp.float32) * scale
        to = own * MOBA_BLOCK + jnp.arange(MOBA_BLOCK)
        s_own = jnp.where(to[None, :] <= tq[:, None], s_own, -jnp.inf)
        p = jax.nn.softmax(jnp.concatenate([s_sel, s_own], axis=-1), axis=-1)
        p_sel = p[..., :n_sel * MOBA_BLOCK].reshape(b, h, MOBA_Q_BLOCK, n_sel, MOBA_BLOCK).astype(v.dtype)
        p_own = p[..., n_sel * MOBA_BLOCK:].astype(v.dtype)
        return (jnp.einsum('bhqnl,bhqnld->bhqd', p_sel, vs)
                + jnp.einsum('bhql,bhld->bhqd', p_own, vo))

    return sweep_blocks(block, s, MOBA_Q_BLOCK)


def diff_attention(q, k, v, lam, head_norm_g, lam_init):
    b, h2, s, dq = q.shape
    h = h2 // 2
    scale = dq ** -0.5
    kpos = jnp.arange(s)

    def block(i):
        q0 = i * Q_BLOCK
        qi = lax.dynamic_slice_in_dim(q, q0, Q_BLOCK, axis=2)
        sc = jnp.einsum('bhqd,bhkd->bhqk', qi, k).astype(jnp.float32) * scale
        mask = kpos[None, :] <= (q0 + jnp.arange(Q_BLOCK))[:, None]
        p = jax.nn.softmax(jnp.where(mask, sc, -jnp.inf), axis=-1).reshape(b, h, 2, Q_BLOCK, s)
        a = p[:, :, 0] - lam * p[:, :, 1]
        return jnp.einsum('bhqk,bhkd->bhqd', a.astype(v.dtype), v)

    o = sweep_blocks(block, s, Q_BLOCK)
    o = rms_norm(o, head_norm_g)
    return o * (1.0 - lam_init)


def stick_breaking_attention(q, k, v):
    b, h, s, d = q.shape
    scale = d ** -0.5
    kpos = jnp.arange(s)

    def block(i):
        q0 = i * Q_BLOCK
        qi = lax.dynamic_slice_in_dim(q, q0, Q_BLOCK, axis=2)
        z = jnp.einsum('bhqd,bhkd->bhqk', qi, k).astype(jnp.float32) * scale
        mask = kpos[None, :] < (q0 + jnp.arange(Q_BLOCK))[:, None]
        log_beta = jax.nn.log_sigmoid(z)
        log_1m_beta = jnp.where(mask, log_beta - z, 0.0)
        between = lax.cumsum(log_1m_beta, axis=3, reverse=True) - log_1m_beta
        w = jnp.where(mask, jnp.exp(log_beta + between), 0.0)
        return jnp.einsum('bhqk,bhkd->bhqd', w.astype(v.dtype), v)

    return sweep_blocks(block, s, Q_BLOCK)


def hybrid_mixer(hn, rope64, rope32, w_in, w_out, lq1, lk1, lq2, lk2, head_norm_g, lam_init):
    proj = hn @ w_in
    cuts = list(np.cumsum(IN_SPLIT_SIZES)[:-1])
    (mq, mk, mv, mg, dq_, dk_, dv_, dg, sq, sk, sv, sg) = jnp.split(proj, cuts, axis=-1)
    cos64, sin64 = rope64
    a_q = apply_partial_rope(to_heads(mq, MOBA_HEADS, MOBA_DIM), cos64, sin64)
    a_k = apply_partial_rope(to_heads(mk, MOBA_HEADS, MOBA_DIM), cos64, sin64)
    a_o = moba_attention(a_q, a_k, to_heads(mv, MOBA_HEADS, MOBA_DIM))
    cos32, sin32 = rope32
    b_q = apply_partial_rope(to_heads(dq_, 2 * DIFF_HEADS, DIFF_QK_DIM), cos32, sin32)
    b_k = apply_partial_rope(to_heads(dk_, 2 * DIFF_HEADS, DIFF_QK_DIM), cos32, sin32)
    f32 = jnp.float32
    lam = (jnp.exp(jnp.sum(lq1.astype(f32) * lk1.astype(f32)))
           - jnp.exp(jnp.sum(lq2.astype(f32) * lk2.astype(f32))) + lam_init)
    b_o = diff_attention(b_q, b_k, to_heads(dv_, DIFF_HEADS, DIFF_V_DIM), lam, head_norm_g, lam_init)
    c_o = stick_breaking_attention(to_heads(sq, SB_HEADS, SB_DIM), to_heads(sk, SB_HEADS, SB_DIM),
                                   to_heads(sv, SB_HEADS, SB_DIM))
    merged = jnp.concatenate([from_heads(a_o) * jax.nn.silu(mg),
                              from_heads(b_o).astype(hn.dtype) * jax.nn.silu(dg),
                              from_heads(c_o) * jax.nn.silu(sg)], axis=-1)
    return merged @ w_out


def memory_cross_attention(hn, mem_n, w_xq, w_xkv, w_xo):
    q = to_heads(hn @ w_xq, XATTN_HEADS, XATTN_DIM)
    k, v = jnp.split(mem_n @ w_xkv, 2, axis=-1)
    k = to_heads(k, XATTN_HEADS, XATTN_DIM)
    v = to_heads(v, XATTN_HEADS, XATTN_DIM)
    sc = jnp.einsum('bhsd,bhmd->bhsm', q, k).astype(jnp.float32) * (XATTN_DIM ** -0.5)
    p = jax.nn.softmax(sc, axis=-1).astype(v.dtype)
    o = jnp.einsum('bhsm,bhmd->bhsd', p, v)
    return from_heads(o) @ w_xo


def setup_inputs(seed: int = 0) -> dict:
    key = jax.random.key(seed)
    ks = jax.random.split(key, 20)
    f32 = jnp.float32

    def w(k, shape, fan_in):
        return jax.random.normal(k, shape, f32) * (fan_in ** -0.5)

    def gain(k, shape):
        return 1.0 + 0.02 * jax.random.normal(k, shape, f32)

    offsets = jax.random.randint(ks[2], (BATCH, 1), 0, 4096, dtype=jnp.int32)
    positions = offsets + jnp.arange(SEQ, dtype=jnp.int32)[None, :]
    return {
        "x": jax.random.normal(ks[0], (BATCH, SEQ, D_MODEL), f32),
        "mem": jax.random.normal(ks[1], (BATCH, MEM_LEN, D_MODEL), f32),
        "positions": positions,
        "attn_norm_g": gain(ks[3], (DEPTH, D_MODEL)),
        "w_in": w(ks[4], (DEPTH, D_MODEL, D_IN), D_MODEL),
        "w_out": w(ks[5], (DEPTH, D_MIX, D_MODEL), D_MIX),
        "diff_lambda_q1": 0.1 * jax.random.normal(ks[6], (DEPTH, DIFF_QK_DIM), f32),
        "diff_lambda_k1": 0.1 * jax.random.normal(ks[7], (DEPTH, DIFF_QK_DIM), f32),
        "diff_lambda_q2": 0.1 * jax.random.normal(ks[8], (DEPTH, DIFF_QK_DIM), f32),
        "diff_lambda_k2": 0.1 * jax.random.normal(ks[9], (DEPTH, DIFF_QK_DIM), f32),
        "diff_head_norm_g": gain(ks[10], (DEPTH, DIFF_V_DIM)),
        "xattn_norm_g": gain(ks[11], (DEPTH, D_MODEL)),
        "mem_norm_g": gain(ks[12], (DEPTH, D_MODEL)),
        "w_xq": w(ks[13], (DEPTH, D_MODEL, XATTN_W), D_MODEL),
        "w_xkv": w(ks[14], (DEPTH, D_MODEL, 2 * XATTN_W), D_MODEL),
        "w_xo": w(ks[15], (DEPTH, XATTN_W, D_MODEL), XATTN_W),
        "final_norm_g": gain(ks[16], (D_MODEL,)),
    }


def reference(x, mem, positions, attn_norm_g, w_in, w_out, diff_lambda_q1, diff_lambda_k1,
              diff_lambda_q2, diff_lambda_k2, diff_head_norm_g, xattn_norm_g, mem_norm_g,
              w_xq, w_xkv, w_xo, final_norm_g):
    rope64 = rope_tables(positions, MOBA_DIM)
    rope32 = rope_tables(positions, DIFF_QK_DIM)
    h = x
    for l in range(DEPTH):
        lam_init = 0.8 - 0.6 * math.exp(-0.3 * l)
        hn = rms_norm(h, attn_norm_g[l])
        h = h + hybrid_mixer(hn, rope64, rope32, w_in[l], w_out[l],
                             diff_lambda_q1[l], diff_lambda_k1[l], diff_lambda_q2[l], diff_lambda_k2[l],
                             diff_head_norm_g[l], lam_init)
        h = h + memory_cross_attention(rms_norm(h, xattn_norm_g[l]), rms_norm(mem, mem_norm_g[l]),
                                       w_xq[l], w_xkv[l], w_xo[l])
    return rms_norm(h, final_norm_g)
```

```cpp
#include <hip/hip_runtime.h>
#include <hip/hip_cooperative_groups.h>
#include <cstdio>
#include <cstdint>
namespace cg = cooperative_groups;
__device__ __forceinline__ int tid_opaque() { int t = threadIdx.x; asm volatile("" : "+v"(t)); return t; }
__device__ __forceinline__ int bid_opaque() { int b = blockIdx.x; asm volatile("" : "+s"(b)); return b; }
__device__ __forceinline__ int grid_opaque() { int b = gridDim.x; asm volatile("" : "+s"(b)); return b; }
namespace pg8 {
#define PG8_LAS __attribute__((address_space(3)))
typedef unsigned short bf16_t;
typedef short bf16x8 __attribute__((ext_vector_type(8)));
typedef float f32x4 __attribute__((ext_vector_type(4)));
typedef unsigned u32x4 __attribute__((ext_vector_type(4)));
constexpr int BM = 256, BK = 64, HALF = 128, HTB = HALF * BK * 2  , STAGE_BYTES = 8 * HTB, NXCD = 8, WGM = 8;

__host__ __device__ __forceinline__ int lds_byte(int r, int c) { const int st = (r >> 4) * 2 + (c >> 5), rr = r & 15, cc = c & 31, ob = rr * 64 + cc * 2; return st * 1024 + (ob ^ (((ob >> 9) & 1) << 5)); }
__host__ __device__ __forceinline__ void stage_rc(int b, int& R, int& C) { const int st = b / 1024, sb = b % 1024, swz = sb ^ (((sb >> 9) & 1) << 5); R = (st >> 1) * 16 + swz / 64; C = (st & 1) * 32 + (swz % 64) / 2; }
__host__ __device__ __forceinline__ int perm32(int rho) { const int n = rho >> 4, i = rho & 15; return 8 * (i >> 2) + 4 * n + (i & 3); }

struct Unit { int pm, pn; };
struct Gemm { const bf16_t* A; const bf16_t* Bt; int M, N, K; };

struct StaticOrder {
    int nM, nN, nwg, G, c;
    __host__ __device__ void init(int M, int N, int G_, int c_) { nM = M / BM; nN = N / BM; nwg = nM * nN; G = G_; c = c_; }
    __host__ __device__ bool next(int i, Unit& u) const {
        const long L = (long)i * G + c; if (L >= nwg) return false;
        int wgid = (int)L; { const int q = nwg / NXCD, r = nwg % NXCD, xcd = wgid % NXCD, off = wgid / NXCD; wgid = (xcd < r ? xcd * (q + 1) : r * (q + 1) + (xcd - r) * q) + off; }
        const int nig = WGM * nN, gid = wgid / nig, fm = gid * WGM, gsz = (nM - fm) < WGM ? (nM - fm) : WGM;
        u.pm = fm + ((wgid % nig) % gsz); u.pn = (wgid % nig) / gsz; return true;
    }
    __device__ __forceinline__ void a_ready(const Unit&) const {}
    __device__ __forceinline__ void done(const Unit&) const {}
};

__device__ __forceinline__ unsigned cvt_pk_bf16(float lo, float hi) { unsigned r; asm volatile("v_cvt_pk_bf16_f32 %0, %1, %2" : "=v"(r) : "v"(lo), "v"(hi)); return r; }
typedef float f32x2 __attribute__((ext_vector_type(2)));
template <class Epi, class Sched, bool ALIGN_EPI = false, bool SP2 = false>
__device__ __forceinline__ void gemm_phase(PG8_LAS unsigned char* lds, const Gemm g, const Sched& S, const Epi& E) {
    const int tid = tid_opaque(), wid = __builtin_amdgcn_readfirstlane(tid >> 6), lane = tid & 63, wr = wid >> 2, wc = wid & 3, fr = lane & 15, fq = lane >> 4;
    const int K = g.K, nt = K / BK;
    unsigned voffA[2], voffB[2];
#pragma unroll
    for (int i = 0; i < 2; ++i) { int R, C; stage_rc(tid * 16 + i * 8192, R, C); const int Rb = Epi::PERM ? ((R & ~31) + perm32(R & 31)) : R;
        voffA[i] = (unsigned)(R * K + C) * 2u; voffB[i] = (unsigned)(Rb * K + C) * 2u; }
    const size_t kstep = (size_t)(BK * 2);
    const size_t hstep = (size_t)HALF * K * 2;
    const size_t tstep = 2 * hstep;
    const unsigned ldsw = (unsigned)wid * 1024u;
    const int aoff = lds_byte(wr * 64 + fr, fq * 8), boff = lds_byte(wc * 32 + fr, fq * 8);
#define PG8_SA(b, h) (((b) * 2 + (h)) * HTB)
#define PG8_SB(b, h) ((4 + (b) * 2 + (h)) * HTB)
#define PG8_STAGE(bufoff, gbase, voff) do { _Pragma("unroll") for (int _i = 0; _i < 2; ++_i) \
        __builtin_amdgcn_global_load_lds((const unsigned*)((const char*)(gbase) + (voff)[_i]), (PG8_LAS unsigned*)(lds + (bufoff) + ldsw + _i * 8192), 16, 0, 0); } while (0)
#define PG8_LDA(dst, b, h) do { _Pragma("unroll") for (int m = 0; m < 4; ++m) _Pragma("unroll") for (int k = 0; k < 2; ++k) dst[m][k] = *(const PG8_LAS bf16x8*)(lds + PG8_SA(b, h) + aoff + m * 2048 + k * 1024); } while (0)
#define PG8_LDB(dst, b, h) do { _Pragma("unroll") for (int n = 0; n < 2; ++n) _Pragma("unroll") for (int k = 0; k < 2; ++k) dst[n][k] = *(const PG8_LAS bf16x8*)(lds + PG8_SB(b, h) + boff + n * 2048 + k * 1024); } while (0)
#define PG8_MMA(ai, bj, At, Bt) do { __builtin_amdgcn_s_setprio(1); _Pragma("unroll") for (int m = 0; m < 4; ++m) _Pragma("unroll") for (int n = 0; n < 2; ++n) _Pragma("unroll") for (int k = 0; k < 2; ++k) \
        acc[ai][bj][m][n] = __builtin_amdgcn_mfma_f32_16x16x32_bf16(Bt[n][k], At[m][k], acc[ai][bj][m][n], 0, 0, 0); __builtin_amdgcn_s_setprio(0); } while (0)
#define PG8_WAIT_V(n) asm volatile("s_waitcnt vmcnt(" #n ")" ::: "memory")
#define PG8_WAIT_L(n) asm volatile("s_waitcnt lgkmcnt(" #n ")" ::: "memory")
#define PG8_BAR __builtin_amdgcn_s_barrier()
#define PG8_SCHED __builtin_amdgcn_sched_barrier(0)
    Unit cur, nxt; int ui = 0;
    if (!S.next(0, cur)) return;
    f32x4 acc[2][2][4][2];
#pragma unroll
    for (int a = 0; a < 2; ++a)
#pragma unroll
        for (int b = 0; b < 2; ++b)
#pragma unroll
            for (int m = 0; m < 4; ++m)
#pragma unroll
                for (int n = 0; n < 2; ++n) acc[a][b][m][n] = (f32x4){0.f, 0.f, 0.f, 0.f};
    bf16x8 At[4][2], B0[2][2], B1[2][2];
    const char* cA = (const char*)g.A + (size_t)cur.pm * tstep; const char* cB = (const char*)g.Bt + (size_t)cur.pn * tstep;
    S.a_ready(cur);
    if constexpr (SP2) {
        PG8_STAGE(PG8_SB(0, 0), cB, voffB); PG8_STAGE(PG8_SB(0, 1), cB + hstep, voffB); PG8_STAGE(PG8_SA(0, 0), cA, voffA); PG8_STAGE(PG8_SA(0, 1), cA + hstep, voffA);
        if (wr == 1) PG8_BAR;
        PG8_WAIT_V(2); PG8_BAR;
        PG8_STAGE(PG8_SB(1, 0), cB + kstep, voffB); PG8_STAGE(PG8_SA(1, 0), cA + kstep, voffA); PG8_STAGE(PG8_SB(1, 1), cB + hstep + kstep, voffB);
        PG8_WAIT_V(6); PG8_BAR;
    } else {
        PG8_STAGE(PG8_SB(0, 0), cB, voffB); PG8_STAGE(PG8_SA(0, 0), cA, voffA); PG8_STAGE(PG8_SB(0, 1), cB + hstep, voffB); PG8_STAGE(PG8_SA(0, 1), cA + hstep, voffA);
        if (wr == 1) PG8_BAR;
        PG8_WAIT_V(4); PG8_BAR;
        PG8_STAGE(PG8_SB(1, 0), cB + kstep, voffB); PG8_STAGE(PG8_SA(1, 0), cA + kstep, voffA); PG8_STAGE(PG8_SB(1, 1), cB + hstep + kstep, voffB);
        PG8_WAIT_V(6); PG8_BAR;
    }
    for (;;) {
        const bool has_next = S.next(ui + 1, nxt);
        const char* nA = has_next ? (const char*)g.A + (size_t)nxt.pm * tstep : cA; const char* nB = has_next ? (const char*)g.Bt + (size_t)nxt.pn * tstep : cB;
        for (int t = 0; t < nt; t += 2) {
            const bool last = (t == nt - 2);
            const char* a1 = cA + (size_t)(t + 1) * kstep;
            const char* a2 = last ? nA : cA + (size_t)(t + 2) * kstep; const char* b2 = last ? nB : cB + (size_t)(t + 2) * kstep;
            const char* a3 = a2 + kstep; const char* b3 = b2 + kstep;
            if (last && has_next) S.a_ready(nxt);
            if constexpr (SP2) {
            PG8_LDB(B0, 0, 0); PG8_LDB(B1, 0, 1); PG8_SCHED; PG8_LDA(At, 0, 0); PG8_STAGE(PG8_SA(1, 1), a1 + hstep, voffA);
            PG8_WAIT_V(8); PG8_WAIT_L(0); PG8_BAR; PG8_MMA(0, 0, At, B0); PG8_MMA(0, 1, At, B1); PG8_BAR; PG8_SCHED;
            PG8_LDA(At, 0, 1); PG8_STAGE(PG8_SB(0, 0), b2, voffB); PG8_STAGE(PG8_SB(0, 1), b2 + hstep, voffB); PG8_STAGE(PG8_SA(0, 0), a2, voffA);
            PG8_WAIT_V(8); PG8_WAIT_L(0); PG8_BAR; PG8_MMA(1, 0, At, B0); PG8_MMA(1, 1, At, B1); PG8_BAR; PG8_SCHED;
            PG8_LDB(B0, 1, 0); PG8_LDB(B1, 1, 1); PG8_SCHED; PG8_LDA(At, 1, 0); PG8_STAGE(PG8_SA(0, 1), a2 + hstep, voffA);
            PG8_WAIT_V(8); PG8_WAIT_L(0); PG8_BAR; PG8_MMA(0, 0, At, B0); PG8_MMA(0, 1, At, B1); PG8_BAR; PG8_SCHED;
            PG8_LDA(At, 1, 1); PG8_STAGE(PG8_SB(1, 0), b3, voffB); PG8_STAGE(PG8_SB(1, 1), b3 + hstep, voffB); PG8_STAGE(PG8_SA(1, 0), a3, voffA);
            PG8_WAIT_V(8); PG8_WAIT_L(0); PG8_BAR; PG8_MMA(1, 0, At, B0); PG8_MMA(1, 1, At, B1); PG8_BAR; PG8_SCHED;
            } else {
            PG8_LDB(B0, 0, 0); PG8_SCHED; PG8_LDA(At, 0, 0); PG8_STAGE(PG8_SA(1, 1), a1 + hstep, voffA);
            PG8_WAIT_L(8); PG8_BAR; PG8_WAIT_L(0); PG8_MMA(0, 0, At, B0); PG8_BAR; PG8_SCHED;
            PG8_LDB(B1, 0, 1); PG8_STAGE(PG8_SB(0, 0), b2, voffB);
            PG8_BAR; PG8_WAIT_L(0); PG8_MMA(0, 1, At, B1); PG8_BAR;
            PG8_LDA(At, 0, 1); PG8_STAGE(PG8_SA(0, 0), a2, voffA);
            PG8_BAR; PG8_WAIT_L(0); PG8_MMA(1, 0, At, B0); PG8_BAR; PG8_SCHED;
            PG8_STAGE(PG8_SB(0, 1), b2 + hstep, voffB);
            PG8_WAIT_V(6); PG8_BAR; PG8_MMA(1, 1, At, B1); PG8_BAR;
            PG8_LDB(B0, 1, 0); PG8_SCHED; PG8_LDA(At, 1, 0); PG8_STAGE(PG8_SA(0, 1), a2 + hstep, voffA);
            PG8_WAIT_L(8); PG8_BAR; PG8_WAIT_L(0); PG8_MMA(0, 0, At, B0); PG8_BAR; PG8_SCHED;
            PG8_LDB(B1, 1, 1); PG8_STAGE(PG8_SB(1, 0), b3, voffB);
            PG8_BAR; PG8_WAIT_L(0); PG8_MMA(0, 1, At, B1); PG8_BAR;
            PG8_LDA(At, 1, 1); PG8_STAGE(PG8_SA(1, 0), a3, voffA);
            PG8_BAR; PG8_WAIT_L(0); PG8_MMA(1, 0, At, B0); PG8_BAR; PG8_SCHED;
            PG8_STAGE(PG8_SB(1, 1), b3 + hstep, voffB);
            PG8_WAIT_V(6); PG8_BAR; PG8_MMA(1, 1, At, B1); PG8_BAR;
            }
        }
        if constexpr (ALIGN_EPI) { if (wr == 0) PG8_BAR; }
        if constexpr (!Epi::AFTER_DRAIN) { E(acc, cur, wr, wc, fr, fq); S.done(cur); }
        if (!has_next) break;
#pragma unroll
        for (int a = 0; a < 2; ++a)
#pragma unroll
            for (int b = 0; b < 2; ++b)
#pragma unroll
                for (int m = 0; m < 4; ++m)
#pragma unroll
                    for (int n = 0; n < 2; ++n) acc[a][b][m][n] = (f32x4){0.f, 0.f, 0.f, 0.f};
        cur = nxt; cA = nA; cB = nB; ++ui;
        if constexpr (ALIGN_EPI) { if (wr == 1) PG8_BAR; }
    }
    PG8_WAIT_V(0);
    if constexpr (!ALIGN_EPI) { if (wr == 0) PG8_BAR; }
    PG8_BAR;
    if constexpr (Epi::AFTER_DRAIN) { E.fused(acc, cur, wr, wc, fr, fq, lds, wid, lane); S.done(cur); }
#undef PG8_SA
#undef PG8_SB
#undef PG8_STAGE
#undef PG8_LDA
#undef PG8_LDB
#undef PG8_MMA
#undef PG8_WAIT_V
#undef PG8_WAIT_L
#undef PG8_BAR
#undef PG8_SCHED
}
}

using pg8::bf16_t; using pg8::bf16x8; using pg8::f32x4; using pg8::u32x4; using pg8::Unit;
typedef float f32x16 __attribute__((ext_vector_type(16)));
typedef unsigned u32x2 __attribute__((ext_vector_type(2)));
typedef float f32x2_t __attribute__((ext_vector_type(2)));
typedef __bf16 bf16x2_t __attribute__((ext_vector_type(2)));
#define LAS __attribute__((address_space(3)))
constexpr int TT = 32768, DM = 1024, SEQ = 8192, NBATCH = 4, MEML = 256;
constexpr int PW = 3072;
constexpr float RMS_EPS = 1e-6f;
constexpr float LOG2E = 1.4426950408889634f;
constexpr float NEGF = -1.0e30f;
constexpr size_t MiB = (size_t)1 << 20;
constexpr size_t WS_CTL = 0, WS_SSQ = 1 * MiB, WS_CS64 = 3 * MiB, WS_CS32 = 5 * MiB, WS_KMEAN = 6 * MiB, WS_MEMN = 8 * MiB, WS_KX = 12 * MiB, WS_VXT = 14 * MiB,
                 WS_W = 16 * MiB, WS_HB = 48 * MiB, WS_P = 112 * MiB, WS_VT = 304 * MiB, WS_MRG = 368 * MiB, WS_QX = 432 * MiB, WS_OX = 432 * MiB  , WS_KIMG = 464 * MiB, WS_END = 496 * MiB;
constexpr size_t W_MAIN = 0, W_V = (size_t)3072 * 1024, W_OUT = W_V + (size_t)1024 * 1024, W_XQ = W_OUT + (size_t)1024 * 1024, W_XK = W_XQ + (size_t)512 * 1024,
                 W_XV = W_XK + (size_t)512 * 1024, W_XO = W_XV + (size_t)512 * 1024, W_LAYER = W_XO + (size_t)1024 * 512;
static_assert(W_LAYER * 2 * 2 <= 32 * MiB, "weights fit");
constexpr int LDS_BYTES = 155648;
constexpr int LDS_MISC = 143360, LDS_RED = 143360 + 1024;

__device__ __forceinline__ unsigned cvtpk(float lo, float hi) { f32x2_t v = {lo, hi}; bf16x2_t b = __builtin_convertvector(v, bf16x2_t); return __builtin_bit_cast(unsigned, b); }
__device__ __forceinline__ float bflo(unsigned w) { return __uint_as_float(w << 16); }
__device__ __forceinline__ float bfhi(unsigned w) { return __uint_as_float(w & 0xffff0000u); }
__device__ __forceinline__ float ex2(float x) { return __builtin_amdgcn_exp2f(x); }
__device__ __forceinline__ float lg2(float x) { return __builtin_amdgcn_logf(x); }
__device__ __forceinline__ float rinv_row(const float* ssq, int row) {
    const f32x4 s = *(const f32x4*)(ssq + (size_t)row * 4);
    return __builtin_amdgcn_rsqf(((s.x + s.y) + (s.z + s.w)) * (1.f / 1024.f) + RMS_EPS);
}
__device__ __forceinline__ float silu_f(float y) { return y * __builtin_amdgcn_rcpf(1.f + ex2(-y * LOG2E)); }
#define ROT2(x1, x2, c, s) do { const float a_ = (x1) * (c) - (x2) * (s), b_ = (x2) * (c) + (x1) * (s); (x1) = a_; (x2) = b_; } while (0)

struct EpiIn {
    static constexpr bool PERM = true, AFTER_DRAIN = false;
    bf16_t* P; const float* ssq; const float* cs64; const float* cs32; bf16_t* Kimg; float* kpart; bf16_t* Ksb; bf16_t* Kdf;
    __device__ __forceinline__ void operator()(const f32x4 (&acc)[2][2][4][2], const Unit& u, int wr, int wc, int fr, int fq) const {
        const int row0 = u.pm * 256 + wr * 64 + fr;
        float rinv[2][4];
#pragma unroll
        for (int ai = 0; ai < 2; ++ai)
#pragma unroll
            for (int m = 0; m < 4; ++m) rinv[ai][m] = rinv_row(ssq, row0 + ai * 128 + m * 16);
#pragma unroll
        for (int bj = 0; bj < 2; ++bj) {
            const int seg = u.pn * 2 + bj;
            const int c0 = seg * 128 + wc * 32 + fq * 8;
            int kind; float sc = 1.f;
            if (seg < 3) { kind = 1; sc = 0.125f * LOG2E; } else if (seg < 6) { kind = 1; } else if (seg < 9) { kind = 3; }
            else if (seg < 11) { kind = 2; sc = 0.17677669529663687f * LOG2E; } else if (seg < 13) { kind = 2; } else if (seg < 15) { kind = 3; }
            else if (seg < 18) { kind = 0; sc = 0.125f * LOG2E; } else if (seg < 21) { kind = 0; } else { kind = 3; }
            const bool rope = (kind == 1 && (c0 & 63) < 16) || (kind == 2 && (c0 & 31) == 0);
            f32x4 cs0 = {0.f, 0.f, 0.f, 0.f}, cs1 = {0.f, 0.f, 0.f, 0.f};
#pragma unroll
            for (int ai = 0; ai < 2; ++ai)
#pragma unroll
                for (int m = 0; m < 4; ++m) {
                    const int row = row0 + ai * 128 + m * 16; const float s = rinv[ai][m];
                    f32x4 v0 = acc[ai][bj][m][0] * s, v1 = acc[ai][bj][m][1] * s;
                    if (kind == 3) {
                        v0.x = silu_f(v0.x); v0.y = silu_f(v0.y); v0.z = silu_f(v0.z); v0.w = silu_f(v0.w);
                        v1.x = silu_f(v1.x); v1.y = silu_f(v1.y); v1.z = silu_f(v1.z); v1.w = silu_f(v1.w);
                    } else {
                        if (rope) {
                            const float* t = (kind == 1) ? (cs64 + (size_t)row * 16 + (c0 & 63)) : (cs32 + (size_t)row * 8);
                            const f32x4 t0 = *(const f32x4*)t, t1 = *(const f32x4*)(t + 4);
                            ROT2(v0.x, v0.y, t0.x, t0.y); ROT2(v0.z, v0.w, t0.z, t0.w); ROT2(v1.x, v1.y, t1.x, t1.y); ROT2(v1.z, v1.w, t1.z, t1.w);
                        }
                        v0 = v0 * sc; v1 = v1 * sc;
                        cs0 = cs0 + v0; cs1 = cs1 + v1;
                    }
                    u32x4 w; w.x = cvtpk(v0.x, v0.y); w.y = cvtpk(v0.z, v0.w); w.z = cvtpk(v1.x, v1.y); w.w = cvtpk(v1.z, v1.w);
                    bf16_t* dst = P + (size_t)row * PW + c0;
                    if (seg >= 3 && seg < 6) {
                        const int cc = c0 - 384, hh = cc >> 6, ch = (cc & 63) >> 3, bb = row >> 13, s = row & 8191;
                        dst = Kimg + ((((size_t)(bb * 6 + hh) * 128 + (s >> 6)) * 8 + ch) * 64 + (s & 63)) * 8;
                    }
                    if (seg >= 11 && seg < 13) {
                        const int cc = c0 - 1408, hh = cc >> 6, ch = (cc & 63) >> 3, bb = row >> 13, s = row & 8191;
                        dst = Kdf + ((((size_t)(bb * 4 + hh) * 128 + (s >> 6)) * 8 + ch) * 64 + (s & 63)) * 8;
                    }
                    if (seg >= 18 && seg < 21) {
                        const int cc = c0 - 2304, hh = cc >> 6, ch = (cc & 63) >> 3, bb = row >> 13, s = row & 8191;
                        dst = Ksb + ((((size_t)(bb * 6 + hh) * 128 + (s >> 6)) * 8 + ch) * 64 + (s & 63)) * 8;
                    }
                    *(u32x4*)dst = w;
                }
            if (seg >= 3 && seg < 6) {
#pragma unroll
                for (int o = 1; o < 16; o <<= 1) {
                    cs0.x += __shfl_xor(cs0.x, o); cs0.y += __shfl_xor(cs0.y, o); cs0.z += __shfl_xor(cs0.z, o); cs0.w += __shfl_xor(cs0.w, o);
                    cs1.x += __shfl_xor(cs1.x, o); cs1.y += __shfl_xor(cs1.y, o); cs1.z += __shfl_xor(cs1.z, o); cs1.w += __shfl_xor(cs1.w, o);
                }
                if (fr == 0) {
                    const int cc = c0 - 384, hh = cc >> 6, bb = u.pm >> 5, blk = u.pm & 31;
                    float* kp = kpart + ((((size_t)(bb * 6 + hh) * 32 + blk) * 2 + wr) * 64 + (cc & 63));
                    *(f32x4*)kp = cs0; *(f32x4*)(kp + 4) = cs1;
                }
            }
        }
    }
};
struct EpiVt {
    static constexpr bool PERM = true, AFTER_DRAIN = false;
    bf16_t* Vt; const float* ssq;
    __device__ __forceinline__ void operator()(const f32x4 (&acc)[2][2][4][2], const Unit& u, int wr, int wc, int fr, int fq) const {
        const int row0 = u.pm * 256 + wr * 64 + fr;
#pragma unroll
        for (int bj = 0; bj < 2; ++bj) {
            const int c0 = u.pn * 256 + bj * 128 + wc * 32 + fq * 8;
            float ri[8];
#pragma unroll
            for (int j = 0; j < 8; ++j) ri[j] = rinv_row(ssq, c0 + j);
#pragma unroll
            for (int ai = 0; ai < 2; ++ai)
#pragma unroll
                for (int m = 0; m < 4; ++m) {
                    const int row = row0 + ai * 128 + m * 16;
                    const f32x4 v0 = acc[ai][bj][m][0], v1 = acc[ai][bj][m][1];
                    u32x4 w; w.x = cvtpk(v0.x * ri[0], v0.y * ri[1]); w.y = cvtpk(v0.z * ri[2], v0.w * ri[3]); w.z = cvtpk(v1.x * ri[4], v1.y * ri[5]); w.w = cvtpk(v1.z * ri[6], v1.w * ri[7]);
                    bf16_t* dst = Vt + (size_t)row * TT + c0;
                    if (2 * u.pm + ai < 3) {
                        const int hh = row >> 6, d = row & 63, bb = c0 >> 13, s = c0 & 8191;
                        dst = Vt + ((((size_t)(bb * 6 + hh) * 128 + (s >> 6)) * 8 + ((s & 63) >> 3)) * 64 + d) * 8;
                    }
                    if (2 * u.pm + ai == 3 || 2 * u.pm + ai == 4) {
                        const int rr = row - 384, hh = rr >> 6, d = rr & 63, bb = c0 >> 13, s = c0 & 8191;
                        dst = Vt + (size_t)384 * TT + ((((size_t)(bb * 4 + hh) * 128 + (s >> 6)) * 8 + ((s & 63) >> 3)) * 64 + d) * 8;
                    }
                    if (2 * u.pm + ai >= 5) {
                        const int rr = row - 640, hh = rr >> 6, d = rr & 63, bb = c0 >> 13, s = c0 & 8191;
                        dst = Vt + (size_t)640 * TT + ((((size_t)(bb * 6 + hh) * 128 + (s >> 6)) * 8 + ((s & 63) >> 3)) * 64 + d) * 8;
                    }
                    *(u32x4*)dst = w;
                }
        }
    }
};
struct EpiRes {
    static constexpr bool PERM = true, AFTER_DRAIN = false;
    bf16_t* h; float* ssq; LAS float* red; int tid;
    __device__ __forceinline__ void operator()(const f32x4 (&acc)[2][2][4][2], const Unit& u, int wr, int wc, int fr, int fq) const {
        const int row0 = u.pm * 256 + wr * 64 + fr, col0 = u.pn * 256 + wc * 32 + 8 * fq;
#pragma unroll
        for (int ai = 0; ai < 2; ++ai)
#pragma unroll
            for (int m = 0; m < 4; ++m) {
                const int row = row0 + ai * 128 + m * 16; float ss = 0.f;
#pragma unroll
                for (int bj = 0; bj < 2; ++bj) {
                    bf16_t* p = h + (size_t)row * DM + col0 + bj * 128;
                    const u32x4 v = *(const u32x4*)p; const f32x4 a0 = acc[ai][bj][m][0], a1 = acc[ai][bj][m][1];
                    const float h0 = bflo(v.x) + a0.x, h1 = bfhi(v.x) + a0.y, h2 = bflo(v.y) + a0.z, h3 = bfhi(v.y) + a0.w, h4 = bflo(v.z) + a1.x, h5 = bfhi(v.z) + a1.y, h6 = bflo(v.w) + a1.z, h7 = bfhi(v.w) + a1.w;
                    u32x4 w; w.x = cvtpk(h0, h1); w.y = cvtpk(h2, h3); w.z = cvtpk(h4, h5); w.w = cvtpk(h6, h7);
                    *(u32x4*)p = w;
                    const float r0 = bflo(w.x), r1 = bfhi(w.x), r2 = bflo(w.y), r3 = bfhi(w.y), r4 = bflo(w.z), r5 = bfhi(w.z), r6 = bflo(w.w), r7 = bfhi(w.w);
                    ss += ((r0 * r0 + r1 * r1) + (r2 * r2 + r3 * r3)) + ((r4 * r4 + r5 * r5) + (r6 * r6 + r7 * r7));
                }
                ss += __shfl_xor(ss, 16); ss += __shfl_xor(ss, 32);
                if (fq == 0) red[(ai * 128 + wr * 64 + m * 16 + fr) * 4 + wc] = ss;
            }
        asm volatile("s_waitcnt lgkmcnt(0)" ::: "memory"); __builtin_amdgcn_s_barrier(); asm volatile("" ::: "memory");
        if (tid < 256) { const f32x4 v = *(const LAS f32x4*)(red + tid * 4); ssq[(size_t)(u.pm * 256 + tid) * 4 + u.pn] = (v.x + v.y) + (v.z + v.w); }
    }
};
struct EpiB16 {
    static constexpr bool PERM = true, AFTER_DRAIN = false;
    bf16_t* O; int ldc; const float* ssq; float scale;
    __device__ __forceinline__ void operator()(const f32x4 (&acc)[2][2][4][2], const Unit& u, int wr, int wc, int fr, int fq) const {
        const int row0 = u.pm * 256 + wr * 64 + fr;
#pragma unroll
        for (int ai = 0; ai < 2; ++ai)
#pragma unroll
            for (int m = 0; m < 4; ++m) {
                const int row = row0 + ai * 128 + m * 16; const float s = ssq ? scale * rinv_row(ssq, row) : scale;
#pragma unroll
                for (int bj = 0; bj < 2; ++bj) {
                    const int c0 = u.pn * 256 + bj * 128 + wc * 32 + fq * 8;
                    const f32x4 v0 = acc[ai][bj][m][0] * s, v1 = acc[ai][bj][m][1] * s;
                    u32x4 w; w.x = cvtpk(v0.x, v0.y); w.y = cvtpk(v0.z, v0.w); w.z = cvtpk(v1.x, v1.y); w.w = cvtpk(v1.z, v1.w);
                    *(u32x4*)(O + (size_t)row * ldc + c0) = w;
                }
            }
    }
};

struct ACtx { int tid, lane, wid, r32, hi, r32p; LAS unsigned char* lds; };
#define MFMA32(a, b, c) __builtin_amdgcn_mfma_f32_32x32x16_bf16((a), (b), (c), 0, 0, 0)

template <int ROWS, int CH> struct Stage {
    static constexpr int N = ROWS * CH / 512;
    u32x4 r[N];
    __device__ __forceinline__ void load(const bf16_t* g, size_t pitch, int tid) {
#pragma unroll
        for (int i = 0; i < N; ++i) { const int idx = tid + i * 512, rl = idx & 7, c = (idx >> 3) & (CH - 1), rh = idx / (8 * CH); r[i] = *(const u32x4*)(g + (size_t)(rh * 8 + rl) * pitch + c * 8); }
    }
    __device__ __forceinline__ void store(LAS unsigned char* dst, int tid) const {
#pragma unroll
        for (int i = 0; i < N; ++i) { const int idx = tid + i * 512, rl = idx & 7, c = (idx >> 3) & (CH - 1), rh = idx / (8 * CH); *(LAS u32x4*)(dst + c * (ROWS * 16) + (rh * 8 + rl) * 16) = r[i]; }
    }
};
template <int ROWS, int CH> __device__ __forceinline__ void stage_glds(const bf16_t* g, size_t pitch, LAS unsigned char* dst, const ACtx& c) {
    constexpr int RB = ROWS / 64, NP = RB * CH / 8;
#pragma unroll
    for (int i = 0; i < NP; ++i) {
        const int p = c.wid + 8 * i, chunk = p / RB, rb = p % RB;
        __builtin_amdgcn_global_load_lds((const unsigned*)(g + (size_t)(rb * 64 + c.lane) * pitch + chunk * 8), (LAS unsigned*)(dst + chunk * (ROWS * 16) + rb * 1024), 16, 0, 0);
    }
}
__device__ __forceinline__ bf16x8 pack8(float a0, float a1, float a2, float a3, float a4, float a5, float a6, float a7) {
    u32x4 w; w.x = cvtpk(a0, a1); w.y = cvtpk(a2, a3); w.z = cvtpk(a4, a5); w.w = cvtpk(a6, a7); return __builtin_bit_cast(bf16x8, w);
}
template <int NK, int KSTR = 1024> __device__ __forceinline__ void qk_tile(f32x16& p0, f32x16& p1, const LAS unsigned char* Ks, int cb, const bf16x8* qr, const ACtx& c) {
    f32x16 z;
#pragma unroll
    for (int r = 0; r < 16; ++r) z[r] = 0.f;
    p0 = z; p1 = z;
    __builtin_amdgcn_s_setprio(1);
#pragma unroll
    for (int d0 = 0; d0 < NK; ++d0) {
        const LAS unsigned char* a = Ks + (cb + 2 * d0 + c.hi) * KSTR + c.r32p * 16;
        const bf16x8 k0 = *(const LAS bf16x8*)a, k1 = *(const LAS bf16x8*)(a + 512);
        p0 = MFMA32(k0, qr[d0], p0); p1 = MFMA32(k1, qr[d0], p1);
    }
    __builtin_amdgcn_s_setprio(0);
}
template <int DVB, int VSTR = 512 * DVB> __device__ __forceinline__ void pv_tile(f32x16* o, const LAS unsigned char* Vs, const f32x16& p0, const f32x16& p1, const ACtx& c) {
    bf16x8 pf[4];
    pf[0] = pack8(p0[0], p0[1], p0[2], p0[3], p0[4], p0[5], p0[6], p0[7]); pf[1] = pack8(p0[8], p0[9], p0[10], p0[11], p0[12], p0[13], p0[14], p0[15]);
    pf[2] = pack8(p1[0], p1[1], p1[2], p1[3], p1[4], p1[5], p1[6], p1[7]); pf[3] = pack8(p1[8], p1[9], p1[10], p1[11], p1[12], p1[13], p1[14], p1[15]);
#pragma unroll
    for (int s = 0; s < 4; ++s)
#pragma unroll
        for (int d0 = 0; d0 < DVB; ++d0) {
            const bf16x8 v = *(const LAS bf16x8*)(Vs + (2 * s + c.hi) * VSTR + (32 * d0 + c.r32) * 16);
            o[d0] = MFMA32(v, pf[s], o[d0]);
        }
}
__device__ __forceinline__ float softmax_step(f32x16& p0, f32x16& p1, float& m, float& l) {
    float mx = fmaxf(p0[0], p1[0]);
#pragma unroll
    for (int r = 1; r < 16; ++r) mx = fmaxf(mx, fmaxf(p0[r], p1[r]));
    mx = fmaxf(mx, __shfl_xor(mx, 32));
    const float mn = fmaxf(m, mx), alpha = ex2(m - mn); m = mn;
    float rs = 0.f;
#pragma unroll
    for (int r = 0; r < 16; ++r) { p0[r] = ex2(p0[r] - mn); p1[r] = ex2(p1[r] - mn); rs += p0[r] + p1[r]; }
    l = l * alpha + rs;
    return alpha;
}
__device__ __forceinline__ void scale_o(f32x16& o, float a) {
#pragma unroll
    for (int r = 0; r < 16; ++r) o[r] *= a;
}
__device__ __forceinline__ void zero16(f32x16& o) {
#pragma unroll
    for (int r = 0; r < 16; ++r) o[r] = 0.f;
}
__device__ __forceinline__ void xhalf(float v, float& lo, float& hi) { auto r = __builtin_amdgcn_permlane32_swap(__float_as_uint(v), __float_as_uint(v), false, false); lo = __uint_as_float(r[0]); hi = __uint_as_float(r[1]); }
__device__ __forceinline__ float xhalf_partner(float v, int hi_lane) { float lo, hi; xhalf(v, lo, hi); return hi_lane ? lo : hi; }
__device__ __forceinline__ unsigned xhalf_or(unsigned v) { auto r = __builtin_amdgcn_permlane32_swap(v, v, false, false); return r[0] | r[1]; }
struct Soft { float m; int zm; float l; };
__device__ __forceinline__ void soft_init(Soft& s) { s.m = 0.f; s.zm = 1; s.l = 0.f; }
__device__ __forceinline__ float max3f(float a, float b, float c) { float r; asm("v_max3_f32 %0, %1, %2, %3" : "=v"(r) : "v"(a), "v"(b), "v"(c)); return r; }
template <int NO> __device__ __forceinline__ void soft_step(Soft& s, f32x16& p0, f32x16& p1, f32x16* o, bool first) {
    float a = max3f(p0[0], p0[1], p1[0]), b = max3f(p0[2], p0[3], p1[1]); a = max3f(a, p1[2], p1[3]);
#pragma unroll
    for (int r = 4; r < 16; r += 4) { a = max3f(a, p0[r], p0[r + 1]); b = max3f(b, p0[r + 2], p0[r + 3]); a = max3f(a, p1[r], p1[r + 1]); b = max3f(b, p1[r + 2], p1[r + 3]); }
    float mx = max3f(a, b, b);
    { float lo_, hi_; xhalf(mx, lo_, hi_); mx = max3f(lo_, hi_, hi_); }
    const float d = mx - s.m;
    const bool up = d > 32.f, dn = first && (d < -32.f) && (mx > -1.0e29f);
    if (__any(up || dn)) {
        const float mn = (up || dn) ? mx : s.m; const float alpha = ex2(s.m - mn); s.m = mn;
        s.l *= alpha;
#pragma unroll
        for (int i = 0; i < NO; ++i) scale_o(o[i], alpha);
        s.zm = __all(s.m == 0.f);
    }
    if (s.zm) {
#pragma unroll
        for (int r = 0; r < 16; ++r) { p0[r] = ex2(p0[r]); p1[r] = ex2(p1[r]); }
    } else {
        const float m = s.m;
#pragma unroll
        for (int r = 0; r < 16; ++r) { p0[r] = ex2(p0[r] - m); p1[r] = ex2(p1[r] - m); }
    }
}
__device__ __forceinline__ bf16x8 ones8() { u32x4 w; w.x = 0x3F803F80u; w.y = 0x3F803F80u; w.z = 0x3F803F80u; w.w = 0x3F803F80u; return __builtin_bit_cast(bf16x8, w); }
template <int DVB, int VSTR> __device__ __forceinline__ void pv_tile_l(f32x16* o, float& l, const LAS unsigned char* Vs, const f32x16& p0, const f32x16& p1, const ACtx& c) {
    bf16x8 pf[4];
    pf[0] = pack8(p0[0], p0[1], p0[2], p0[3], p0[4], p0[5], p0[6], p0[7]); pf[1] = pack8(p0[8], p0[9], p0[10], p0[11], p0[12], p0[13], p0[14], p0[15]);
    pf[2] = pack8(p1[0], p1[1], p1[2], p1[3], p1[4], p1[5], p1[6], p1[7]); pf[3] = pack8(p1[8], p1[9], p1[10], p1[11], p1[12], p1[13], p1[14], p1[15]);
    const bf16x8 one = ones8();
    f32x16 la; zero16(la);
    __builtin_amdgcn_s_setprio(1);
#pragma unroll
    for (int s = 0; s < 4; ++s) {
        la = MFMA32(one, pf[s], la);
#pragma unroll
        for (int d0 = 0; d0 < DVB; ++d0) {
            const bf16x8 v = *(const LAS bf16x8*)(Vs + (2 * s + c.hi) * VSTR + (32 * d0 + c.r32) * 16);
            o[d0] = MFMA32(v, pf[s], o[d0]);
        }
    }
    __builtin_amdgcn_s_setprio(0);
    l += la[0];
}
template <bool STRICT> __device__ __forceinline__ void mask_causal(f32x16& p0, f32x16& p1, int kbase, int q, int hi) {
#pragma unroll
    for (int r = 0; r < 16; ++r) {
        const int key = kbase + 16 * (r >> 3) + 8 * hi + (r & 7);
        const bool v0 = STRICT ? (key < q) : (key <= q), v1 = STRICT ? (key + 32 < q) : (key + 32 <= q);
        p0[r] = v0 ? p0[r] : NEGF; p1[r] = v1 ? p1[r] : NEGF;
    }
}
__device__ __forceinline__ void top3_insert(float& t1, float& t2, float& t3, float v) {
    const float a = fmaxf(t1, v), b = fminf(t1, v); t1 = a; const float c = fmaxf(t2, b), d = fminf(t2, b); t2 = c; t3 = fmaxf(t3, d);
}

__device__ __forceinline__ void store_gated_rows(const ACtx& c, LAS unsigned char* stg, const f32x16* o, const bf16_t* Gp0, bf16_t* Op0, size_t gpitch) {
#pragma unroll
    for (int d0 = 0; d0 < 2; ++d0)
#pragma unroll
        for (int r4 = 0; r4 < 4; ++r4) {
            u32x2 w; w.x = cvtpk(o[d0][4 * r4], o[d0][4 * r4 + 1]); w.y = cvtpk(o[d0][4 * r4 + 2], o[d0][4 * r4 + 3]);
            *(LAS u32x2*)(stg + c.r32 * 128 + (((4 * d0 + r4) ^ (c.r32 & 7)) * 16) + c.hi * 8) = w;
        }
    asm volatile("s_waitcnt lgkmcnt(0)" ::: "memory");
#pragma unroll
    for (int i = 0; i < 4; ++i) {
        const int row = i * 8 + (c.lane >> 3), ch = c.lane & 7;
        const u32x4 v = *(const LAS u32x4*)(stg + row * 128 + ((ch ^ (row & 7)) * 16));
        const u32x4 g = *(const u32x4*)(Gp0 + (size_t)row * gpitch + ch * 8);
        u32x4 w; w.x = cvtpk(bflo(v.x) * bflo(g.x), bfhi(v.x) * bfhi(g.x)); w.y = cvtpk(bflo(v.y) * bflo(g.y), bfhi(v.y) * bfhi(g.y));
        w.z = cvtpk(bflo(v.z) * bflo(g.z), bfhi(v.z) * bfhi(g.z)); w.w = cvtpk(bflo(v.w) * bflo(g.w), bfhi(v.w) * bfhi(g.w));
        *(u32x4*)(Op0 + (size_t)row * DM + ch * 8) = w;
    }
    asm volatile("s_waitcnt lgkmcnt(0)" ::: "memory");
}
constexpr int MOBA_PART = 32768, MOBA_REC = 136;
template <int NP> __device__ __forceinline__ void stage_linear(const bf16_t* g, LAS unsigned char* dst, const ACtx& c) {
#pragma unroll
    for (int i = 0; i < NP; ++i) { const int p = c.wid + 8 * i; __builtin_amdgcn_global_load_lds((const unsigned*)(g + (size_t)p * 512 + c.lane * 8), (LAS unsigned*)(dst + p * 1024), 16, 0, 0); }
}
__device__ __forceinline__ void moba_unit(const ACtx& c, int b, int h, int qb, const bf16_t* P, const bf16_t* Kimg, const bf16_t* Vimg, const float* kpart, bf16_t* merged) {
    const size_t tok0 = (size_t)b * SEQ;
    const int qrel = c.wid * 32 + c.r32;
    const size_t qtok = tok0 + qb * 256 + qrel;
    const bf16_t* Kg = Kimg + (size_t)(b * 6 + h) * 128 * 4096;
    const bf16_t* Vg = Vimg + (size_t)(b * 6 + h) * 128 * 4096;
    const bf16_t* Qp = P + qtok * PW + h * 64;
    unsigned sel = 0u;
    if (qb > 0) {
        {
            bf16x8 qr[4];
#pragma unroll
            for (int d0 = 0; d0 < 4; ++d0) qr[d0] = *(const bf16x8*)(Qp + d0 * 16 + c.hi * 8);
            f32x16 g; zero16(g);
            const float* km = kpart + ((size_t)(b * 6 + h) * 32 + c.r32) * 128;
#pragma unroll
            for (int d0 = 0; d0 < 4; ++d0) {
                const float* kq = km + d0 * 16 + c.hi * 8;
                const f32x4 a0 = *(const f32x4*)kq + *(const f32x4*)(kq + 64), a1 = *(const f32x4*)(kq + 4) + *(const f32x4*)(kq + 68);
                const float sc = 1.f / 256.f;
                const bf16x8 kf = pack8(a0.x * sc, a0.y * sc, a0.z * sc, a0.w * sc, a1.x * sc, a1.y * sc, a1.z * sc, a1.w * sc); g = MFMA32(kf, qr[d0], g);
            }
            float t1 = NEGF, t2 = NEGF, t3 = NEGF;
#pragma unroll
            for (int r = 0; r < 16; ++r) { const int blk = (r & 3) + 8 * (r >> 2) + 4 * c.hi; const float v = (blk < qb) ? g[r] : NEGF; g[r] = v; top3_insert(t1, t2, t3, v); }
            const float u1 = xhalf_partner(t1, c.hi), u2 = xhalf_partner(t2, c.hi), u3 = xhalf_partner(t3, c.hi);
            top3_insert(t1, t2, t3, u1); top3_insert(t1, t2, t3, u2); top3_insert(t1, t2, t3, u3);
            unsigned seq = 0u;
#pragma unroll
            for (int r = 0; r < 16; ++r) { const int blk = (r & 3) + 8 * (r >> 2) + 4 * c.hi; if (blk < qb) { if (g[r] > t3) sel |= 1u << blk; else if (g[r] == t3) seq |= 1u << blk; } }
            sel = xhalf_or(sel); seq = xhalf_or(seq);
            { const int need = 3 - __popc(sel); while (__popc(seq) > need) seq &= ~(0x80000000u >> __clz((int)seq)); }
            sel |= seq;
        }
        LAS int* cnt = (LAS int*)c.lds; LAS unsigned short* list = (LAS unsigned short*)(c.lds + 1024);
        if (c.tid < 32) cnt[c.tid] = 0;
        __syncthreads();
        if (c.hi == 0) {
            unsigned s = sel; int slot = 0;
            while (s) { const int blk = __ffs((int)s) - 1; s &= s - 1u; const int pos = __hip_atomic_fetch_add(cnt + blk, 1, __ATOMIC_RELAXED, __HIP_MEMORY_SCOPE_WORKGROUP); list[blk * 256 + pos] = (unsigned short)(qrel | (slot << 8)); ++slot; }
        }
        __syncthreads();
        int item = 0;
#pragma unroll 1
        for (int j = 0; j < qb; ++j) {
            const int n = __builtin_amdgcn_readfirstlane(cnt[j]); const int ntile = (n + 31) >> 5;
#pragma unroll 1
            for (int tl = 0; tl < ntile; ++tl, ++item) {
                if ((item & 7) != c.wid) continue;
                const int idx = 32 * tl + c.r32; const bool valid = idx < n;
                const unsigned e = list[j * 256 + (valid ? idx : 0)]; const int ql = e & 255, slot = e >> 8;
                const bf16_t* Qg = P + (tok0 + qb * 256 + ql) * PW + h * 64;
                bf16x8 qg[4];
#pragma unroll
                for (int d0 = 0; d0 < 4; ++d0) qg[d0] = *(const bf16x8*)(Qg + d0 * 16 + c.hi * 8);
                Soft s2; soft_init(s2); f32x16 o2[2]; zero16(o2[0]); zero16(o2[1]);
                const bf16_t* kp = Kg + (size_t)(j * 4) * 4096 + (c.hi * 64 + c.r32p) * 8;
                const bf16_t* vp = Vg + (size_t)(j * 4) * 4096 + (c.hi * 64 + c.r32) * 8;
                bf16x8 kc[8];
#pragma unroll
                for (int i = 0; i < 4; ++i) { kc[2 * i] = *(const bf16x8*)(kp + i * 1024); kc[2 * i + 1] = *(const bf16x8*)(kp + i * 1024 + 256); }
#pragma unroll 2
                for (int kt = 0; kt < 4; ++kt) {
                    bf16x8 vc[8];
                    { const bf16_t* vq = vp + (size_t)kt * 4096;
#pragma unroll
                      for (int i = 0; i < 4; ++i) { vc[2 * i] = *(const bf16x8*)(vq + i * 1024); vc[2 * i + 1] = *(const bf16x8*)(vq + i * 1024 + 256); } }
                    f32x16 p0, p1; zero16(p0); zero16(p1);
#pragma unroll
                    for (int d0 = 0; d0 < 4; ++d0) { p0 = MFMA32(kc[2 * d0], qg[d0], p0); p1 = MFMA32(kc[2 * d0 + 1], qg[d0], p1); }
                    if (kt < 3) {
                        const bf16_t* kq = kp + (size_t)(kt + 1) * 4096;
#pragma unroll
                        for (int i = 0; i < 4; ++i) { kc[2 * i] = *(const bf16x8*)(kq + i * 1024); kc[2 * i + 1] = *(const bf16x8*)(kq + i * 1024 + 256); }
                    }
                    soft_step<2>(s2, p0, p1, o2, kt == 0);
                    bf16x8 pf[4]; const bf16x8 one = ones8(); f32x16 la; zero16(la);
                    pf[0] = pack8(p0[0], p0[1], p0[2], p0[3], p0[4], p0[5], p0[6], p0[7]); pf[1] = pack8(p0[8], p0[9], p0[10], p0[11], p0[12], p0[13], p0[14], p0[15]);
                    pf[2] = pack8(p1[0], p1[1], p1[2], p1[3], p1[4], p1[5], p1[6], p1[7]); pf[3] = pack8(p1[8], p1[9], p1[10], p1[11], p1[12], p1[13], p1[14], p1[15]);
#pragma unroll
                    for (int s = 0; s < 4; ++s) {
                        la = MFMA32(one, pf[s], la);
                        o2[0] = MFMA32(vc[2 * s], pf[s], o2[0]); o2[1] = MFMA32(vc[2 * s + 1], pf[s], o2[1]);
                    }
                    s2.l += la[0];
                }
                const float m2 = s2.m, l2 = s2.l;
                if (valid) {
                    LAS unsigned char* rec = c.lds + MOBA_PART + (ql * 3 + slot) * MOBA_REC;
#pragma unroll
                    for (int d0 = 0; d0 < 2; ++d0)
#pragma unroll
                        for (int r4 = 0; r4 < 4; ++r4) { u32x2 w; w.x = cvtpk(o2[d0][4 * r4], o2[d0][4 * r4 + 1]); w.y = cvtpk(o2[d0][4 * r4 + 2], o2[d0][4 * r4 + 3]); *(LAS u32x2*)(rec + (32 * d0 + 8 * r4 + 4 * c.hi) * 2) = w; }
                    if (c.hi == 0) { *(LAS float*)(rec + 128) = m2; *(LAS float*)(rec + 132) = l2; }
                }
            }
        }
        __syncthreads();
    }
    Soft sm; soft_init(sm); f32x16 o[2]; zero16(o[0]); zero16(o[1]);
    {
        bf16x8 qr[4];
#pragma unroll
        for (int d0 = 0; d0 < 4; ++d0) qr[d0] = *(const bf16x8*)(Qp + d0 * 16 + c.hi * 8);
        const bf16_t* kp = Kg + (size_t)(qb * 4) * 4096 + (c.hi * 64 + c.r32p) * 8;
        const bf16_t* vp = Vg + (size_t)(qb * 4) * 4096 + (c.hi * 64 + c.r32) * 8;
        const int ntl = ((32 * c.wid + 31) >> 6) + 1;
        bf16x8 kc[8];
#pragma unroll
        for (int i = 0; i < 4; ++i) { kc[2 * i] = *(const bf16x8*)(kp + i * 1024); kc[2 * i + 1] = *(const bf16x8*)(kp + i * 1024 + 256); }
#pragma unroll 1
        for (int kt = 0; kt < ntl; ++kt) {
            bf16x8 vc[8];
            { const bf16_t* vq = vp + (size_t)kt * 4096;
#pragma unroll
              for (int i = 0; i < 4; ++i) { vc[2 * i] = *(const bf16x8*)(vq + i * 1024); vc[2 * i + 1] = *(const bf16x8*)(vq + i * 1024 + 256); } }
            f32x16 p0, p1; zero16(p0); zero16(p1);
#pragma unroll
            for (int d0 = 0; d0 < 4; ++d0) { p0 = MFMA32(kc[2 * d0], qr[d0], p0); p1 = MFMA32(kc[2 * d0 + 1], qr[d0], p1); }
            if (kt + 1 < ntl) {
                const bf16_t* kq = kp + (size_t)(kt + 1) * 4096;
#pragma unroll
                for (int i = 0; i < 4; ++i) { kc[2 * i] = *(const bf16x8*)(kq + i * 1024); kc[2 * i + 1] = *(const bf16x8*)(kq + i * 1024 + 256); }
            }
            if (64 * kt + 63 > 32 * c.wid) mask_causal<false>(p0, p1, 64 * kt, qrel, c.hi);
            soft_step<2>(sm, p0, p1, o, kt == 0);
            bf16x8 pf[4]; const bf16x8 one = ones8(); f32x16 la; zero16(la);
            pf[0] = pack8(p0[0], p0[1], p0[2], p0[3], p0[4], p0[5], p0[6], p0[7]); pf[1] = pack8(p0[8], p0[9], p0[10], p0[11], p0[12], p0[13], p0[14], p0[15]);
            pf[2] = pack8(p1[0], p1[1], p1[2], p1[3], p1[4], p1[5], p1[6], p1[7]); pf[3] = pack8(p1[8], p1[9], p1[10], p1[11], p1[12], p1[13], p1[14], p1[15]);
#pragma unroll
            for (int s = 0; s < 4; ++s) { la = MFMA32(one, pf[s], la); o[0] = MFMA32(vc[2 * s], pf[s], o[0]); o[1] = MFMA32(vc[2 * s + 1], pf[s], o[1]); }
            sm.l += la[0];
        }
    }
    float l = sm.l;
    if (qb > 0) {
        const float m = sm.m;
        const int nsel = __popc(sel);
        const LAS unsigned char* rec0 = c.lds + MOBA_PART + (qrel * 3) * MOBA_REC;
        float ms0 = NEGF, ms1 = NEGF, ms2 = NEGF;
        if (nsel > 0) ms0 = *(const LAS float*)(rec0 + 128);
        if (nsel > 1) ms1 = *(const LAS float*)(rec0 + MOBA_REC + 128);
        if (nsel > 2) ms2 = *(const LAS float*)(rec0 + 2 * MOBA_REC + 128);
        const float M = fmaxf(fmaxf(m, ms0), fmaxf(ms1, ms2));
        const float w0 = ex2(m - M); l *= w0; scale_o(o[0], w0); scale_o(o[1], w0);
#pragma unroll
        for (int s = 0; s < 3; ++s) {
            if (s < nsel) {
                const LAS unsigned char* rec = rec0 + s * MOBA_REC;
                const float ws = ex2((s == 0 ? ms0 : (s == 1 ? ms1 : ms2)) - M);
                l += ws * *(const LAS float*)(rec + 132);
#pragma unroll
                for (int d0 = 0; d0 < 2; ++d0)
#pragma unroll
                    for (int r4 = 0; r4 < 4; ++r4) { const u32x2 v = *(const LAS u32x2*)(rec + (32 * d0 + 8 * r4 + 4 * c.hi) * 2);
                        o[d0][4 * r4] += ws * bflo(v.x); o[d0][4 * r4 + 1] += ws * bfhi(v.x); o[d0][4 * r4 + 2] += ws * bflo(v.y); o[d0][4 * r4 + 3] += ws * bfhi(v.y); }
            }
        }
    }
    const float inv = 1.f / l;
    scale_o(o[0], inv); scale_o(o[1], inv);
    { const size_t qt0 = tok0 + qb * 256 + c.wid * 32;
      store_gated_rows(c, c.lds + c.wid * 4096, o, P + qt0 * PW + 768 + h * 64, merged + qt0 * DM + h * 64, PW); }
    __syncthreads();
}

__device__ __forceinline__ void diff_sub(const bool MASK, const ACtx& c, const LAS unsigned char* Ks, const LAS unsigned char* Vs, const bf16x8 (&qr)[2][2], int kbase, int qabs,
                                                             Soft& s0, Soft& s1, f32x16* oa, f32x16* ob, bool first) {
    f32x16 p0, p1, r0, r1;
    qk_tile<2, 1024>(p0, p1, Ks, 0, qr[0], c);
    qk_tile<2, 1024>(r0, r1, Ks, 4, qr[1], c);
    if (MASK) { mask_causal<false>(p0, p1, kbase, qabs, c.hi); mask_causal<false>(r0, r1, kbase, qabs, c.hi); }
    soft_step<2>(s0, p0, p1, oa, first);
    soft_step<2>(s1, r0, r1, ob, first);
    {
        float sa = 0.f, sb = 0.f;
#pragma unroll
        for (int r = 0; r < 16; ++r) { sa += p0[r] + p1[r]; sb += r0[r] + r1[r]; }
        s0.l += sa; s1.l += sb;
    }
    pv_tile<2, 1024>(oa, Vs, p0, p1, c);
    pv_tile<2, 1024>(ob, Vs, r0, r1, c);
}
__device__ __forceinline__ void diff_unit(const ACtx& c, int b, int h, int qb, const bf16_t* P, const bf16_t* Kdf, const bf16_t* Vdf, bf16_t* merged, float lam, float one_m_li, const float* hng) {
    const size_t tok0 = (size_t)b * SEQ;
    const int q0w = qb * 256 + c.wid * 32, qabs = q0w + c.r32;
    const size_t qtok = tok0 + qabs;
    const bf16_t* Qp = P + qtok * PW + 1152 + h * 64;
    bf16x8 qr[2][2];
#pragma unroll
    for (int sh = 0; sh < 2; ++sh)
#pragma unroll
        for (int d0 = 0; d0 < 2; ++d0) qr[sh][d0] = *(const bf16x8*)(Qp + sh * 32 + d0 * 16 + c.hi * 8);
    const int NT = 2 * qb + 2;
    const bf16_t* Kg = Kdf + (size_t)(b * 4 + h) * 128 * 4096;
    const bf16_t* Vg = Vdf + (size_t)(b * 4 + h) * 128 * 4096;
    stage_linear<2>(Kg, c.lds, c); stage_linear<2>(Vg, c.lds + 32768, c);
    __syncthreads();
    Soft s0, s1; soft_init(s0); soft_init(s1); f32x16 oa[2], ob[2]; zero16(oa[0]); zero16(oa[1]); zero16(ob[0]); zero16(ob[1]);
#pragma unroll 1
    for (int t = 0; t < NT; ++t) {
        const int cur = t & 1;
        if (t + 1 < NT) { stage_linear<2>(Kg + (size_t)(2 * t + 2) * 4096, c.lds + (cur ^ 1) * 16384, c); stage_linear<2>(Vg + (size_t)(2 * t + 2) * 4096, c.lds + 32768 + (cur ^ 1) * 16384, c); }
#pragma unroll
        for (int u = 0; u < 2; ++u) {
            const int kbase = 128 * t + 64 * u;
            if (kbase <= q0w + 31) {
                const LAS unsigned char* Ks = c.lds + cur * 16384 + u * 8192; const LAS unsigned char* Vs = c.lds + 32768 + cur * 16384 + u * 8192;
                diff_sub(kbase + 63 > q0w, c, Ks, Vs, qr, kbase, qabs, s0, s1, oa, ob, kbase == 0);
            }
        }
        __syncthreads();
    }
    { float lo_, hi_; xhalf(s0.l, lo_, hi_); s0.l = lo_ + hi_; xhalf(s1.l, lo_, hi_); s1.l = lo_ + hi_; }
    const float a0 = 1.f / s0.l, a1 = lam / s1.l;
    float ss = 0.f;
#pragma unroll
    for (int d0 = 0; d0 < 2; ++d0)
#pragma unroll
        for (int r = 0; r < 16; ++r) { const float f = oa[d0][r] * a0 - ob[d0][r] * a1; oa[d0][r] = f; ss += f * f; }
    { float lo_, hi_; xhalf(ss, lo_, hi_); ss = lo_ + hi_; }
    const float rn = __builtin_amdgcn_rsqf(ss * (1.f / 64.f) + RMS_EPS) * one_m_li;
#pragma unroll
    for (int d0 = 0; d0 < 2; ++d0)
#pragma unroll
        for (int r4 = 0; r4 < 4; ++r4) {
            const int d = 32 * d0 + 8 * r4 + 4 * c.hi; const f32x4 hg = *(const f32x4*)(hng + d);
            oa[d0][4 * r4] *= rn * hg.x; oa[d0][4 * r4 + 1] *= rn * hg.y; oa[d0][4 * r4 + 2] *= rn * hg.z; oa[d0][4 * r4 + 3] *= rn * hg.w;
        }
    { const size_t qt0 = tok0 + q0w;
      store_gated_rows(c, c.lds + c.wid * 4096, oa, P + qt0 * PW + 1664 + h * 64, merged + qt0 * DM + 384 + h * 64, PW); }
    __syncthreads();
}

__device__ __forceinline__ void sb_elem(float z, bool valid, float& a, float& lb) {
    const float e = ex2(-fabsf(z)); const float sp = fmaxf(z, 0.f) + lg2(1.f + e);
    a = valid ? -sp : 0.f; lb = valid ? (z - sp) : NEGF;
}
__device__ __forceinline__ void sb_unit(const ACtx& c, int b, int h, int qb, const bf16_t* P, const bf16_t* Ksb, const bf16_t* Vsb, bf16_t* merged) {
    const size_t tok0 = (size_t)b * SEQ;
    const int q0w = qb * 256 + c.wid * 32, qabs = q0w + c.r32;
    const size_t qtok = tok0 + qabs;
    const bf16_t* Qp = P + qtok * PW + 1920 + h * 64;
    bf16x8 qr[4];
#pragma unroll
    for (int d0 = 0; d0 < 4; ++d0) qr[d0] = *(const bf16x8*)(Qp + d0 * 16 + c.hi * 8);
    const bf16_t* kp = Ksb + (size_t)(b * 6 + h) * 128 * 4096 + (c.hi * 64 + c.r32p) * 8;
    const bf16_t* vp = Vsb + (size_t)(b * 6 + h) * 128 * 4096 + (c.hi * 64 + c.r32) * 8;
    float R = 0.f; f32x16 o[2]; zero16(o[0]); zero16(o[1]);
    int t = (q0w + 30) >> 6;
    {
        bf16x8 kc[8];
#pragma unroll
        for (int i = 0; i < 4; ++i) { kc[2 * i] = *(const bf16x8*)(kp + (size_t)t * 4096 + i * 1024); kc[2 * i + 1] = *(const bf16x8*)(kp + (size_t)t * 4096 + i * 1024 + 256); }
#pragma unroll 1
        for (;;) {
            bf16x8 vc[8];
#pragma unroll
            for (int i = 0; i < 4; ++i) { vc[2 * i] = *(const bf16x8*)(vp + (size_t)t * 4096 + i * 1024); vc[2 * i + 1] = *(const bf16x8*)(vp + (size_t)t * 4096 + i * 1024 + 256); }
            f32x16 p0, p1; zero16(p0); zero16(p1);
#pragma unroll
            for (int d0 = 0; d0 < 4; ++d0) { p0 = MFMA32(kc[2 * d0], qr[d0], p0); p1 = MFMA32(kc[2 * d0 + 1], qr[d0], p1); }
            if (t > 0) {
#pragma unroll
                for (int i = 0; i < 4; ++i) { kc[2 * i] = *(const bf16x8*)(kp + (size_t)(t - 1) * 4096 + i * 1024); kc[2 * i + 1] = *(const bf16x8*)(kp + (size_t)(t - 1) * 4096 + i * 1024 + 256); }
            }
            const bool needmask = (64 * t + 63 >= q0w);
            f32x16 a0, a1;
#pragma unroll
            for (int r = 0; r < 16; ++r) {
                const int key = 64 * t + 16 * (r >> 3) + 8 * c.hi + (r & 7);
                float a, lb;
                sb_elem(p0[r], !needmask || (key < qabs), a, lb); a0[r] = a; p0[r] = lb;
                sb_elem(p1[r], !needmask || (key + 32 < qabs), a, lb); a1[r] = a; p1[r] = lb;
            }
            float gs0 = 0.f, gs1 = 0.f, gs2 = 0.f, gs3 = 0.f;
#pragma unroll
            for (int i = 0; i < 8; ++i) { gs0 += a0[i]; gs1 += a0[8 + i]; gs2 += a1[i]; gs3 += a1[8 + i]; }
            const float pg0 = xhalf_partner(gs0, c.hi), pg1 = xhalf_partner(gs1, c.hi), pg2 = xhalf_partner(gs2, c.hi), pg3 = xhalf_partner(gs3, c.hi);
            const float so2 = gs3, so1 = so2 + gs2, so0 = so1 + gs1;
            const float pe2 = pg3, pe1 = pe2 + pg2, pe0 = pe1 + pg1;
            const float totO = so0 + gs0, totP = pe0 + pg0;
            float base0 = R + so0 + (c.hi ? pe0 : totP);
            float base1 = R + so1 + (c.hi ? pe1 : pe0);
            float base2 = R + so2 + (c.hi ? pe2 : pe1);
            float base3 = R + (c.hi ? 0.f : pe2);
#pragma unroll
            for (int i = 7; i >= 0; --i) {
                p0[i] = ex2(p0[i] + base0); base0 += a0[i];
                p0[8 + i] = ex2(p0[8 + i] + base1); base1 += a0[8 + i];
                p1[i] = ex2(p1[i] + base2); base2 += a1[i];
                p1[8 + i] = ex2(p1[8 + i] + base3); base3 += a1[8 + i];
            }
            R += c.hi ? (totP + totO) : (totO + totP);
            bf16x8 pf[4];
            pf[0] = pack8(p0[0], p0[1], p0[2], p0[3], p0[4], p0[5], p0[6], p0[7]); pf[1] = pack8(p0[8], p0[9], p0[10], p0[11], p0[12], p0[13], p0[14], p0[15]);
            pf[2] = pack8(p1[0], p1[1], p1[2], p1[3], p1[4], p1[5], p1[6], p1[7]); pf[3] = pack8(p1[8], p1[9], p1[10], p1[11], p1[12], p1[13], p1[14], p1[15]);
#pragma unroll
            for (int s = 0; s < 4; ++s) { o[0] = MFMA32(vc[2 * s], pf[s], o[0]); o[1] = MFMA32(vc[2 * s + 1], pf[s], o[1]); }
            if (t == 0 || __all(R < -150.f)) break;
            --t;
        }
    }
    { const size_t qt0 = tok0 + q0w;
      store_gated_rows(c, c.lds + c.wid * 4096, o, P + qt0 * PW + 2688 + h * 64, merged + qt0 * DM + 640 + h * 64, PW); }
}

__device__ __forceinline__ void xattn_unit(const ACtx& c, int b, int hx, int qb, const bf16_t* QX, const bf16_t* KX, const bf16_t* VXT, bf16_t* OX) {
    const size_t qtok = (size_t)b * SEQ + qb * 256 + c.wid * 32 + c.r32;
    const bf16_t* Qp = QX + qtok * 512 + hx * 128;
    bf16x8 qr[8];
#pragma unroll
    for (int d0 = 0; d0 < 8; ++d0) qr[d0] = *(const bf16x8*)(Qp + d0 * 16 + c.hi * 8);
    const bf16_t* Kg = KX + (size_t)(b * MEML) * 512 + hx * 128;
    const bf16_t* Vg = VXT + (size_t)(hx * 128) * 1024 + b * MEML;
    stage_glds<256, 16>(Kg, 512, c.lds, c); stage_glds<128, 32>(Vg, 1024, c.lds + 65536, c);
    __syncthreads();
    Soft sm; soft_init(sm); f32x16 o[4]; zero16(o[0]); zero16(o[1]); zero16(o[2]); zero16(o[3]);
#pragma unroll 2
    for (int t = 0; t < 4; ++t) {
        f32x16 p0, p1; qk_tile<8, 4096>(p0, p1, c.lds + t * 1024, 0, qr, c);
        soft_step<4>(sm, p0, p1, o, t == 0);
        pv_tile_l<4, 2048>(o, sm.l, c.lds + 65536 + t * 16384, p0, p1, c);
    }
    __syncthreads();
    const float inv = 1.f / sm.l;
    bf16_t* Op = OX + qtok * 512 + hx * 128;
#pragma unroll
    for (int d0 = 0; d0 < 4; ++d0)
#pragma unroll
        for (int r4 = 0; r4 < 4; ++r4) {
            const int d = 32 * d0 + 8 * r4 + 4 * c.hi;
            u32x2 w; w.x = cvtpk(o[d0][4 * r4] * inv, o[d0][4 * r4 + 1] * inv); w.y = cvtpk(o[d0][4 * r4 + 2] * inv, o[d0][4 * r4 + 3] * inv);
            *(u32x2*)(Op + d) = w;
        }
}

__device__ __forceinline__ float wave_sum(float v) {
#pragma unroll
    for (int o = 1; o < 64; o <<= 1) v += __shfl_xor(v, o);
    return v;
}
__device__ __forceinline__ void kmean_item(int item, const bf16_t* Kimg, bf16_t* kmean, int lane) {
    const int blk = item & 31, bh = item >> 5;
    const bf16_t* img = Kimg + ((size_t)bh * 128 + blk * 4) * 4096;
    const int kl = lane >> 3, cc = lane & 7;
    float s0 = 0.f, s1 = 0.f, s2 = 0.f, s3 = 0.f, s4 = 0.f, s5 = 0.f, s6 = 0.f, s7 = 0.f;
#pragma unroll 8
    for (int it = 0; it < 32; ++it) {
        const int key = it * 8 + kl;
        const u32x4 v = *(const u32x4*)(img + ((size_t)((key >> 6) * 8 + cc) * 64 + (key & 63)) * 8);
        s0 += bflo(v.x); s1 += bfhi(v.x); s2 += bflo(v.y); s3 += bfhi(v.y); s4 += bflo(v.z); s5 += bfhi(v.z); s6 += bflo(v.w); s7 += bfhi(v.w);
    }
#pragma unroll
    for (int o = 8; o < 64; o <<= 1) { s0 += __shfl_xor(s0, o); s1 += __shfl_xor(s1, o); s2 += __shfl_xor(s2, o); s3 += __shfl_xor(s3, o); s4 += __shfl_xor(s4, o); s5 += __shfl_xor(s5, o); s6 += __shfl_xor(s6, o); s7 += __shfl_xor(s7, o); }
    if (lane < 8) { const float k = 1.f / 256.f; u32x4 w; w.x = cvtpk(s0 * k, s1 * k); w.y = cvtpk(s2 * k, s3 * k); w.z = cvtpk(s4 * k, s5 * k); w.w = cvtpk(s6 * k, s7 * k); *(u32x4*)(kmean + (size_t)item * 64 + cc * 8) = w; }
}
__device__ __forceinline__ int src_main(int n) {
    int base, j, kind;
    if (n < 384) { base = 0; j = n; kind = 1; } else if (n < 768) { base = 384; j = n - 384; kind = 1; } else if (n < 1152) { base = 1152; j = n - 768; kind = 0; }
    else if (n < 1408) { base = 1536; j = n - 1152; kind = 2; } else if (n < 1664) { base = 1792; j = n - 1408; kind = 2; } else if (n < 1920) { base = 2304; j = n - 1664; kind = 0; }
    else if (n < 2304) { base = 2560; j = n - 1920; kind = 0; } else if (n < 2688) { base = 2944; j = n - 2304; kind = 0; } else { base = 3712; j = n - 2688; kind = 0; }
    if (kind == 1) { const int d = j & 63; if (d < 16) j = (j & ~63) + ((d & 1) ? 8 + (d >> 1) : (d >> 1)); }
    else if (kind == 2) { const int d = j & 31; if (d < 8) j = (j & ~31) + ((d & 1) ? 4 + (d >> 1) : (d >> 1)); }
    return base + j;
}
__device__ __forceinline__ int src_v(int n) { return n < 384 ? 768 + n : (n < 640 ? 2048 + (n - 384) : 3328 + (n - 640)); }
__device__ __forceinline__ void transpose_item(const float* W, int K, int Nsrc, bf16_t* WT, int Ndst, int mode, int coloff, LAS float* scr, int item, int lane, const float* gain) {
    const int nblk = Ndst / 32, kb = item / nblk, nb = item % nblk, k0 = 64 * kb, n0 = 32 * nb;
    const int nn = n0 + (lane & 31); const int sc = (mode == 1) ? src_main(nn) : ((mode == 2) ? src_v(nn) : coloff + nn);
#pragma unroll 16
    for (int i = 0; i < 32; ++i) { const int kk = 2 * i + (lane >> 5); const float gk = gain ? gain[k0 + kk] : 1.f; scr[kk * 33 + (lane & 31)] = W[(size_t)(k0 + kk) * Nsrc + sc] * gk; }
    asm volatile("s_waitcnt lgkmcnt(0)" ::: "memory");
    const int cc = lane & 7;
#pragma unroll
    for (int j = 0; j < 4; ++j) { const int n = (lane >> 3) + 8 * j; const LAS float* s = scr + (8 * cc) * 33 + n;
        u32x4 o; o.x = cvtpk(s[0 * 33], s[1 * 33]); o.y = cvtpk(s[2 * 33], s[3 * 33]); o.z = cvtpk(s[4 * 33], s[5 * 33]); o.w = cvtpk(s[6 * 33], s[7 * 33]);
        *(u32x4*)(WT + (size_t)(n0 + n) * K + k0 + 8 * cc) = o; }
    asm volatile("s_waitcnt lgkmcnt(0)" ::: "memory");
}
__device__ __forceinline__ void rope_cs(float pos, float chi, float clo, float& cs, float& sn) {
    const float h = pos * chi; float lo = fmaf(pos, chi, -h); lo = fmaf(pos, clo, lo);
    const float fr = (h - floorf(h)) + lo;
    cs = __builtin_amdgcn_cosf(fr); sn = __builtin_amdgcn_sinf(fr);
}

struct Args { const float* in[17]; float* out; unsigned char* ws; int ph_lo, ph_hi; };

__device__ __forceinline__ void prologue(const Args& a, LAS unsigned char* lds, int tid, int lane, int wid) {
    unsigned char* ws = a.ws;
    const int G = gridDim.x, gw = blockIdx.x * 8 + wid, NGW = G * 8;
    LAS float* scr = (LAS float*)(lds + wid * 16384);
    bf16_t* Wb = (bf16_t*)(ws + WS_W);
    constexpr int I_MAIN = 16 * 96, I_V = 16 * 32, I_OUT = 16 * 32, I_XQ = 16 * 16, I_XK = 16 * 16, I_XV = 16 * 16, I_XO = 8 * 32, I_L = I_MAIN + I_V + I_OUT + I_XQ + I_XK + I_XV + I_XO;
    for (int it = gw; it < 2 * I_L; it += NGW) {
        const int l = it / I_L; int r = it % I_L; bf16_t* W = Wb + (size_t)l * W_LAYER;
        const float* w_in = a.in[4] + (size_t)l * 1024 * 4096; const float* w_out = a.in[5] + (size_t)l * 1024 * 1024;
        const float* w_xq = a.in[13] + (size_t)l * 1024 * 512; const float* w_xkv = a.in[14] + (size_t)l * 1024 * 1024; const float* w_xo = a.in[15] + (size_t)l * 512 * 1024;
        if (r < I_MAIN) { transpose_item(w_in, 1024, 4096, W + W_MAIN, 3072, 1, 0, scr, r, lane, a.in[3] + l * DM); continue; } r -= I_MAIN;
        if (r < I_V) { transpose_item(w_in, 1024, 4096, W + W_V, 1024, 2, 0, scr, r, lane, a.in[3] + l * DM); continue; } r -= I_V;
        if (r < I_OUT) { transpose_item(w_out, 1024, 1024, W + W_OUT, 1024, 0, 0, scr, r, lane, nullptr); continue; } r -= I_OUT;
        if (r < I_XQ) { transpose_item(w_xq, 1024, 512, W + W_XQ, 512, 0, 0, scr, r, lane, a.in[11] + l * DM); continue; } r -= I_XQ;
        if (r < I_XK) { transpose_item(w_xkv, 1024, 1024, W + W_XK, 512, 0, 0, scr, r, lane, nullptr); continue; } r -= I_XK;
        if (r < I_XV) { transpose_item(w_xkv, 1024, 1024, W + W_XV, 512, 0, 512, scr, r, lane, nullptr); continue; } r -= I_XV;
        transpose_item(w_xo, 512, 1024, W + W_XO, 1024, 0, 0, scr, r, lane, nullptr);
    }
    {
        const float* x = a.in[0]; bf16_t* hb = (bf16_t*)(ws + WS_HB); float* ssq = (float*)(ws + WS_SSQ);
        for (int row = gw; row < TT; row += 2 * NGW) {
            const int row2 = row + NGW;
            const f32x4* xr = (const f32x4*)(x + (size_t)row * DM) + lane; const f32x4* xr2 = (const f32x4*)(x + (size_t)row2 * DM) + lane;
            f32x4 v[4], v2[4];
#pragma unroll
            for (int j = 0; j < 4; ++j) { v[j] = xr[64 * j]; v2[j] = xr2[64 * j]; }
            float s = 0.f, s2 = 0.f; u32x2* o8 = (u32x2*)(hb + (size_t)row * DM) + lane; u32x2* o82 = (u32x2*)(hb + (size_t)row2 * DM) + lane;
#pragma unroll
            for (int j = 0; j < 4; ++j) {
                u32x2 w; w.x = cvtpk(v[j].x, v[j].y); w.y = cvtpk(v[j].z, v[j].w); o8[64 * j] = w;
                { const float r0 = bflo(w.x), r1 = bfhi(w.x), r2 = bflo(w.y), r3 = bfhi(w.y); s += (r0 * r0 + r1 * r1) + (r2 * r2 + r3 * r3); }
                u32x2 w2; w2.x = cvtpk(v2[j].x, v2[j].y); w2.y = cvtpk(v2[j].z, v2[j].w); o82[64 * j] = w2;
                { const float r0 = bflo(w2.x), r1 = bfhi(w2.x), r2 = bflo(w2.y), r3 = bfhi(w2.y); s2 += (r0 * r0 + r1 * r1) + (r2 * r2 + r3 * r3); }
            }
            s = wave_sum(s); s2 = wave_sum(s2);
            if (lane < 4) { ssq[(size_t)row * 4 + lane] = (lane == 0) ? s : 0.f; ssq[(size_t)row2 * 4 + lane] = (lane == 0) ? s2 : 0.f; }
        }
    }
    for (int it = gw; it < 2 * 1024; it += NGW) {
        const int l = it >> 10, row = it & 1023; const float* g = a.in[12] + l * DM; bf16_t* mo = (bf16_t*)(ws + WS_MEMN) + (size_t)l * 1024 * 1024 + (size_t)row * DM;
        const f32x4* xr = (const f32x4*)(a.in[1] + (size_t)row * DM) + lane; f32x4 v[4]; float s = 0.f;
#pragma unroll
        for (int j = 0; j < 4; ++j) { v[j] = xr[64 * j]; s += (v[j].x * v[j].x + v[j].y * v[j].y) + (v[j].z * v[j].z + v[j].w * v[j].w); }
        const float ri = __builtin_amdgcn_rsqf(wave_sum(s) * (1.f / 1024.f) + RMS_EPS);
#pragma unroll
        for (int j = 0; j < 4; ++j) { const f32x4 gg = *((const f32x4*)g + lane + 64 * j); u32x2 w; w.x = cvtpk(v[j].x * ri * gg.x, v[j].y * ri * gg.y); w.y = cvtpk(v[j].z * ri * gg.z, v[j].w * ri * gg.w); *((u32x2*)mo + lane + 64 * j) = w; }
    }
    {
        const int gt = blockIdx.x * 512 + tid;
        constexpr float ROPE64_HI[8] = {1.591549367e-01f, 3.086376376e-02f, 5.985185504e-03f, 1.160663669e-03f, 2.250790858e-04f, 4.364795313e-05f, 8.464330676e-06f, 1.641426252e-06f};
        constexpr float ROPE64_LO[8] = {6.420638327e-09f, -3.597993882e-10f, 2.087540496e-10f, -2.775752479e-11f, -6.755000964e-12f, -3.416928741e-13f, 1.318804142e-13f, 1.098673667e-14f};
        for (int tk = gt; tk < TT; tk += G * 512) {
            const float pos = (float)((const int*)a.in[2])[tk]; float* c64 = (float*)(ws + WS_CS64) + (size_t)tk * 16; float* c32 = (float*)(ws + WS_CS32) + (size_t)tk * 8;
#pragma unroll
            for (int i = 0; i < 8; ++i) { float cs, sn; rope_cs(pos, ROPE64_HI[i], ROPE64_LO[i], cs, sn); c64[2 * i] = cs; c64[2 * i + 1] = sn; }
#pragma unroll
            for (int i = 0; i < 4; ++i) { float cs, sn; rope_cs(pos, ROPE64_HI[2 * i], ROPE64_LO[2 * i], cs, sn); c32[2 * i] = cs; c32[2 * i + 1] = sn; }
        }
    }
    if (blockIdx.x == 0 && wid == 0) {
        int* ctl = (int*)(ws + WS_CTL);
        if (lane < 16) ctl[lane] = 0;
#pragma unroll
        for (int l = 0; l < 2; ++l) {
            float p1 = 0.f, p2 = 0.f;
            if (lane < 32) { p1 = a.in[6][l * 32 + lane] * a.in[7][l * 32 + lane]; p2 = a.in[8][l * 32 + lane] * a.in[9][l * 32 + lane]; }
            p1 = wave_sum(p1); p2 = wave_sum(p2);
            const float li = 0.8f - 0.6f * expf(-0.3f * (float)l);
            if (lane == 0) { ((float*)ctl)[16 + 2 * l] = expf(p1) - expf(p2) + li; ((float*)ctl)[17 + 2 * l] = 1.f - li; }
        }
    }
}

__device__ __forceinline__ void final_norm(const Args& a, int lane, int wid) {
    const int gw = blockIdx.x * 8 + wid, NGW = gridDim.x * 8; const float* ssq = (const float*)(a.ws + WS_SSQ); const float* g = a.in[16]; const bf16_t* hb = (const bf16_t*)(a.ws + WS_HB);
    f32x4 gv[2][2];
#pragma unroll
    for (int j = 0; j < 2; ++j) { gv[j][0] = *(const f32x4*)(g + 512 * j + lane * 8); gv[j][1] = *(const f32x4*)(g + 512 * j + lane * 8 + 4); }
    for (int row0 = gw; row0 < TT; row0 += 2 * NGW) {
        u32x4 v[2][2]; float ri[2];
#pragma unroll
        for (int q = 0; q < 2; ++q) { const int row = row0 + q * NGW; ri[q] = rinv_row(ssq, row);
#pragma unroll
            for (int j = 0; j < 2; ++j) v[q][j] = *(const u32x4*)(hb + (size_t)row * DM + 512 * j + lane * 8); }
#pragma unroll
        for (int q = 0; q < 2; ++q)
#pragma unroll
            for (int j = 0; j < 2; ++j) {
                const u32x4 w = v[q][j];
                f32x4 o0, o1; o0.x = bflo(w.x); o0.y = bfhi(w.x); o0.z = bflo(w.y); o0.w = bfhi(w.y); o1.x = bflo(w.z); o1.y = bfhi(w.z); o1.z = bflo(w.w); o1.w = bfhi(w.w);
                float* op = a.out + (size_t)(row0 + q * NGW) * DM + 512 * j + lane * 8;
                *(f32x4*)op = o0 * ri[q] * gv[j][0]; *(f32x4*)(op + 4) = o1 * ri[q] * gv[j][1];
            }
    }
}

__device__ __forceinline__ int pi32(int r) { return (r & ~12) | ((r & 4) << 1) | ((r & 8) >> 1); }
constexpr int N_PHASES = 12;
#ifndef PROBE_MIX
#define PROBE_MIX 0
#endif
#ifndef PH_MASK
#define PH_MASK 0x1FF
#endif
__device__ __forceinline__ bf16_t* wlayer(const Args& a, int l) { return (bf16_t*)(a.ws + WS_W) + (size_t)l * W_LAYER; }
__device__ __forceinline__ void make_ctx(ACtx& c, LAS unsigned char* lds) {
    const int tid = tid_opaque(), lane = tid & 63;
    c.tid = tid; c.lane = lane; c.wid = __builtin_amdgcn_readfirstlane(tid >> 6); c.r32 = lane & 31; c.hi = lane >> 5; c.r32p = pi32(lane & 31); c.lds = lds;
}
__device__ __forceinline__ void phase_in(const Args& a, LAS unsigned char* lds, int l) {
    const int G = grid_opaque(), bid = bid_opaque(); unsigned char* ws = a.ws;
    { pg8::Gemm g{(const bf16_t*)(ws + WS_HB), wlayer(a, l) + W_MAIN, TT, 3072, 1024}; pg8::StaticOrder S; S.init(TT, 3072, G, bid);
      EpiIn E{(bf16_t*)(ws + WS_P), (const float*)(ws + WS_SSQ), (const float*)(ws + WS_CS64), (const float*)(ws + WS_CS32), (bf16_t*)(ws + WS_KIMG), (float*)(ws + WS_KMEAN), (bf16_t*)a.out, (bf16_t*)a.out + (size_t)16 * 1024 * 1024};
      pg8::gemm_phase<EpiIn, pg8::StaticOrder, true, true>(lds, g, S, E); }
    { pg8::Gemm g{wlayer(a, l) + W_V, (const bf16_t*)(ws + WS_HB), 1024, TT, 1024}; pg8::StaticOrder S; S.init(1024, TT, G, bid);
      EpiVt E{(bf16_t*)(ws + WS_VT), (const float*)(ws + WS_SSQ)};
      pg8::gemm_phase<EpiVt, pg8::StaticOrder, true, true>(lds, g, S, E); }
}
__device__ __forceinline__ void phase_kmean(const Args& a, LAS unsigned char* lds, int l) {
    const int G = grid_opaque(), bid = bid_opaque(), tid_ = tid_opaque(), lane = tid_ & 63, wid = __builtin_amdgcn_readfirstlane(tid_ >> 6); unsigned char* ws = a.ws;
    for (int it = bid * 8 + wid; it < 768; it += G * 8) kmean_item(it, (const bf16_t*)(ws + WS_KIMG), (bf16_t*)(ws + WS_KMEAN), lane);
    bf16_t* memn = (bf16_t*)(ws + WS_MEMN) + (size_t)l * 1024 * 1024; bf16_t* kx = (bf16_t*)(ws + WS_KX) + (size_t)l * 1024 * 512; bf16_t* vxt = (bf16_t*)(ws + WS_VXT) + (size_t)l * 512 * 1024;
#pragma unroll 1
    for (int j = 0; j < 2; ++j) {
        pg8::Gemm g; g.A = j ? (wlayer(a, l) + W_XV) : memn; g.Bt = j ? memn : (wlayer(a, l) + W_XK); g.M = j ? 512 : 1024; g.N = j ? 1024 : 512; g.K = 1024;
        pg8::StaticOrder S; S.init(g.M, g.N, G, (bid + G - 8 - 16 * j) % G); EpiB16 E{j ? vxt : kx, j ? 1024 : 512, nullptr, 1.f};
        pg8::gemm_phase<EpiB16, pg8::StaticOrder, true, true>(lds, g, S, E);
    }
}
struct OneUnit {
    Unit u;
    __device__ __forceinline__ bool next(int i, Unit& o) const { if (i) return false; o = u; return true; }
    __device__ __forceinline__ void a_ready(const Unit&) const {}
    __device__ __forceinline__ void done(const Unit&) const {}
};
#ifndef MIX_TYPES
#define MIX_TYPES 7
#endif
__device__ __forceinline__ void phase_mix(const Args& a, LAS unsigned char* lds, int l, int rep, int types) {
    volatile LAS int* wq = (volatile LAS int*)(lds + LDS_MISC);
    const int x0 = (int)((unsigned)__builtin_amdgcn_s_getreg((3 << 11) | 20) & 7u);
    int nq = 0;
    for (;;) {
        unsigned char* ws = a.ws; asm volatile("" : "+s"(ws));
        int* ctl = (int*)(ws + WS_CTL);
        const bf16_t* P = (const bf16_t*)(ws + WS_P); const bf16_t* Vt = (const bf16_t*)(ws + WS_VT); bf16_t* mrg = (bf16_t*)(ws + WS_MRG);
        ACtx c; make_ctx(c, lds);
        const int q = (x0 + nq) & 7;
        if (c.tid == 0) *wq = __hip_atomic_fetch_add(ctl + 32 + (l * 2 + rep) * 8 + q, 1, __ATOMIC_RELAXED, __HIP_MEMORY_SCOPE_AGENT);
        __syncthreads();
        const int i = __builtin_amdgcn_readfirstlane(*wq);
        __syncthreads();
        if (i >= 258) { if (++nq >= 8) break; continue; }
        if (i >= 256) {
            const int it = (i - 256) + 2 * q, j = it >> 3, uu = it & 7;
            bf16_t* memn = (bf16_t*)(ws + WS_MEMN) + (size_t)l * 1024 * 1024;
            pg8::Gemm g; g.A = j ? (wlayer(a, l) + W_XV) : memn; g.Bt = j ? memn : (wlayer(a, l) + W_XK); g.M = j ? 512 : 1024; g.N = j ? 1024 : 512; g.K = 1024;
            OneUnit S; S.u.pm = j ? (uu & 1) : (uu & 3); S.u.pn = j ? (uu >> 1) : (uu >> 2);
            EpiB16 E{j ? ((bf16_t*)(ws + WS_VXT) + (size_t)l * 512 * 1024) : ((bf16_t*)(ws + WS_KX) + (size_t)l * 1024 * 512), j ? 1024 : 512, nullptr, 1.f};
            pg8::gemm_phase<EpiB16, OneUnit, true, true>(lds, g, S, E);
            __syncthreads();
            continue;
        }
        int type, bh, qb;
        if (i < 56) { type = 0; qb = 31 - (i >> 1); bh = q + 8 * (i & 1); }
        else if (i < 152) { const int j = i - 56; type = 1; qb = 31 - j / 3; bh = q + 8 * (j % 3); }
        else if (i < 160) { const int j = i - 152; type = 0; qb = 3 - (j >> 1); bh = q + 8 * (j & 1); }
        else { const int j = i - 160; type = 2; qb = 31 - j / 3; bh = q + 8 * (j % 3); }
        if (type == 0) { if (types & 1) diff_unit(c, bh >> 2, bh & 3, qb, P, (const bf16_t*)a.out + (size_t)16 * 1024 * 1024, Vt + (size_t)384 * TT, mrg, ((const float*)ctl)[16 + 2 * l], ((const float*)ctl)[17 + 2 * l], a.in[10] + l * 64); }
        else if (type == 1) { if (types & 2) moba_unit(c, bh / 6, bh % 6, qb, P, (const bf16_t*)(ws + WS_KIMG), Vt, (const float*)(ws + WS_KMEAN), mrg); }
        else if (types & 4) sb_unit(c, bh / 6, bh % 6, qb, P, (const bf16_t*)a.out, Vt + (size_t)640 * TT, mrg);
    }
}
__device__ __forceinline__ void phase_res(const Args& a, LAS unsigned char* lds, int l, bool o) {
    unsigned char* ws = a.ws;
    pg8::Gemm g; g.A = (const bf16_t*)(ws + (o ? WS_MRG : WS_OX)); g.Bt = wlayer(a, l) + (o ? W_OUT : W_XO); g.M = TT; g.N = 1024; g.K = o ? 1024 : 512;
    pg8::StaticOrder S; S.init(TT, 1024, grid_opaque(), bid_opaque());
    EpiRes E; E.h = (bf16_t*)(ws + WS_HB); E.ssq = (float*)(ws + WS_SSQ);
    E.red = (LAS float*)(lds + LDS_RED); E.tid = tid_opaque();
    pg8::gemm_phase<EpiRes, pg8::StaticOrder, true, true>(lds, g, S, E);
}
__device__ __forceinline__ void phase_xq(const Args& a, LAS unsigned char* lds, int l) {
    unsigned char* ws = a.ws;
    pg8::Gemm g{(const bf16_t*)(ws + WS_HB), wlayer(a, l) + W_XQ, TT, 512, 1024}; pg8::StaticOrder S; S.init(TT, 512, grid_opaque(), bid_opaque());
    EpiB16 E{(bf16_t*)(ws + WS_QX), 512, (const float*)(ws + WS_SSQ), 0.08838834764831845f * LOG2E};
    pg8::gemm_phase<EpiB16, pg8::StaticOrder, true, true>(lds, g, S, E);
    asm volatile("s_waitcnt vmcnt(0)" ::: "memory");
    __syncthreads();
    Unit u;
    if (S.next(0, u)) {
        ACtx c; make_ctx(c, lds);
        const bf16_t* kx = (const bf16_t*)(ws + WS_KX) + (size_t)l * 1024 * 512; const bf16_t* vxt = (const bf16_t*)(ws + WS_VXT) + (size_t)l * 512 * 1024;
#pragma unroll 1
        for (int hh = 0; hh < 2; ++hh) xattn_unit(c, u.pm >> 5, 2 * u.pn + hh, u.pm & 31, (const bf16_t*)(ws + WS_QX), kx, vxt, (bf16_t*)(ws + WS_OX));
    }
}
__device__ __forceinline__ void phase_xattn(const Args& a, LAS unsigned char* lds, int l) {
    unsigned char* ws = a.ws; ACtx c; make_ctx(c, lds);
    const bf16_t* kx = (const bf16_t*)(ws + WS_KX) + (size_t)l * 1024 * 512; const bf16_t* vxt = (const bf16_t*)(ws + WS_VXT) + (size_t)l * 512 * 1024;
    for (int i = bid_opaque(); i < 512; i += grid_opaque()) { const int qb = i & 31, bh = i >> 5; xattn_unit(c, bh >> 2, bh & 3, qb, (const bf16_t*)(ws + WS_QX), kx, vxt, (bf16_t*)(ws + WS_OX)); }
}
#define XB_TMO      128
#define XB_XCNT(j)  (256  + 64 * (j))
#define XB_XSUB(j)  (1280 + 64 * (j))
#define XB_XGEN(j)  (2304 + 64 * (j))
#define XB_TOP      3328
#define XB_TOPGEN   3392
#define XCD_BAR_WORDS 3456
#define XB_SPIN_CAP (1u << 18)

__device__ __forceinline__ unsigned xb_ld(unsigned* p)              { return __hip_atomic_load(p, __ATOMIC_RELAXED, __HIP_MEMORY_SCOPE_AGENT); }
__device__ __forceinline__ unsigned xb_add(unsigned* p, unsigned v) { return __hip_atomic_fetch_add(p, v, __ATOMIC_RELAXED, __HIP_MEMORY_SCOPE_AGENT); }
__device__ __forceinline__ unsigned xb_xcc_id() { return (unsigned)__builtin_amdgcn_s_getreg((3 << 11) | 20) & 0xFu; }
#define XB_SPIN(cond, bar) do { unsigned _sp = 0; while (cond) { __builtin_amdgcn_s_sleep(1); \
    if ((++_sp & 255u) == 0u) { if (xb_ld(&(bar)[XB_TMO])) break; if (_sp > XB_SPIN_CAP) { atomicAdd(&(bar)[XB_TMO], 1u); break; } } } } while (0)

struct XcdBarrier {
    unsigned* bar; unsigned x;
    volatile LAS unsigned* st;
};

__device__ __forceinline__ XcdBarrier xcd_barrier_post(unsigned* bar, volatile LAS unsigned* st) {
    XcdBarrier b; b.bar = bar; b.x = xb_xcc_id(); b.st = st;
    if (threadIdx.x == 0) (void)xb_add(&bar[XB_XCNT(b.x)], 1u);
    return b;
}
__device__ __forceinline__ void xcd_barrier_complete(unsigned* bar, unsigned x, unsigned& nloc, unsigned& nx) {
    const unsigned G = gridDim.x * gridDim.y * gridDim.z;
    unsigned sum, cnt, mine, sp = 0u;
    for (;;) {
        sum = 0u; cnt = 0u; mine = 0u;
#pragma unroll
        for (unsigned j = 0; j < 16; ++j) { const unsigned c = xb_ld(&bar[XB_XCNT(j)]); sum += c; cnt += (c > 0u) ? 1u : 0u; mine = (j == x) ? c : mine; }
        if (sum == G) break;
        __builtin_amdgcn_s_sleep(1);
        if ((++sp & 255u) == 0u) { if (xb_ld(&bar[XB_TMO])) break; if (sp > XB_SPIN_CAP) { atomicAdd(&bar[XB_TMO], 1u); break; } }
    }
    nloc = mine > 0u ? mine : 1u; nx = cnt > 0u ? cnt : 1u;
}

__device__ __forceinline__ void xcd_barrier(const XcdBarrier& b) {
    asm volatile("s_waitcnt vmcnt(0)" ::: "memory");
    __syncthreads();
    if (threadIdx.x == 0) {
        unsigned* bar = b.bar;
        __builtin_amdgcn_s_waitcnt(0);
        unsigned nloc = b.st[0], nx = b.st[1];
        if (nloc == 0u) { xcd_barrier_complete(bar, b.x, nloc, nx); b.st[0] = nloc; b.st[1] = nx; }
        const unsigned old = xb_add(&bar[XB_XSUB(b.x)], 1u);
        const unsigned gen = old / nloc;
        if (old + 1u == (gen + 1u) * nloc) {
            __builtin_amdgcn_fence(__ATOMIC_RELEASE, "agent");
            asm volatile("s_waitcnt vmcnt(0)" ::: "memory");
            const unsigned og = xb_add(&bar[XB_TOP], 1u);
            const unsigned tg = og / nx;
            if (og + 1u == (tg + 1u) * nx) xb_add(&bar[XB_TOPGEN], 1u);
            else XB_SPIN(xb_ld(&bar[XB_TOPGEN]) == tg, bar);
            __builtin_amdgcn_fence(__ATOMIC_ACQUIRE, "agent");
            xb_add(&bar[XB_XGEN(b.x)], 1u);
            asm volatile("s_waitcnt vmcnt(0)" ::: "memory");
        } else {
            XB_SPIN(xb_ld(&bar[XB_XGEN(b.x)]) == gen, bar);
            __builtin_amdgcn_fence(__ATOMIC_ACQUIRE, "agent");
            asm volatile("s_waitcnt vmcnt(0)" ::: "memory");
        }
    }
    __syncthreads();
}


__device__ __forceinline__ void grid_bar(unsigned* bar, unsigned k) {
    asm volatile("s_waitcnt vmcnt(0)" ::: "memory");
    __syncthreads();
    if (threadIdx.x == 0) {
        __builtin_amdgcn_fence(__ATOMIC_RELEASE, "agent");
        asm volatile("s_waitcnt vmcnt(0)" ::: "memory");
        const unsigned G = gridDim.x, g = blockIdx.x & 7u, ng = (G - g + 7u) >> 3;
        unsigned* sub = bar + 64 * (1 + g); unsigned* gen = bar + 64 * (9 + g); unsigned* top = bar + 64 * 17;
        const unsigned old = __hip_atomic_fetch_add(sub, 1u, __ATOMIC_RELAXED, __HIP_MEMORY_SCOPE_AGENT);
        if (old + 1u == k * ng) {
            const unsigned oldt = __hip_atomic_fetch_add(top, 1u, __ATOMIC_RELAXED, __HIP_MEMORY_SCOPE_AGENT);
            if (oldt + 1u == k * 8u) {
#pragma unroll
                for (int gg = 0; gg < 8; ++gg) __hip_atomic_store(bar + 64 * (9 + gg), k, __ATOMIC_RELAXED, __HIP_MEMORY_SCOPE_AGENT);
            }
        }
        while (__hip_atomic_load(gen, __ATOMIC_RELAXED, __HIP_MEMORY_SCOPE_AGENT) < k) __builtin_amdgcn_s_sleep(2);
        __builtin_amdgcn_fence(__ATOMIC_ACQUIRE, "agent");
        asm volatile("s_waitcnt vmcnt(0)" ::: "memory");
    }
    __syncthreads();
}
__global__ void __launch_bounds__(512, 2) fwd_kernel(Args a) {
    extern __shared__ __attribute__((aligned(16))) unsigned char lds_raw[];
    LAS unsigned char* lds = (LAS unsigned char*)lds_raw;
    volatile LAS unsigned* xst = (volatile LAS unsigned*)(lds + LDS_MISC + 256);
    if (threadIdx.x == 0) { xst[0] = 0u; xst[1] = 0u; }
    __syncthreads();
    XcdBarrier xbar = xcd_barrier_post((unsigned*)(a.ws + WS_CTL) + 1024, xst);
#pragma unroll 1
    for (int ph = a.ph_lo; ph < a.ph_hi; ++ph) {
        if (ph == 0) { const int t_ = tid_opaque(); prologue(a, lds, t_, t_ & 63, __builtin_amdgcn_readfirstlane(t_ >> 6)); }
        else if (ph == N_PHASES - 1) { const int t_ = tid_opaque(); final_norm(a, t_ & 63, __builtin_amdgcn_readfirstlane(t_ >> 6)); }
        else {
            const int l = (ph - 1) / 5, r = (ph - 1) % 5;
            if (r == 0) { if (PH_MASK & 1) phase_in(a, lds, l); }
            else if (r == 1) { phase_mix(a, lds, l, 0, MIX_TYPES);
#if PROBE_MIX
                __syncthreads(); phase_mix(a, lds, l, 1, PROBE_MIX);
#endif
            }
            else if (r == 2 || r == 4) { if (PH_MASK & 8) phase_res(a, lds, l, r == 2); }
            else { if (PH_MASK & 16) phase_xq(a, lds, l); }
        }
        if (ph + 1 < a.ph_hi) {
            if (a.ph_hi > 4096) cg::this_grid().sync();
            xcd_barrier(xbar);
        }
    }
}

#ifndef MK_PER_PHASE
#define MK_PER_PHASE 0
#endif
extern "C" void kernel_launch(void* const* d_in, const int* in_sizes, int n_in, void* d_out, int out_size, void* d_ws, size_t ws_size, hipStream_t stream) {
    static int grid = 0;
    if (grid == 0) {
        if (n_in != 17 || out_size != TT * DM || ws_size < WS_END) { fprintf(stderr, "kernel_launch: unexpected shapes (n_in %d out %d ws %zu)\n", n_in, out_size, ws_size); grid = -1; return; }
        int dev = 0, cus = 0, per_cu = 0;
        if (hipGetDevice(&dev) != hipSuccess || hipDeviceGetAttribute(&cus, hipDeviceAttributeMultiprocessorCount, dev) != hipSuccess) { grid = -1; return; }
        if (hipFuncSetAttribute((const void*)fwd_kernel, hipFuncAttributeMaxDynamicSharedMemorySize, LDS_BYTES) != hipSuccess) { fprintf(stderr, "kernel_launch: hipFuncSetAttribute failed\n"); grid = -1; return; }
        if (hipOccupancyMaxActiveBlocksPerMultiprocessor(&per_cu, (const void*)fwd_kernel, 512, LDS_BYTES) != hipSuccess || per_cu < 1) { fprintf(stderr, "kernel_launch: occupancy query says %d\n", per_cu); (void)hipGetLastError(); }
        grid = cus;
    }
    if (grid < 0) return;
    Args a{};
    for (int i = 0; i < 17; ++i) a.in[i] = (const float*)d_in[i];
    a.out = (float*)d_out; a.ws = (unsigned char*)d_ws;
#if MK_PER_PHASE
    for (int ph = 0; ph < N_PHASES; ++ph) { a.ph_lo = ph; a.ph_hi = ph + 1; hipLaunchKernelGGL(fwd_kernel, dim3(grid), dim3(512), LDS_BYTES, stream, a); }
#else
    a.ph_lo = 0; a.ph_hi = N_PHASES;
    (void)hipMemsetAsync(d_ws, 0, 32768, stream);
    void* args[] = {&a};
    hipError_t e = hipLaunchCooperativeKernel((const void*)fwd_kernel, dim3(grid), dim3(512), args, LDS_BYTES, stream);
    if (e != hipSuccess) fprintf(stderr, "kernel_launch: cooperative launch failed: %s (grid %d)\n", hipGetErrorString(e), grid);
#endif
}
```

```cpp
#include <hip/hip_runtime.h>
#include <hip/hip_cooperative_groups.h>
#include <cstdio>
#include <cstdint>
namespace cg = cooperative_groups;
__device__ __forceinline__ int tid_opaque() { int t = threadIdx.x; asm volatile("" : "+v"(t)); return t; }
__device__ __forceinline__ int bid_opaque() { int b = blockIdx.x; asm volatile("" : "+s"(b)); return b; }
__device__ __forceinline__ int grid_opaque() { int b = gridDim.x; asm volatile("" : "+s"(b)); return b; }
namespace pg8 {
#define PG8_LAS __attribute__((address_space(3)))
typedef unsigned short bf16_t;
typedef short bf16x8 __attribute__((ext_vector_type(8)));
typedef float f32x4 __attribute__((ext_vector_type(4)));
typedef unsigned u32x4 __attribute__((ext_vector_type(4)));
constexpr int BM = 256, BK = 64, HALF = 128, HTB = HALF * BK * 2  , STAGE_BYTES = 8 * HTB, NXCD = 8, WGM = 8;

__host__ __device__ __forceinline__ int lds_byte(int r, int c) { const int st = (r >> 4) * 2 + (c >> 5), rr = r & 15, cc = c & 31, ob = rr * 64 + cc * 2; return st * 1024 + (ob ^ (((ob >> 9) & 1) << 5)); }
__host__ __device__ __forceinline__ void stage_rc(int b, int& R, int& C) { const int st = b / 1024, sb = b % 1024, swz = sb ^ (((sb >> 9) & 1) << 5); R = (st >> 1) * 16 + swz / 64; C = (st & 1) * 32 + (swz % 64) / 2; }
__host__ __device__ __forceinline__ int perm32(int rho) { const int n = rho >> 4, i = rho & 15; return 8 * (i >> 2) + 4 * n + (i & 3); }

struct Unit { int pm, pn; };
struct Gemm { const bf16_t* A; const bf16_t* Bt; int M, N, K; };

struct StaticOrder {
    int nM, nN, nwg, G, c;
    __host__ __device__ void init(int M, int N, int G_, int c_) { nM = M / BM; nN = N / BM; nwg = nM * nN; G = G_; c = c_; }
    __host__ __device__ bool next(int i, Unit& u) const {
        const long L = (long)i * G + c; if (L >= nwg) return false;
        int wgid = (int)L; { const int q = nwg / NXCD, r = nwg % NXCD, xcd = wgid % NXCD, off = wgid / NXCD; wgid = (xcd < r ? xcd * (q + 1) : r * (q + 1) + (xcd - r) * q) + off; }
        const int nig = WGM * nN, gid = wgid / nig, fm = gid * WGM, gsz = (nM - fm) < WGM ? (nM - fm) : WGM;
        u.pm = fm + ((wgid % nig) % gsz); u.pn = (wgid % nig) / gsz; return true;
    }
    __device__ __forceinline__ void a_ready(const Unit&) const {}
    __device__ __forceinline__ void done(const Unit&) const {}
};

__device__ __forceinline__ unsigned cvt_pk_bf16(float lo, float hi) { unsigned r; asm volatile("v_cvt_pk_bf16_f32 %0, %1, %2" : "=v"(r) : "v"(lo), "v"(hi)); return r; }
typedef float f32x2 __attribute__((ext_vector_type(2)));
template <class Epi, class Sched, bool ALIGN_EPI = false, bool SP2 = false>
__device__ __forceinline__ void gemm_phase(PG8_LAS unsigned char* lds, const Gemm g, const Sched& S, const Epi& E) {
    const int tid = tid_opaque(), wid = __builtin_amdgcn_readfirstlane(tid >> 6), lane = tid & 63, wr = wid >> 2, wc = wid & 3, fr = lane & 15, fq = lane >> 4;
    const int K = g.K, nt = K / BK;
    unsigned voffA[2], voffB[2];
#pragma unroll
    for (int i = 0; i < 2; ++i) { int R, C; stage_rc(tid * 16 + i * 8192, R, C); const int Rb = Epi::PERM ? ((R & ~31) + perm32(R & 31)) : R;
        voffA[i] = (unsigned)(R * K + C) * 2u; voffB[i] = (unsigned)(Rb * K + C) * 2u; }
    const size_t kstep = (size_t)(BK * 2);
    const size_t hstep = (size_t)HALF * K * 2;
    const size_t tstep = 2 * hstep;
    const unsigned ldsw = (unsigned)wid * 1024u;
    const int aoff = lds_byte(wr * 64 + fr, fq * 8), boff = lds_byte(wc * 32 + fr, fq * 8);
#define PG8_SA(b, h) (((b) * 2 + (h)) * HTB)
#define PG8_SB(b, h) ((4 + (b) * 2 + (h)) * HTB)
#define PG8_STAGE(bufoff, gbase, voff) do { _Pragma("unroll") for (int _i = 0; _i < 2; ++_i) \
        __builtin_amdgcn_global_load_lds((const unsigned*)((const char*)(gbase) + (voff)[_i]), (PG8_LAS unsigned*)(lds + (bufoff) + ldsw + _i * 8192), 16, 0, 0); } while (0)
#define PG8_LDA(dst, b, h) do { _Pragma("unroll") for (int m = 0; m < 4; ++m) _Pragma("unroll") for (int k = 0; k < 2; ++k) dst[m][k] = *(const PG8_LAS bf16x8*)(lds + PG8_SA(b, h) + aoff + m * 2048 + k * 1024); } while (0)
#define PG8_LDB(dst, b, h) do { _Pragma("unroll") for (int n = 0; n < 2; ++n) _Pragma("unroll") for (int k = 0; k < 2; ++k) dst[n][k] = *(const PG8_LAS bf16x8*)(lds + PG8_SB(b, h) + boff + n * 2048 + k * 1024); } while (0)
#define PG8_MMA(ai, bj, At, Bt) do { __builtin_amdgcn_s_setprio(1); _Pragma("unroll") for (int m = 0; m < 4; ++m) _Pragma("unroll") for (int n = 0; n < 2; ++n) _Pragma("unroll") for (int k = 0; k < 2; ++k) \
        acc[ai][bj][m][n] = __builtin_amdgcn_mfma_f32_16x16x32_bf16(Bt[n][k], At[m][k], acc[ai][bj][m][n], 0, 0, 0); __builtin_amdgcn_s_setprio(0); } while (0)
#define PG8_WAIT_V(n) asm volatile("s_waitcnt vmcnt(" #n ")" ::: "memory")
#define PG8_WAIT_L(n) asm volatile("s_waitcnt lgkmcnt(" #n ")" ::: "memory")
#define PG8_BAR __builtin_amdgcn_s_barrier()
#define PG8_SCHED __builtin_amdgcn_sched_barrier(0)
    Unit cur, nxt; int ui = 0;
    if (!S.next(0, cur)) return;
    f32x4 acc[2][2][4][2];
#pragma unroll
    for (int a = 0; a < 2; ++a)
#pragma unroll
        for (int b = 0; b < 2; ++b)
#pragma unroll
            for (int m = 0; m < 4; ++m)
#pragma unroll
                for (int n = 0; n < 2; ++n) acc[a][b][m][n] = (f32x4){0.f, 0.f, 0.f, 0.f};
    bf16x8 At[4][2], B0[2][2], B1[2][2];
    const char* cA = (const char*)g.A + (size_t)cur.pm * tstep; const char* cB = (const char*)g.Bt + (size_t)cur.pn * tstep;
    S.a_ready(cur);
    if constexpr (SP2) {
        PG8_STAGE(PG8_SB(0, 0), cB, voffB); PG8_STAGE(PG8_SB(0, 1), cB + hstep, voffB); PG8_STAGE(PG8_SA(0, 0), cA, voffA); PG8_STAGE(PG8_SA(0, 1), cA + hstep, voffA);
        if (wr == 1) PG8_BAR;
        PG8_WAIT_V(2); PG8_BAR;
        PG8_STAGE(PG8_SB(1, 0), cB + kstep, voffB); PG8_STAGE(PG8_SA(1, 0), cA + kstep, voffA); PG8_STAGE(PG8_SB(1, 1), cB + hstep + kstep, voffB);
        PG8_WAIT_V(6); PG8_BAR;
    } else {
        PG8_STAGE(PG8_SB(0, 0), cB, voffB); PG8_STAGE(PG8_SA(0, 0), cA, voffA); PG8_STAGE(PG8_SB(0, 1), cB + hstep, voffB); PG8_STAGE(PG8_SA(0, 1), cA + hstep, voffA);
        if (wr == 1) PG8_BAR;
        PG8_WAIT_V(4); PG8_BAR;
        PG8_STAGE(PG8_SB(1, 0), cB + kstep, voffB); PG8_STAGE(PG8_SA(1, 0), cA + kstep, voffA); PG8_STAGE(PG8_SB(1, 1), cB + hstep + kstep, voffB);
        PG8_WAIT_V(6); PG8_BAR;
    }
    for (;;) {
        const bool has_next = S.next(ui + 1, nxt);
        const char* nA = has_next ? (const char*)g.A + (size_t)nxt.pm * tstep : cA; const char* nB = has_next ? (const char*)g.Bt + (size_t)nxt.pn * tstep : cB;
        for (int t = 0; t < nt; t += 2) {
            const bool last = (t == nt - 2);
            const char* a1 = cA + (size_t)(t + 1) * kstep;
            const char* a2 = last ? nA : cA + (size_t)(t + 2) * kstep; const char* b2 = last ? nB : cB + (size_t)(t + 2) * kstep;
            const char* a3 = a2 + kstep; const char* b3 = b2 + kstep;
            if (last && has_next) S.a_ready(nxt);
            if constexpr (SP2) {
            PG8_LDB(B0, 0, 0); PG8_LDB(B1, 0, 1); PG8_SCHED; PG8_LDA(At, 0, 0); PG8_STAGE(PG8_SA(1, 1), a1 + hstep, voffA);
            PG8_WAIT_V(8); PG8_WAIT_L(0); PG8_BAR; PG8_MMA(0, 0, At, B0); PG8_MMA(0, 1, At, B1); PG8_BAR; PG8_SCHED;
            PG8_LDA(At, 0, 1); PG8_STAGE(PG8_SB(0, 0), b2, voffB); PG8_STAGE(PG8_SB(0, 1), b2 + hstep, voffB); PG8_STAGE(PG8_SA(0, 0), a2, voffA);
            PG8_WAIT_V(8); PG8_WAIT_L(0); PG8_BAR; PG8_MMA(1, 0, At, B0); PG8_MMA(1, 1, At, B1); PG8_BAR; PG8_SCHED;
            PG8_LDB(B0, 1, 0); PG8_LDB(B1, 1, 1); PG8_SCHED; PG8_LDA(At, 1, 0); PG8_STAGE(PG8_SA(0, 1), a2 + hstep, voffA);
            PG8_WAIT_V(8); PG8_WAIT_L(0); PG8_BAR; PG8_MMA(0, 0, At, B0); PG8_MMA(0, 1, At, B1); PG8_BAR; PG8_SCHED;
            PG8_LDA(At, 1, 1); PG8_STAGE(PG8_SB(1, 0), b3, voffB); PG8_STAGE(PG8_SB(1, 1), b3 + hstep, voffB); PG8_STAGE(PG8_SA(1, 0), a3, voffA);
            PG8_WAIT_V(8); PG8_WAIT_L(0); PG8_BAR; PG8_MMA(1, 0, At, B0); PG8_MMA(1, 1, At, B1); PG8_BAR; PG8_SCHED;
            } else {
            PG8_LDB(B0, 0, 0); PG8_SCHED; PG8_LDA(At, 0, 0); PG8_STAGE(PG8_SA(1, 1), a1 + hstep, voffA);
            PG8_WAIT_L(8); PG8_BAR; PG8_WAIT_L(0); PG8_MMA(0, 0, At, B0); PG8_BAR; PG8_SCHED;
            PG8_LDB(B1, 0, 1); PG8_STAGE(PG8_SB(0, 0), b2, voffB);
            PG8_BAR; PG8_WAIT_L(0); PG8_MMA(0, 1, At, B1); PG8_BAR;
            PG8_LDA(At, 0, 1); PG8_STAGE(PG8_SA(0, 0), a2, voffA);
            PG8_BAR; PG8_WAIT_L(0); PG8_MMA(1, 0, At, B0); PG8_BAR; PG8_SCHED;
            PG8_STAGE(PG8_SB(0, 1), b2 + hstep, voffB);
            PG8_WAIT_V(6); PG8_BAR; PG8_MMA(1, 1, At, B1); PG8_BAR;
            PG8_LDB(B0, 1, 0); PG8_SCHED; PG8_LDA(At, 1, 0); PG8_STAGE(PG8_SA(0, 1), a2 + hstep, voffA);
            PG8_WAIT_L(8); PG8_BAR; PG8_WAIT_L(0); PG8_MMA(0, 0, At, B0); PG8_BAR; PG8_SCHED;
            PG8_LDB(B1, 1, 1); PG8_STAGE(PG8_SB(1, 0), b3, voffB);
            PG8_BAR; PG8_WAIT_L(0); PG8_MMA(0, 1, At, B1); PG8_BAR;
            PG8_LDA(At, 1, 1); PG8_STAGE(PG8_SA(1, 0), a3, voffA);
            PG8_BAR; PG8_WAIT_L(0); PG8_MMA(1, 0, At, B0); PG8_BAR; PG8_SCHED;
            PG8_STAGE(PG8_SB(1, 1), b3 + hstep, voffB);
            PG8_WAIT_V(6); PG8_BAR; PG8_MMA(1, 1, At, B1); PG8_BAR;
            }
        }
        if constexpr (ALIGN_EPI) { if (wr == 0) PG8_BAR; }
        if constexpr (!Epi::AFTER_DRAIN) { E(acc, cur, wr, wc, fr, fq); S.done(cur); }
        if (!has_next) break;
#pragma unroll
        for (int a = 0; a < 2; ++a)
#pragma unroll
            for (int b = 0; b < 2; ++b)
#pragma unroll
                for (int m = 0; m < 4; ++m)
#pragma unroll
                    for (int n = 0; n < 2; ++n) acc[a][b][m][n] = (f32x4){0.f, 0.f, 0.f, 0.f};
        cur = nxt; cA = nA; cB = nB; ++ui;
        if constexpr (ALIGN_EPI) { if (wr == 1) PG8_BAR; }
    }
    PG8_WAIT_V(0);
    if constexpr (!ALIGN_EPI) { if (wr == 0) PG8_BAR; }
    PG8_BAR;
    if constexpr (Epi::AFTER_DRAIN) { E.fused(acc, cur, wr, wc, fr, fq, lds, wid, lane); S.done(cur); }
#undef PG8_SA
#undef PG8_SB
#undef PG8_STAGE
#undef PG8_LDA
#undef PG8_LDB
#undef PG8_MMA
#undef PG8_WAIT_V
#undef PG8_WAIT_L
#undef PG8_BAR
#undef PG8_SCHED
}
}

using pg8::bf16_t; using pg8::bf16x8; using pg8::f32x4; using pg8::u32x4; using pg8::Unit;
typedef float f32x16 __attribute__((ext_vector_type(16)));
typedef unsigned u32x2 __attribute__((ext_vector_type(2)));
typedef float f32x2_t __attribute__((ext_vector_type(2)));
typedef __bf16 bf16x2_t __attribute__((ext_vector_type(2)));
#define LAS __attribute__((address_space(3)))
constexpr int TT = 32768, DM = 1024, SEQ = 8192, NBATCH = 4, MEML = 256;
constexpr int PW = 3072;
constexpr float RMS_EPS = 1e-6f;
constexpr float LOG2E = 1.4426950408889634f;
constexpr float NEGF = -1.0e30f;
constexpr size_t MiB = (size_t)1 << 20;
constexpr size_t WS_CTL = 0, WS_SSQ = 1 * MiB, WS_CS64 = 3 * MiB, WS_CS32 = 5 * MiB, WS_KMEAN = 6 * MiB, WS_MEMN = 8 * MiB, WS_KX = 12 * MiB, WS_VXT = 14 * MiB,
                 WS_W = 16 * MiB, WS_HB = 48 * MiB, WS_P = 112 * MiB, WS_VT = 304 * MiB, WS_MRG = 368 * MiB, WS_QX = 432 * MiB, WS_OX = 432 * MiB  , WS_KIMG = 464 * MiB, WS_END = 496 * MiB;
constexpr size_t W_MAIN = 0, W_V = (size_t)3072 * 1024, W_OUT = W_V + (size_t)1024 * 1024, W_XQ = W_OUT + (size_t)1024 * 1024, W_XK = W_XQ + (size_t)512 * 1024,
                 W_XV = W_XK + (size_t)512 * 1024, W_XO = W_XV + (size_t)512 * 1024, W_LAYER = W_XO + (size_t)1024 * 512;
static_assert(W_LAYER * 2 * 2 <= 32 * MiB, "weights fit");
constexpr int LDS_BYTES = 155648;
constexpr int LDS_MISC = 143360, LDS_RED = 143360 + 1024;

__device__ __forceinline__ unsigned cvtpk(float lo, float hi) { f32x2_t v = {lo, hi}; bf16x2_t b = __builtin_convertvector(v, bf16x2_t); return __builtin_bit_cast(unsigned, b); }
__device__ __forceinline__ float bflo(unsigned w) { return __uint_as_float(w << 16); }
__device__ __forceinline__ float bfhi(unsigned w) { return __uint_as_float(w & 0xffff0000u); }
__device__ __forceinline__ float ex2(float x) { return __builtin_amdgcn_exp2f(x); }
__device__ __forceinline__ float lg2(float x) { return __builtin_amdgcn_logf(x); }
__device__ __forceinline__ float rinv_row(const float* ssq, int row) {
    const f32x4 s = *(const f32x4*)(ssq + (size_t)row * 4);
    return __builtin_amdgcn_rsqf(((s.x + s.y) + (s.z + s.w)) * (1.f / 1024.f) + RMS_EPS);
}
__device__ __forceinline__ float silu_f(float y) { return y * __builtin_amdgcn_rcpf(1.f + ex2(-y * LOG2E)); }
#define ROT2(x1, x2, c, s) do { const float a_ = (x1) * (c) - (x2) * (s), b_ = (x2) * (c) + (x1) * (s); (x1) = a_; (x2) = b_; } while (0)

struct EpiIn {
    static constexpr bool PERM = true, AFTER_DRAIN = false;
    bf16_t* P; const float* ssq; const float* cs64; const float* cs32; bf16_t* Kimg; float* kpart; bf16_t* Ksb; bf16_t* Kdf;
    __device__ __forceinline__ void operator()(const f32x4 (&acc)[2][2][4][2], const Unit& u, int wr, int wc, int fr, int fq) const {
        const int row0 = u.pm * 256 + wr * 64 + fr;
        float rinv[2][4];
#pragma unroll
        for (int ai = 0; ai < 2; ++ai)
#pragma unroll
            for (int m = 0; m < 4; ++m) rinv[ai][m] = rinv_row(ssq, row0 + ai * 128 + m * 16);
#pragma unroll
        for (int bj = 0; bj < 2; ++bj) {
            const int seg = u.pn * 2 + bj;
            const int c0 = seg * 128 + wc * 32 + fq * 8;
            int kind; float sc = 1.f;
            if (seg < 3) { kind = 1; sc = 0.125f * LOG2E; } else if (seg < 6) { kind = 1; } else if (seg < 9) { kind = 3; }
            else if (seg < 11) { kind = 2; sc = 0.17677669529663687f * LOG2E; } else if (seg < 13) { kind = 2; } else if (seg < 15) { kind = 3; }
            else if (seg < 18) { kind = 0; sc = 0.125f * LOG2E; } else if (seg < 21) { kind = 0; } else { kind = 3; }
            const bool rope = (kind == 1 && (c0 & 63) < 16) || (kind == 2 && (c0 & 31) == 0);
            f32x4 cs0 = {0.f, 0.f, 0.f, 0.f}, cs1 = {0.f, 0.f, 0.f, 0.f};
#pragma unroll
            for (int ai = 0; ai < 2; ++ai)
#pragma unroll
                for (int m = 0; m < 4; ++m) {
                    const int row = row0 + ai * 128 + m * 16; const float s = rinv[ai][m];
                    f32x4 v0 = acc[ai][bj][m][0] * s, v1 = acc[ai][bj][m][1] * s;
                    if (kind == 3) {
                        v0.x = silu_f(v0.x); v0.y = silu_f(v0.y); v0.z = silu_f(v0.z); v0.w = silu_f(v0.w);
                        v1.x = silu_f(v1.x); v1.y = silu_f(v1.y); v1.z = silu_f(v1.z); v1.w = silu_f(v1.w);
                    } else {
                        if (rope) {
                            const float* t = (kind == 1) ? (cs64 + (size_t)row * 16 + (c0 & 63)) : (cs32 + (size_t)row * 8);
                            const f32x4 t0 = *(const f32x4*)t, t1 = *(const f32x4*)(t + 4);
                            ROT2(v0.x, v0.y, t0.x, t0.y); ROT2(v0.z, v0.w, t0.z, t0.w); ROT2(v1.x, v1.y, t1.x, t1.y); ROT2(v1.z, v1.w, t1.z, t1.w);
                        }
                        v0 = v0 * sc; v1 = v1 * sc;
                        cs0 = cs0 + v0; cs1 = cs1 + v1;
                    }
                    u32x4 w; w.x = cvtpk(v0.x, v0.y); w.y = cvtpk(v0.z, v0.w); w.z = cvtpk(v1.x, v1.y); w.w = cvtpk(v1.z, v1.w);
                    bf16_t* dst = P + (size_t)row * PW + c0;
                    if (seg >= 3 && seg < 6) {
                        const int cc = c0 - 384, hh = cc >> 6, ch = (cc & 63) >> 3, bb = row >> 13, s = row & 8191;
                        dst = Kimg + ((((size_t)(bb * 6 + hh) * 128 + (s >> 6)) * 8 + ch) * 64 + (s & 63)) * 8;
                    }
                    if (seg >= 11 && seg < 13) {
                        const int cc = c0 - 1408, hh = cc >> 6, ch = (cc & 63) >> 3, bb = row >> 13, s = row & 8191;
                        dst = Kdf + ((((size_t)(bb * 4 + hh) * 128 + (s >> 6)) * 8 + ch) * 64 + (s & 63)) * 8;
                    }
                    if (seg >= 18 && seg < 21) {
                        const int cc = c0 - 2304, hh = cc >> 6, ch = (cc & 63) >> 3, bb = row >> 13, s = row & 8191;
                        dst = Ksb + ((((size_t)(bb * 6 + hh) * 128 + (s >> 6)) * 8 + ch) * 64 + (s & 63)) * 8;
                    }
                    *(u32x4*)dst = w;
                }
            if (seg >= 3 && seg < 6) {
#pragma unroll
                for (int o = 1; o < 16; o <<= 1) {
                    cs0.x += __shfl_xor(cs0.x, o); cs0.y += __shfl_xor(cs0.y, o); cs0.z += __shfl_xor(cs0.z, o); cs0.w += __shfl_xor(cs0.w, o);
                    cs1.x += __shfl_xor(cs1.x, o); cs1.y += __shfl_xor(cs1.y, o); cs1.z += __shfl_xor(cs1.z, o); cs1.w += __shfl_xor(cs1.w, o);
                }
                if (fr == 0) {
                    const int cc = c0 - 384, hh = cc >> 6, bb = u.pm >> 5, blk = u.pm & 31;
                    float* kp = kpart + ((((size_t)(bb * 6 + hh) * 32 + blk) * 2 + wr) * 64 + (cc & 63));
                    *(f32x4*)kp = cs0; *(f32x4*)(kp + 4) = cs1;
                }
            }
        }
    }
};
struct EpiVt {
    static constexpr bool PERM = true, AFTER_DRAIN = false;
    bf16_t* Vt; const float* ssq;
    __device__ __forceinline__ void operator()(const f32x4 (&acc)[2][2][4][2], const Unit& u, int wr, int wc, int fr, int fq) const {
        const int row0 = u.pm * 256 + wr * 64 + fr;
#pragma unroll
        for (int bj = 0; bj < 2; ++bj) {
            const int c0 = u.pn * 256 + bj * 128 + wc * 32 + fq * 8;
            float ri[8];
#pragma unroll
            for (int j = 0; j < 8; ++j) ri[j] = rinv_row(ssq, c0 + j);
#pragma unroll
            for (int ai = 0; ai < 2; ++ai)
#pragma unroll
                for (int m = 0; m < 4; ++m) {
                    const int row = row0 + ai * 128 + m * 16;
                    const f32x4 v0 = acc[ai][bj][m][0], v1 = acc[ai][bj][m][1];
                    u32x4 w; w.x = cvtpk(v0.x * ri[0], v0.y * ri[1]); w.y = cvtpk(v0.z * ri[2], v0.w * ri[3]); w.z = cvtpk(v1.x * ri[4], v1.y * ri[5]); w.w = cvtpk(v1.z * ri[6], v1.w * ri[7]);
                    bf16_t* dst = Vt + (size_t)row * TT + c0;
                    if (2 * u.pm + ai < 3) {
                        const int hh = row >> 6, d = row & 63, bb = c0 >> 13, s = c0 & 8191;
                        dst = Vt + ((((size_t)(bb * 6 + hh) * 128 + (s >> 6)) * 8 + ((s & 63) >> 3)) * 64 + d) * 8;
                    }
                    if (2 * u.pm + ai == 3 || 2 * u.pm + ai == 4) {
                        const int rr = row - 384, hh = rr >> 6, d = rr & 63, bb = c0 >> 13, s = c0 & 8191;
                        dst = Vt + (size_t)384 * TT + ((((size_t)(bb * 4 + hh) * 128 + (s >> 6)) * 8 + ((s & 63) >> 3)) * 64 + d) * 8;
                    }
                    if (2 * u.pm + ai >= 5) {
                        const int rr = row - 640, hh = rr >> 6, d = rr & 63, bb = c0 >> 13, s = c0 & 8191;
                        dst = Vt + (size_t)640 * TT + ((((size_t)(bb * 6 + hh) * 128 + (s >> 6)) * 8 + ((s & 63) >> 3)) * 64 + d) * 8;
                    }
                    *(u32x4*)dst = w;
                }
        }
    }
};
struct EpiRes {
    static constexpr bool PERM = true, AFTER_DRAIN = false;
    bf16_t* h; float* ssq; LAS float* red; int tid;
    __device__ __forceinline__ void operator()(const f32x4 (&acc)[2][2][4][2], const Unit& u, int wr, int wc, int fr, int fq) const {
        const int row0 = u.pm * 256 + wr * 64 + fr, col0 = u.pn * 256 + wc * 32 + 8 * fq;
#pragma unroll
        for (int ai = 0; ai < 2; ++ai)
#pragma unroll
            for (int m = 0; m < 4; ++m) {
                const int row = row0 + ai * 128 + m * 16; float ss = 0.f;
#pragma unroll
                for (int bj = 0; bj < 2; ++bj) {
                    bf16_t* p = h + (size_t)row * DM + col0 + bj * 128;
                    const u32x4 v = *(const u32x4*)p; const f32x4 a0 = acc[ai][bj][m][0], a1 = acc[ai][bj][m][1];
                    const float h0 = bflo(v.x) + a0.x, h1 = bfhi(v.x) + a0.y, h2 = bflo(v.y) + a0.z, h3 = bfhi(v.y) + a0.w, h4 = bflo(v.z) + a1.x, h5 = bfhi(v.z) + a1.y, h6 = bflo(v.w) + a1.z, h7 = bfhi(v.w) + a1.w;
                    u32x4 w; w.x = cvtpk(h0, h1); w.y = cvtpk(h2, h3); w.z = cvtpk(h4, h5); w.w = cvtpk(h6, h7);
                    *(u32x4*)p = w;
                    const float r0 = bflo(w.x), r1 = bfhi(w.x), r2 = bflo(w.y), r3 = bfhi(w.y), r4 = bflo(w.z), r5 = bfhi(w.z), r6 = bflo(w.w), r7 = bfhi(w.w);
                    ss += ((r0 * r0 + r1 * r1) + (r2 * r2 + r3 * r3)) + ((r4 * r4 + r5 * r5) + (r6 * r6 + r7 * r7));
                }
                ss += __shfl_xor(ss, 16); ss += __shfl_xor(ss, 32);
                if (fq == 0) red[(ai * 128 + wr * 64 + m * 16 + fr) * 4 + wc] = ss;
            }
        asm volatile("s_waitcnt lgkmcnt(0)" ::: "memory"); __builtin_amdgcn_s_barrier(); asm volatile("" ::: "memory");
        if (tid < 256) { const f32x4 v = *(const LAS f32x4*)(red + tid * 4); ssq[(size_t)(u.pm * 256 + tid) * 4 + u.pn] = (v.x + v.y) + (v.z + v.w); }
    }
};
struct EpiB16 {
    static constexpr bool PERM = true, AFTER_DRAIN = false;
    bf16_t* O; int ldc; const float* ssq; float scale;
    __device__ __forceinline__ void operator()(const f32x4 (&acc)[2][2][4][2], const Unit& u, int wr, int wc, int fr, int fq) const {
        const int row0 = u.pm * 256 + wr * 64 + fr;
#pragma unroll
        for (int ai = 0; ai < 2; ++ai)
#pragma unroll
            for (int m = 0; m < 4; ++m) {
                const int row = row0 + ai * 128 + m * 16; const float s = ssq ? scale * rinv_row(ssq, row) : scale;
#pragma unroll
                for (int bj = 0; bj < 2; ++bj) {
                    const int c0 = u.pn * 256 + bj * 128 + wc * 32 + fq * 8;
                    const f32x4 v0 = acc[ai][bj][m][0] * s, v1 = acc[ai][bj][m][1] * s;
                    u32x4 w; w.x = cvtpk(v0.x, v0.y); w.y = cvtpk(v0.z, v0.w); w.z = cvtpk(v1.x, v1.y); w.w = cvtpk(v1.z, v1.w);
                    *(u32x4*)(O + (size_t)row * ldc + c0) = w;
                }
            }
    }
};

struct ACtx { int tid, lane, wid, r32, hi, r32p; LAS unsigned char* lds; };
#define MFMA32(a, b, c) __builtin_amdgcn_mfma_f32_32x32x16_bf16((a), (b), (c), 0, 0, 0)

template <int ROWS, int CH> struct Stage {
    static constexpr int N = ROWS * CH / 512;
    u32x4 r[N];
    __device__ __forceinline__ void load(const bf16_t* g, size_t pitch, int tid) {
#pragma unroll
        for (int i = 0; i < N; ++i) { const int idx = tid + i * 512, rl = idx & 7, c = (idx >> 3) & (CH - 1), rh = idx / (8 * CH); r[i] = *(const u32x4*)(g + (size_t)(rh * 8 + rl) * pitch + c * 8); }
    }
    __device__ __forceinline__ void store(LAS unsigned char* dst, int tid) const {
#pragma unroll
        for (int i = 0; i < N; ++i) { const int idx = tid + i * 512, rl = idx & 7, c = (idx >> 3) & (CH - 1), rh = idx / (8 * CH); *(LAS u32x4*)(dst + c * (ROWS * 16) + (rh * 8 + rl) * 16) = r[i]; }
    }
};
template <int ROWS, int CH> __device__ __forceinline__ void stage_glds(const bf16_t* g, size_t pitch, LAS unsigned char* dst, const ACtx& c) {
    constexpr int RB = ROWS / 64, NP = RB * CH / 8;
#pragma unroll
    for (int i = 0; i < NP; ++i) {
        const int p = c.wid + 8 * i, chunk = p / RB, rb = p % RB;
        __builtin_amdgcn_global_load_lds((const unsigned*)(g + (size_t)(rb * 64 + c.lane) * pitch + chunk * 8), (LAS unsigned*)(dst + chunk * (ROWS * 16) + rb * 1024), 16, 0, 0);
    }
}
__device__ __forceinline__ bf16x8 pack8(float a0, float a1, float a2, float a3, float a4, float a5, float a6, float a7) {
    u32x4 w; w.x = cvtpk(a0, a1); w.y = cvtpk(a2, a3); w.z = cvtpk(a4, a5); w.w = cvtpk(a6, a7); return __builtin_bit_cast(bf16x8, w);
}
template <int NK, int KSTR = 1024> __device__ __forceinline__ void qk_tile(f32x16& p0, f32x16& p1, const LAS unsigned char* Ks, int cb, const bf16x8* qr, const ACtx& c) {
    f32x16 z;
#pragma unroll
    for (int r = 0; r < 16; ++r) z[r] = 0.f;
    p0 = z; p1 = z;
#pragma unroll
    for (int d0 = 0; d0 < NK; ++d0) {
        const LAS unsigned char* a = Ks + (cb + 2 * d0 + c.hi) * KSTR + c.r32p * 16;
        const bf16x8 k0 = *(const LAS bf16x8*)a, k1 = *(const LAS bf16x8*)(a + 512);
        p0 = MFMA32(k0, qr[d0], p0); p1 = MFMA32(k1, qr[d0], p1);
    }
}
template <int DVB, int VSTR = 512 * DVB> __device__ __forceinline__ void pv_tile(f32x16* o, const LAS unsigned char* Vs, const f32x16& p0, const f32x16& p1, const ACtx& c) {
    bf16x8 pf[4];
    pf[0] = pack8(p0[0], p0[1], p0[2], p0[3], p0[4], p0[5], p0[6], p0[7]); pf[1] = pack8(p0[8], p0[9], p0[10], p0[11], p0[12], p0[13], p0[14], p0[15]);
    pf[2] = pack8(p1[0], p1[1], p1[2], p1[3], p1[4], p1[5], p1[6], p1[7]); pf[3] = pack8(p1[8], p1[9], p1[10], p1[11], p1[12], p1[13], p1[14], p1[15]);
#pragma unroll
    for (int s = 0; s < 4; ++s)
#pragma unroll
        for (int d0 = 0; d0 < DVB; ++d0) {
            const bf16x8 v = *(const LAS bf16x8*)(Vs + (2 * s + c.hi) * VSTR + (32 * d0 + c.r32) * 16);
            o[d0] = MFMA32(v, pf[s], o[d0]);
        }
}
__device__ __forceinline__ float softmax_step(f32x16& p0, f32x16& p1, float& m, float& l) {
    float mx = fmaxf(p0[0], p1[0]);
#pragma unroll
    for (int r = 1; r < 16; ++r) mx = fmaxf(mx, fmaxf(p0[r], p1[r]));
    mx = fmaxf(mx, __shfl_xor(mx, 32));
    const float mn = fmaxf(m, mx), alpha = ex2(m - mn); m = mn;
    float rs = 0.f;
#pragma unroll
    for (int r = 0; r < 16; ++r) { p0[r] = ex2(p0[r] - mn); p1[r] = ex2(p1[r] - mn); rs += p0[r] + p1[r]; }
    l = l * alpha + rs;
    return alpha;
}
__device__ __forceinline__ void scale_o(f32x16& o, float a) {
#pragma unroll
    for (int r = 0; r < 16; ++r) o[r] *= a;
}
__device__ __forceinline__ void zero16(f32x16& o) {
#pragma unroll
    for (int r = 0; r < 16; ++r) o[r] = 0.f;
}
__device__ __forceinline__ void xhalf(float v, float& lo, float& hi) { auto r = __builtin_amdgcn_permlane32_swap(__float_as_uint(v), __float_as_uint(v), false, false); lo = __uint_as_float(r[0]); hi = __uint_as_float(r[1]); }
__device__ __forceinline__ float xhalf_partner(float v, int hi_lane) { float lo, hi; xhalf(v, lo, hi); return hi_lane ? lo : hi; }
__device__ __forceinline__ unsigned xhalf_or(unsigned v) { auto r = __builtin_amdgcn_permlane32_swap(v, v, false, false); return r[0] | r[1]; }
struct Soft { float m; int zm; float l; };
__device__ __forceinline__ void soft_init(Soft& s) { s.m = 0.f; s.zm = 1; s.l = 0.f; }
__device__ __forceinline__ float max3f(float a, float b, float c) { float r; asm("v_max3_f32 %0, %1, %2, %3" : "=v"(r) : "v"(a), "v"(b), "v"(c)); return r; }
template <int NO> __device__ __forceinline__ void soft_step(Soft& s, f32x16& p0, f32x16& p1, f32x16* o, bool first) {
    float a = max3f(p0[0], p0[1], p1[0]), b = max3f(p0[2], p0[3], p1[1]); a = max3f(a, p1[2], p1[3]);
#pragma unroll
    for (int r = 4; r < 16; r += 4) { a = max3f(a, p0[r], p0[r + 1]); b = max3f(b, p0[r + 2], p0[r + 3]); a = max3f(a, p1[r], p1[r + 1]); b = max3f(b, p1[r + 2], p1[r + 3]); }
    float mx = max3f(a, b, b);
    { float lo_, hi_; xhalf(mx, lo_, hi_); mx = max3f(lo_, hi_, hi_); }
    const float d = mx - s.m;
    const bool up = d > 32.f, dn = first && (d < -32.f) && (mx > -1.0e29f);
    if (__any(up || dn)) {
        const float mn = (up || dn) ? mx : s.m; const float alpha = ex2(s.m - mn); s.m = mn;
        s.l *= alpha;
#pragma unroll
        for (int i = 0; i < NO; ++i) scale_o(o[i], alpha);
        s.zm = __all(s.m == 0.f);
    }
    if (s.zm) {
#pragma unroll
        for (int r = 0; r < 16; ++r) { p0[r] = ex2(p0[r]); p1[r] = ex2(p1[r]); }
    } else {
        const float m = s.m;
#pragma unroll
        for (int r = 0; r < 16; ++r) { p0[r] = ex2(p0[r] - m); p1[r] = ex2(p1[r] - m); }
    }
}
__device__ __forceinline__ bf16x8 ones8() { u32x4 w; w.x = 0x3F803F80u; w.y = 0x3F803F80u; w.z = 0x3F803F80u; w.w = 0x3F803F80u; return __builtin_bit_cast(bf16x8, w); }
template <int DVB, int VSTR> __device__ __forceinline__ void pv_tile_l(f32x16* o, float& l, const LAS unsigned char* Vs, const f32x16& p0, const f32x16& p1, const ACtx& c) {
    bf16x8 pf[4];
    pf[0] = pack8(p0[0], p0[1], p0[2], p0[3], p0[4], p0[5], p0[6], p0[7]); pf[1] = pack8(p0[8], p0[9], p0[10], p0[11], p0[12], p0[13], p0[14], p0[15]);
    pf[2] = pack8(p1[0], p1[1], p1[2], p1[3], p1[4], p1[5], p1[6], p1[7]); pf[3] = pack8(p1[8], p1[9], p1[10], p1[11], p1[12], p1[13], p1[14], p1[15]);
    const bf16x8 one = ones8();
    f32x16 la; zero16(la);
#pragma unroll
    for (int s = 0; s < 4; ++s) {
        la = MFMA32(one, pf[s], la);
#pragma unroll
        for (int d0 = 0; d0 < DVB; ++d0) {
            const bf16x8 v = *(const LAS bf16x8*)(Vs + (2 * s + c.hi) * VSTR + (32 * d0 + c.r32) * 16);
            o[d0] = MFMA32(v, pf[s], o[d0]);
        }
    }
    l += la[0];
}
template <bool STRICT> __device__ __forceinline__ void mask_causal(f32x16& p0, f32x16& p1, int kbase, int q, int hi) {
#pragma unroll
    for (int r = 0; r < 16; ++r) {
        const int key = kbase + 16 * (r >> 3) + 8 * hi + (r & 7);
        const bool v0 = STRICT ? (key < q) : (key <= q), v1 = STRICT ? (key + 32 < q) : (key + 32 <= q);
        p0[r] = v0 ? p0[r] : NEGF; p1[r] = v1 ? p1[r] : NEGF;
    }
}
__device__ __forceinline__ void top3_insert(float& t1, float& t2, float& t3, float v) {
    const float a = fmaxf(t1, v), b = fminf(t1, v); t1 = a; const float c = fmaxf(t2, b), d = fminf(t2, b); t2 = c; t3 = fmaxf(t3, d);
}

__device__ __forceinline__ void store_gated_rows(const ACtx& c, LAS unsigned char* stg, const f32x16* o, const bf16_t* Gp0, bf16_t* Op0, size_t gpitch) {
#pragma unroll
    for (int d0 = 0; d0 < 2; ++d0)
#pragma unroll
        for (int r4 = 0; r4 < 4; ++r4) {
            u32x2 w; w.x = cvtpk(o[d0][4 * r4], o[d0][4 * r4 + 1]); w.y = cvtpk(o[d0][4 * r4 + 2], o[d0][4 * r4 + 3]);
            *(LAS u32x2*)(stg + c.r32 * 128 + (((4 * d0 + r4) ^ (c.r32 & 7)) * 16) + c.hi * 8) = w;
        }
    asm volatile("s_waitcnt lgkmcnt(0)" ::: "memory");
#pragma unroll
    for (int i = 0; i < 4; ++i) {
        const int row = i * 8 + (c.lane >> 3), ch = c.lane & 7;
        const u32x4 v = *(const LAS u32x4*)(stg + row * 128 + ((ch ^ (row & 7)) * 16));
        const u32x4 g = *(const u32x4*)(Gp0 + (size_t)row * gpitch + ch * 8);
        u32x4 w; w.x = cvtpk(bflo(v.x) * bflo(g.x), bfhi(v.x) * bfhi(g.x)); w.y = cvtpk(bflo(v.y) * bflo(g.y), bfhi(v.y) * bfhi(g.y));
        w.z = cvtpk(bflo(v.z) * bflo(g.z), bfhi(v.z) * bfhi(g.z)); w.w = cvtpk(bflo(v.w) * bflo(g.w), bfhi(v.w) * bfhi(g.w));
        *(u32x4*)(Op0 + (size_t)row * DM + ch * 8) = w;
    }
    asm volatile("s_waitcnt lgkmcnt(0)" ::: "memory");
}
constexpr int MOBA_PART = 32768, MOBA_REC = 136;
template <int NP> __device__ __forceinline__ void stage_linear(const bf16_t* g, LAS unsigned char* dst, const ACtx& c) {
#pragma unroll
    for (int i = 0; i < NP; ++i) { const int p = c.wid + 8 * i; __builtin_amdgcn_global_load_lds((const unsigned*)(g + (size_t)p * 512 + c.lane * 8), (LAS unsigned*)(dst + p * 1024), 16, 0, 0); }
}
__device__ __forceinline__ void moba_unit(const ACtx& c, int b, int h, int qb, const bf16_t* P, const bf16_t* Kimg, const bf16_t* Vimg, const float* kpart, bf16_t* merged) {
    const size_t tok0 = (size_t)b * SEQ;
    const int qrel = c.wid * 32 + c.r32;
    const size_t qtok = tok0 + qb * 256 + qrel;
    const bf16_t* Kg = Kimg + (size_t)(b * 6 + h) * 128 * 4096;
    const bf16_t* Vg = Vimg + (size_t)(b * 6 + h) * 128 * 4096;
    const bf16_t* Qp = P + qtok * PW + h * 64;
    unsigned sel = 0u;
    if (qb > 0) {
        {
            bf16x8 qr[4];
#pragma unroll
            for (int d0 = 0; d0 < 4; ++d0) qr[d0] = *(const bf16x8*)(Qp + d0 * 16 + c.hi * 8);
            f32x16 g; zero16(g);
            const float* km = kpart + ((size_t)(b * 6 + h) * 32 + c.r32) * 128;
#pragma unroll
            for (int d0 = 0; d0 < 4; ++d0) {
                const float* kq = km + d0 * 16 + c.hi * 8;
                const f32x4 a0 = *(const f32x4*)kq + *(const f32x4*)(kq + 64), a1 = *(const f32x4*)(kq + 4) + *(const f32x4*)(kq + 68);
                const float sc = 1.f / 256.f;
                const bf16x8 kf = pack8(a0.x * sc, a0.y * sc, a0.z * sc, a0.w * sc, a1.x * sc, a1.y * sc, a1.z * sc, a1.w * sc); g = MFMA32(kf, qr[d0], g);
            }
            float t1 = NEGF, t2 = NEGF, t3 = NEGF;
#pragma unroll
            for (int r = 0; r < 16; ++r) { const int blk = (r & 3) + 8 * (r >> 2) + 4 * c.hi; const float v = (blk < qb) ? g[r] : NEGF; g[r] = v; top3_insert(t1, t2, t3, v); }
            const float u1 = xhalf_partner(t1, c.hi), u2 = xhalf_partner(t2, c.hi), u3 = xhalf_partner(t3, c.hi);
            top3_insert(t1, t2, t3, u1); top3_insert(t1, t2, t3, u2); top3_insert(t1, t2, t3, u3);
            unsigned seq = 0u;
#pragma unroll
            for (int r = 0; r < 16; ++r) { const int blk = (r & 3) + 8 * (r >> 2) + 4 * c.hi; if (blk < qb) { if (g[r] > t3) sel |= 1u << blk; else if (g[r] == t3) seq |= 1u << blk; } }
            sel = xhalf_or(sel); seq = xhalf_or(seq);
            { const int need = 3 - __popc(sel); while (__popc(seq) > need) seq &= ~(0x80000000u >> __clz((int)seq)); }
            sel |= seq;
        }
        LAS int* cnt = (LAS int*)c.lds; LAS unsigned short* list = (LAS unsigned short*)(c.lds + 1024);
        if (c.tid < 32) cnt[c.tid] = 0;
        __syncthreads();
        if (c.hi == 0) {
            unsigned s = sel; int slot = 0;
            while (s) { const int blk = __ffs((int)s) - 1; s &= s - 1u; const int pos = __hip_atomic_fetch_add(cnt + blk, 1, __ATOMIC_RELAXED, __HIP_MEMORY_SCOPE_WORKGROUP); list[blk * 256 + pos] = (unsigned short)(qrel | (slot << 8)); ++slot; }
        }
        __syncthreads();
        int item = 0;
#pragma unroll 1
        for (int j = 0; j < qb; ++j) {
            const int n = __builtin_amdgcn_readfirstlane(cnt[j]); const int ntile = (n + 31) >> 5;
#pragma unroll 1
            for (int tl = 0; tl < ntile; ++tl, ++item) {
                if ((item & 7) != c.wid) continue;
                const int idx = 32 * tl + c.r32; const bool valid = idx < n;
                const unsigned e = list[j * 256 + (valid ? idx : 0)]; const int ql = e & 255, slot = e >> 8;
                const bf16_t* Qg = P + (tok0 + qb * 256 + ql) * PW + h * 64;
                bf16x8 qg[4];
#pragma unroll
                for (int d0 = 0; d0 < 4; ++d0) qg[d0] = *(const bf16x8*)(Qg + d0 * 16 + c.hi * 8);
                Soft s2; soft_init(s2); f32x16 o2[2]; zero16(o2[0]); zero16(o2[1]);
                const bf16_t* kp = Kg + (size_t)(j * 4) * 4096 + (c.hi * 64 + c.r32p) * 8;
                const bf16_t* vp = Vg + (size_t)(j * 4) * 4096 + (c.hi * 64 + c.r32) * 8;
                bf16x8 kc[8];
#pragma unroll
                for (int i = 0; i < 4; ++i) { kc[2 * i] = *(const bf16x8*)(kp + i * 1024); kc[2 * i + 1] = *(const bf16x8*)(kp + i * 1024 + 256); }
#pragma unroll 1
                for (int kt = 0; kt < 4; ++kt) {
                    bf16x8 vc[8];
                    { const bf16_t* vq = vp + (size_t)kt * 4096;
#pragma unroll
                      for (int i = 0; i < 4; ++i) { vc[2 * i] = *(const bf16x8*)(vq + i * 1024); vc[2 * i + 1] = *(const bf16x8*)(vq + i * 1024 + 256); } }
                    f32x16 p0, p1; zero16(p0); zero16(p1);
#pragma unroll
                    for (int d0 = 0; d0 < 4; ++d0) { p0 = MFMA32(kc[2 * d0], qg[d0], p0); p1 = MFMA32(kc[2 * d0 + 1], qg[d0], p1); }
                    if (kt < 3) {
                        const bf16_t* kq = kp + (size_t)(kt + 1) * 4096;
#pragma unroll
                        for (int i = 0; i < 4; ++i) { kc[2 * i] = *(const bf16x8*)(kq + i * 1024); kc[2 * i + 1] = *(const bf16x8*)(kq + i * 1024 + 256); }
                    }
                    soft_step<2>(s2, p0, p1, o2, kt == 0);
                    bf16x8 pf[4]; const bf16x8 one = ones8(); f32x16 la; zero16(la);
                    pf[0] = pack8(p0[0], p0[1], p0[2], p0[3], p0[4], p0[5], p0[6], p0[7]); pf[1] = pack8(p0[8], p0[9], p0[10], p0[11], p0[12], p0[13], p0[14], p0[15]);
                    pf[2] = pack8(p1[0], p1[1], p1[2], p1[3], p1[4], p1[5], p1[6], p1[7]); pf[3] = pack8(p1[8], p1[9], p1[10], p1[11], p1[12], p1[13], p1[14], p1[15]);
#pragma unroll
                    for (int s = 0; s < 4; ++s) {
                        la = MFMA32(one, pf[s], la);
                        o2[0] = MFMA32(vc[2 * s], pf[s], o2[0]); o2[1] = MFMA32(vc[2 * s + 1], pf[s], o2[1]);
                    }
                    s2.l += la[0];
                }
                const float m2 = s2.m, l2 = s2.l;
                if (valid) {
                    LAS unsigned char* rec = c.lds + MOBA_PART + (ql * 3 + slot) * MOBA_REC;
#pragma unroll
                    for (int d0 = 0; d0 < 2; ++d0)
#pragma unroll
                        for (int r4 = 0; r4 < 4; ++r4) { u32x2 w; w.x = cvtpk(o2[d0][4 * r4], o2[d0][4 * r4 + 1]); w.y = cvtpk(o2[d0][4 * r4 + 2], o2[d0][4 * r4 + 3]); *(LAS u32x2*)(rec + (32 * d0 + 8 * r4 + 4 * c.hi) * 2) = w; }
                    if (c.hi == 0) { *(LAS float*)(rec + 128) = m2; *(LAS float*)(rec + 132) = l2; }
                }
            }
        }
        __syncthreads();
    }
    Soft sm; soft_init(sm); f32x16 o[2]; zero16(o[0]); zero16(o[1]);
    {
        bf16x8 qr[4];
#pragma unroll
        for (int d0 = 0; d0 < 4; ++d0) qr[d0] = *(const bf16x8*)(Qp + d0 * 16 + c.hi * 8);
        const bf16_t* kp = Kg + (size_t)(qb * 4) * 4096 + (c.hi * 64 + c.r32p) * 8;
        const bf16_t* vp = Vg + (size_t)(qb * 4) * 4096 + (c.hi * 64 + c.r32) * 8;
        const int ntl = ((32 * c.wid + 31) >> 6) + 1;
        bf16x8 kc[8];
#pragma unroll
        for (int i = 0; i < 4; ++i) { kc[2 * i] = *(const bf16x8*)(kp + i * 1024); kc[2 * i + 1] = *(const bf16x8*)(kp + i * 1024 + 256); }
#pragma unroll 1
        for (int kt = 0; kt < ntl; ++kt) {
            bf16x8 vc[8];
            { const bf16_t* vq = vp + (size_t)kt * 4096;
#pragma unroll
              for (int i = 0; i < 4; ++i) { vc[2 * i] = *(const bf16x8*)(vq + i * 1024); vc[2 * i + 1] = *(const bf16x8*)(vq + i * 1024 + 256); } }
            f32x16 p0, p1; zero16(p0); zero16(p1);
#pragma unroll
            for (int d0 = 0; d0 < 4; ++d0) { p0 = MFMA32(kc[2 * d0], qr[d0], p0); p1 = MFMA32(kc[2 * d0 + 1], qr[d0], p1); }
            if (kt + 1 < ntl) {
                const bf16_t* kq = kp + (size_t)(kt + 1) * 4096;
#pragma unroll
                for (int i = 0; i < 4; ++i) { kc[2 * i] = *(const bf16x8*)(kq + i * 1024); kc[2 * i + 1] = *(const bf16x8*)(kq + i * 1024 + 256); }
            }
            if (64 * kt + 63 > 32 * c.wid) mask_causal<false>(p0, p1, 64 * kt, qrel, c.hi);
            soft_step<2>(sm, p0, p1, o, kt == 0);
            bf16x8 pf[4]; const bf16x8 one = ones8(); f32x16 la; zero16(la);
            pf[0] = pack8(p0[0], p0[1], p0[2], p0[3], p0[4], p0[5], p0[6], p0[7]); pf[1] = pack8(p0[8], p0[9], p0[10], p0[11], p0[12], p0[13], p0[14], p0[15]);
            pf[2] = pack8(p1[0], p1[1], p1[2], p1[3], p1[4], p1[5], p1[6], p1[7]); pf[3] = pack8(p1[8], p1[9], p1[10], p1[11], p1[12], p1[13], p1[14], p1[15]);
#pragma unroll
            for (int s = 0; s < 4; ++s) { la = MFMA32(one, pf[s], la); o[0] = MFMA32(vc[2 * s], pf[s], o[0]); o[1] = MFMA32(vc[2 * s + 1], pf[s], o[1]); }
            sm.l += la[0];
        }
    }
    float l = sm.l;
    if (qb > 0) {
        const float m = sm.m;
        const int nsel = __popc(sel);
        const LAS unsigned char* rec0 = c.lds + MOBA_PART + (qrel * 3) * MOBA_REC;
        float ms0 = NEGF, ms1 = NEGF, ms2 = NEGF;
        if (nsel > 0) ms0 = *(const LAS float*)(rec0 + 128);
        if (nsel > 1) ms1 = *(const LAS float*)(rec0 + MOBA_REC + 128);
        if (nsel > 2) ms2 = *(const LAS float*)(rec0 + 2 * MOBA_REC + 128);
        const float M = fmaxf(fmaxf(m, ms0), fmaxf(ms1, ms2));
        const float w0 = ex2(m - M); l *= w0; scale_o(o[0], w0); scale_o(o[1], w0);
#pragma unroll
        for (int s = 0; s < 3; ++s) {
            if (s < nsel) {
                const LAS unsigned char* rec = rec0 + s * MOBA_REC;
                const float ws = ex2((s == 0 ? ms0 : (s == 1 ? ms1 : ms2)) - M);
                l += ws * *(const LAS float*)(rec + 132);
#pragma unroll
                for (int d0 = 0; d0 < 2; ++d0)
#pragma unroll
                    for (int r4 = 0; r4 < 4; ++r4) { const u32x2 v = *(const LAS u32x2*)(rec + (32 * d0 + 8 * r4 + 4 * c.hi) * 2);
                        o[d0][4 * r4] += ws * bflo(v.x); o[d0][4 * r4 + 1] += ws * bfhi(v.x); o[d0][4 * r4 + 2] += ws * bflo(v.y); o[d0][4 * r4 + 3] += ws * bfhi(v.y); }
            }
        }
    }
    const float inv = 1.f / l;
    scale_o(o[0], inv); scale_o(o[1], inv);
    { const size_t qt0 = tok0 + qb * 256 + c.wid * 32;
      store_gated_rows(c, c.lds + c.wid * 4096, o, P + qt0 * PW + 768 + h * 64, merged + qt0 * DM + h * 64, PW); }
    __syncthreads();
}

__device__ __forceinline__ void diff_sub(const bool MASK, const ACtx& c, const LAS unsigned char* Ks, const LAS unsigned char* Vs, const bf16x8 (&qr)[2][2], int kbase, int qabs,
                                                             Soft& s0, Soft& s1, f32x16* oa, f32x16* ob, bool first) {
    f32x16 p0, p1, r0, r1;
    qk_tile<2, 1024>(p0, p1, Ks, 0, qr[0], c);
    qk_tile<2, 1024>(r0, r1, Ks, 4, qr[1], c);
    if (MASK) { mask_causal<false>(p0, p1, kbase, qabs, c.hi); mask_causal<false>(r0, r1, kbase, qabs, c.hi); }
    soft_step<2>(s0, p0, p1, oa, first);
    soft_step<2>(s1, r0, r1, ob, first);
    {
        float sa = 0.f, sb = 0.f;
#pragma unroll
        for (int r = 0; r < 16; ++r) { sa += p0[r] + p1[r]; sb += r0[r] + r1[r]; }
        s0.l += sa; s1.l += sb;
    }
    pv_tile<2, 1024>(oa, Vs, p0, p1, c);
    pv_tile<2, 1024>(ob, Vs, r0, r1, c);
}
__device__ __forceinline__ void diff_unit(const ACtx& c, int b, int h, int qb, const bf16_t* P, const bf16_t* Kdf, const bf16_t* Vdf, bf16_t* merged, float lam, float one_m_li, const float* hng) {
    const size_t tok0 = (size_t)b * SEQ;
    const int q0w = qb * 256 + c.wid * 32, qabs = q0w + c.r32;
    const size_t qtok = tok0 + qabs;
    const bf16_t* Qp = P + qtok * PW + 1152 + h * 64;
    bf16x8 qr[2][2];
#pragma unroll
    for (int sh = 0; sh < 2; ++sh)
#pragma unroll
        for (int d0 = 0; d0 < 2; ++d0) qr[sh][d0] = *(const bf16x8*)(Qp + sh * 32 + d0 * 16 + c.hi * 8);
    const int NT = 2 * qb + 2;
    const bf16_t* Kg = Kdf + (size_t)(b * 4 + h) * 128 * 4096;
    const bf16_t* Vg = Vdf + (size_t)(b * 4 + h) * 128 * 4096;
    stage_linear<2>(Kg, c.lds, c); stage_linear<2>(Vg, c.lds + 32768, c);
    __syncthreads();
    Soft s0, s1; soft_init(s0); soft_init(s1); f32x16 oa[2], ob[2]; zero16(oa[0]); zero16(oa[1]); zero16(ob[0]); zero16(ob[1]);
#pragma unroll 1
    for (int t = 0; t < NT; ++t) {
        const int cur = t & 1;
        if (t + 1 < NT) { stage_linear<2>(Kg + (size_t)(2 * t + 2) * 4096, c.lds + (cur ^ 1) * 16384, c); stage_linear<2>(Vg + (size_t)(2 * t + 2) * 4096, c.lds + 32768 + (cur ^ 1) * 16384, c); }
#pragma unroll
        for (int u = 0; u < 2; ++u) {
            const int kbase = 128 * t + 64 * u;
            if (kbase <= q0w + 31) {
                const LAS unsigned char* Ks = c.lds + cur * 16384 + u * 8192; const LAS unsigned char* Vs = c.lds + 32768 + cur * 16384 + u * 8192;
                diff_sub(kbase + 63 > q0w, c, Ks, Vs, qr, kbase, qabs, s0, s1, oa, ob, kbase == 0);
            }
        }
        __syncthreads();
    }
    { float lo_, hi_; xhalf(s0.l, lo_, hi_); s0.l = lo_ + hi_; xhalf(s1.l, lo_, hi_); s1.l = lo_ + hi_; }
    const float a0 = 1.f / s0.l, a1 = lam / s1.l;
    float ss = 0.f;
#pragma unroll
    for (int d0 = 0; d0 < 2; ++d0)
#pragma unroll
        for (int r = 0; r < 16; ++r) { const float f = oa[d0][r] * a0 - ob[d0][r] * a1; oa[d0][r] = f; ss += f * f; }
    { float lo_, hi_; xhalf(ss, lo_, hi_); ss = lo_ + hi_; }
    const float rn = __builtin_amdgcn_rsqf(ss * (1.f / 64.f) + RMS_EPS) * one_m_li;
#pragma unroll
    for (int d0 = 0; d0 < 2; ++d0)
#pragma unroll
        for (int r4 = 0; r4 < 4; ++r4) {
            const int d = 32 * d0 + 8 * r4 + 4 * c.hi; const f32x4 hg = *(const f32x4*)(hng + d);
            oa[d0][4 * r4] *= rn * hg.x; oa[d0][4 * r4 + 1] *= rn * hg.y; oa[d0][4 * r4 + 2] *= rn * hg.z; oa[d0][4 * r4 + 3] *= rn * hg.w;
        }
    { const size_t qt0 = tok0 + q0w;
      store_gated_rows(c, c.lds + c.wid * 4096, oa, P + qt0 * PW + 1664 + h * 64, merged + qt0 * DM + 384 + h * 64, PW); }
    __syncthreads();
}

__device__ __forceinline__ void sb_elem(float z, bool valid, float& a, float& lb) {
    const float e = ex2(-fabsf(z)); const float sp = fmaxf(z, 0.f) + lg2(1.f + e);
    a = valid ? -sp : 0.f; lb = valid ? (z - sp) : NEGF;
}
__device__ __forceinline__ void sb_unit(const ACtx& c, int b, int h, int qb, const bf16_t* P, const bf16_t* Ksb, const bf16_t* Vsb, bf16_t* merged) {
    const size_t tok0 = (size_t)b * SEQ;
    const int q0w = qb * 256 + c.wid * 32, qabs = q0w + c.r32;
    const size_t qtok = tok0 + qabs;
    const bf16_t* Qp = P + qtok * PW + 1920 + h * 64;
    bf16x8 qr[4];
#pragma unroll
    for (int d0 = 0; d0 < 4; ++d0) qr[d0] = *(const bf16x8*)(Qp + d0 * 16 + c.hi * 8);
    const bf16_t* kp = Ksb + (size_t)(b * 6 + h) * 128 * 4096 + (c.hi * 64 + c.r32p) * 8;
    const bf16_t* vp = Vsb + (size_t)(b * 6 + h) * 128 * 4096 + (c.hi * 64 + c.r32) * 8;
    float R = 0.f; f32x16 o[2]; zero16(o[0]); zero16(o[1]);
    int t = (q0w + 30) >> 6;
    {
        bf16x8 kc[8];
#pragma unroll
        for (int i = 0; i < 4; ++i) { kc[2 * i] = *(const bf16x8*)(kp + (size_t)t * 4096 + i * 1024); kc[2 * i + 1] = *(const bf16x8*)(kp + (size_t)t * 4096 + i * 1024 + 256); }
#pragma unroll 1
        for (;;) {
            bf16x8 vc[8];
#pragma unroll
            for (int i = 0; i < 4; ++i) { vc[2 * i] = *(const bf16x8*)(vp + (size_t)t * 4096 + i * 1024); vc[2 * i + 1] = *(const bf16x8*)(vp + (size_t)t * 4096 + i * 1024 + 256); }
            f32x16 p0, p1; zero16(p0); zero16(p1);
#pragma unroll
            for (int d0 = 0; d0 < 4; ++d0) { p0 = MFMA32(kc[2 * d0], qr[d0], p0); p1 = MFMA32(kc[2 * d0 + 1], qr[d0], p1); }
            if (t > 0) {
#pragma unroll
                for (int i = 0; i < 4; ++i) { kc[2 * i] = *(const bf16x8*)(kp + (size_t)(t - 1) * 4096 + i * 1024); kc[2 * i + 1] = *(const bf16x8*)(kp + (size_t)(t - 1) * 4096 + i * 1024 + 256); }
            }
            const bool needmask = (64 * t + 63 >= q0w);
            f32x16 a0, a1;
#pragma unroll
            for (int r = 0; r < 16; ++r) {
                const int key = 64 * t + 16 * (r >> 3) + 8 * c.hi + (r & 7);
                float a, lb;
                sb_elem(p0[r], !needmask || (key < qabs), a, lb); a0[r] = a; p0[r] = lb;
                sb_elem(p1[r], !needmask || (key + 32 < qabs), a, lb); a1[r] = a; p1[r] = lb;
            }
            float gs0 = 0.f, gs1 = 0.f, gs2 = 0.f, gs3 = 0.f;
#pragma unroll
            for (int i = 0; i < 8; ++i) { gs0 += a0[i]; gs1 += a0[8 + i]; gs2 += a1[i]; gs3 += a1[8 + i]; }
            const float pg0 = xhalf_partner(gs0, c.hi), pg1 = xhalf_partner(gs1, c.hi), pg2 = xhalf_partner(gs2, c.hi), pg3 = xhalf_partner(gs3, c.hi);
            const float so2 = gs3, so1 = so2 + gs2, so0 = so1 + gs1;
            const float pe2 = pg3, pe1 = pe2 + pg2, pe0 = pe1 + pg1;
            const float totO = so0 + gs0, totP = pe0 + pg0;
            float base0 = R + so0 + (c.hi ? pe0 : totP);
            float base1 = R + so1 + (c.hi ? pe1 : pe0);
            float base2 = R + so2 + (c.hi ? pe2 : pe1);
            float base3 = R + (c.hi ? 0.f : pe2);
#pragma unroll
            for (int i = 7; i >= 0; --i) {
                p0[i] = ex2(p0[i] + base0); base0 += a0[i];
                p0[8 + i] = ex2(p0[8 + i] + base1); base1 += a0[8 + i];
                p1[i] = ex2(p1[i] + base2); base2 += a1[i];
                p1[8 + i] = ex2(p1[8 + i] + base3); base3 += a1[8 + i];
            }
            R += c.hi ? (totP + totO) : (totO + totP);
            bf16x8 pf[4];
            pf[0] = pack8(p0[0], p0[1], p0[2], p0[3], p0[4], p0[5], p0[6], p0[7]); pf[1] = pack8(p0[8], p0[9], p0[10], p0[11], p0[12], p0[13], p0[14], p0[15]);
            pf[2] = pack8(p1[0], p1[1], p1[2], p1[3], p1[4], p1[5], p1[6], p1[7]); pf[3] = pack8(p1[8], p1[9], p1[10], p1[11], p1[12], p1[13], p1[14], p1[15]);
#pragma unroll
            for (int s = 0; s < 4; ++s) { o[0] = MFMA32(vc[2 * s], pf[s], o[0]); o[1] = MFMA32(vc[2 * s + 1], pf[s], o[1]); }
            if (t == 0 || __all(R < -150.f)) break;
            --t;
        }
    }
    { const size_t qt0 = tok0 + q0w;
      store_gated_rows(c, c.lds + c.wid * 4096, o, P + qt0 * PW + 2688 + h * 64, merged + qt0 * DM + 640 + h * 64, PW); }
}

__device__ __forceinline__ void xattn_unit(const ACtx& c, int b, int hx, int qb, const bf16_t* QX, const bf16_t* KX, const bf16_t* VXT, bf16_t* OX) {
    const size_t qtok = (size_t)b * SEQ + qb * 256 + c.wid * 32 + c.r32;
    const bf16_t* Qp = QX + qtok * 512 + hx * 128;
    bf16x8 qr[8];
#pragma unroll
    for (int d0 = 0; d0 < 8; ++d0) qr[d0] = *(const bf16x8*)(Qp + d0 * 16 + c.hi * 8);
    const bf16_t* Kg = KX + (size_t)(b * MEML) * 512 + hx * 128;
    const bf16_t* Vg = VXT + (size_t)(hx * 128) * 1024 + b * MEML;
    stage_glds<256, 16>(Kg, 512, c.lds, c); stage_glds<128, 32>(Vg, 1024, c.lds + 65536, c);
    __syncthreads();
    Soft sm; soft_init(sm); f32x16 o[4]; zero16(o[0]); zero16(o[1]); zero16(o[2]); zero16(o[3]);
#pragma unroll 1
    for (int t = 0; t < 4; ++t) {
        f32x16 p0, p1; qk_tile<8, 4096>(p0, p1, c.lds + t * 1024, 0, qr, c);
        soft_step<4>(sm, p0, p1, o, t == 0);
        pv_tile_l<4, 2048>(o, sm.l, c.lds + 65536 + t * 16384, p0, p1, c);
    }
    __syncthreads();
    const float inv = 1.f / sm.l;
    bf16_t* Op = OX + qtok * 512 + hx * 128;
#pragma unroll
    for (int d0 = 0; d0 < 4; ++d0)
#pragma unroll
        for (int r4 = 0; r4 < 4; ++r4) {
            const int d = 32 * d0 + 8 * r4 + 4 * c.hi;
            u32x2 w; w.x = cvtpk(o[d0][4 * r4] * inv, o[d0][4 * r4 + 1] * inv); w.y = cvtpk(o[d0][4 * r4 + 2] * inv, o[d0][4 * r4 + 3] * inv);
            *(u32x2*)(Op + d) = w;
        }
}

__device__ __forceinline__ float wave_sum(float v) {
#pragma unroll
    for (int o = 1; o < 64; o <<= 1) v += __shfl_xor(v, o);
    return v;
}
__device__ __forceinline__ void kmean_item(int item, const bf16_t* Kimg, bf16_t* kmean, int lane) {
    const int blk = item & 31, bh = item >> 5;
    const bf16_t* img = Kimg + ((size_t)bh * 128 + blk * 4) * 4096;
    const int kl = lane >> 3, cc = lane & 7;
    float s0 = 0.f, s1 = 0.f, s2 = 0.f, s3 = 0.f, s4 = 0.f, s5 = 0.f, s6 = 0.f, s7 = 0.f;
#pragma unroll 8
    for (int it = 0; it < 32; ++it) {
        const int key = it * 8 + kl;
        const u32x4 v = *(const u32x4*)(img + ((size_t)((key >> 6) * 8 + cc) * 64 + (key & 63)) * 8);
        s0 += bflo(v.x); s1 += bfhi(v.x); s2 += bflo(v.y); s3 += bfhi(v.y); s4 += bflo(v.z); s5 += bfhi(v.z); s6 += bflo(v.w); s7 += bfhi(v.w);
    }
#pragma unroll
    for (int o = 8; o < 64; o <<= 1) { s0 += __shfl_xor(s0, o); s1 += __shfl_xor(s1, o); s2 += __shfl_xor(s2, o); s3 += __shfl_xor(s3, o); s4 += __shfl_xor(s4, o); s5 += __shfl_xor(s5, o); s6 += __shfl_xor(s6, o); s7 += __shfl_xor(s7, o); }
    if (lane < 8) { const float k = 1.f / 256.f; u32x4 w; w.x = cvtpk(s0 * k, s1 * k); w.y = cvtpk(s2 * k, s3 * k); w.z = cvtpk(s4 * k, s5 * k); w.w = cvtpk(s6 * k, s7 * k); *(u32x4*)(kmean + (size_t)item * 64 + cc * 8) = w; }
}
__device__ __forceinline__ int src_main(int n) {
    int base, j, kind;
    if (n < 384) { base = 0; j = n; kind = 1; } else if (n < 768) { base = 384; j = n - 384; kind = 1; } else if (n < 1152) { base = 1152; j = n - 768; kind = 0; }
    else if (n < 1408) { base = 1536; j = n - 1152; kind = 2; } else if (n < 1664) { base = 1792; j = n - 1408; kind = 2; } else if (n < 1920) { base = 2304; j = n - 1664; kind = 0; }
    else if (n < 2304) { base = 2560; j = n - 1920; kind = 0; } else if (n < 2688) { base = 2944; j = n - 2304; kind = 0; } else { base = 3712; j = n - 2688; kind = 0; }
    if (kind == 1) { const int d = j & 63; if (d < 16) j = (j & ~63) + ((d & 1) ? 8 + (d >> 1) : (d >> 1)); }
    else if (kind == 2) { const int d = j & 31; if (d < 8) j = (j & ~31) + ((d & 1) ? 4 + (d >> 1) : (d >> 1)); }
    return base + j;
}
__device__ __forceinline__ int src_v(int n) { return n < 384 ? 768 + n : (n < 640 ? 2048 + (n - 384) : 3328 + (n - 640)); }
__device__ __forceinline__ void transpose_item(const float* W, int K, int Nsrc, bf16_t* WT, int Ndst, int mode, int coloff, LAS float* scr, int item, int lane, const float* gain) {
    const int nblk = Ndst / 32, kb = item / nblk, nb = item % nblk, k0 = 64 * kb, n0 = 32 * nb;
    const int nn = n0 + (lane & 31); const int sc = (mode == 1) ? src_main(nn) : ((mode == 2) ? src_v(nn) : coloff + nn);
#pragma unroll 16
    for (int i = 0; i < 32; ++i) { const int kk = 2 * i + (lane >> 5); const float gk = gain ? gain[k0 + kk] : 1.f; scr[kk * 33 + (lane & 31)] = W[(size_t)(k0 + kk) * Nsrc + sc] * gk; }
    asm volatile("s_waitcnt lgkmcnt(0)" ::: "memory");
    const int cc = lane & 7;
#pragma unroll
    for (int j = 0; j < 4; ++j) { const int n = (lane >> 3) + 8 * j; const LAS float* s = scr + (8 * cc) * 33 + n;
        u32x4 o; o.x = cvtpk(s[0 * 33], s[1 * 33]); o.y = cvtpk(s[2 * 33], s[3 * 33]); o.z = cvtpk(s[4 * 33], s[5 * 33]); o.w = cvtpk(s[6 * 33], s[7 * 33]);
        *(u32x4*)(WT + (size_t)(n0 + n) * K + k0 + 8 * cc) = o; }
    asm volatile("s_waitcnt lgkmcnt(0)" ::: "memory");
}
__device__ __forceinline__ void rope_cs(float pos, float chi, float clo, float& cs, float& sn) {
    const float h = pos * chi; float lo = fmaf(pos, chi, -h); lo = fmaf(pos, clo, lo);
    const float fr = (h - floorf(h)) + lo;
    cs = __builtin_amdgcn_cosf(fr); sn = __builtin_amdgcn_sinf(fr);
}

struct Args { const float* in[17]; float* out; unsigned char* ws; int ph_lo, ph_hi; };

__device__ __forceinline__ void prologue(const Args& a, LAS unsigned char* lds, int tid, int lane, int wid) {
    unsigned char* ws = a.ws;
    const int G = gridDim.x, gw = blockIdx.x * 8 + wid, NGW = G * 8;
    LAS float* scr = (LAS float*)(lds + wid * 16384);
    bf16_t* Wb = (bf16_t*)(ws + WS_W);
    constexpr int I_MAIN = 16 * 96, I_V = 16 * 32, I_OUT = 16 * 32, I_XQ = 16 * 16, I_XK = 16 * 16, I_XV = 16 * 16, I_XO = 8 * 32, I_L = I_MAIN + I_V + I_OUT + I_XQ + I_XK + I_XV + I_XO;
    for (int it = gw; it < 2 * I_L; it += NGW) {
        const int l = it / I_L; int r = it % I_L; bf16_t* W = Wb + (size_t)l * W_LAYER;
        const float* w_in = a.in[4] + (size_t)l * 1024 * 4096; const float* w_out = a.in[5] + (size_t)l * 1024 * 1024;
        const float* w_xq = a.in[13] + (size_t)l * 1024 * 512; const float* w_xkv = a.in[14] + (size_t)l * 1024 * 1024; const float* w_xo = a.in[15] + (size_t)l * 512 * 1024;
        if (r < I_MAIN) { transpose_item(w_in, 1024, 4096, W + W_MAIN, 3072, 1, 0, scr, r, lane, a.in[3] + l * DM); continue; } r -= I_MAIN;
        if (r < I_V) { transpose_item(w_in, 1024, 4096, W + W_V, 1024, 2, 0, scr, r, lane, a.in[3] + l * DM); continue; } r -= I_V;
        if (r < I_OUT) { transpose_item(w_out, 1024, 1024, W + W_OUT, 1024, 0, 0, scr, r, lane, nullptr); continue; } r -= I_OUT;
        if (r < I_XQ) { transpose_item(w_xq, 1024, 512, W + W_XQ, 512, 0, 0, scr, r, lane, a.in[11] + l * DM); continue; } r -= I_XQ;
        if (r < I_XK) { transpose_item(w_xkv, 1024, 1024, W + W_XK, 512, 0, 0, scr, r, lane, nullptr); continue; } r -= I_XK;
        if (r < I_XV) { transpose_item(w_xkv, 1024, 1024, W + W_XV, 512, 0, 512, scr, r, lane, nullptr); continue; } r -= I_XV;
        transpose_item(w_xo, 512, 1024, W + W_XO, 1024, 0, 0, scr, r, lane, nullptr);
    }
    {
        const float* x = a.in[0]; bf16_t* hb = (bf16_t*)(ws + WS_HB); float* ssq = (float*)(ws + WS_SSQ);
        for (int row = gw; row < TT; row += 2 * NGW) {
            const int row2 = row + NGW;
            const f32x4* xr = (const f32x4*)(x + (size_t)row * DM) + lane; const f32x4* xr2 = (const f32x4*)(x + (size_t)row2 * DM) + lane;
            f32x4 v[4], v2[4];
#pragma unroll
            for (int j = 0; j < 4; ++j) { v[j] = xr[64 * j]; v2[j] = xr2[64 * j]; }
            float s = 0.f, s2 = 0.f; u32x2* o8 = (u32x2*)(hb + (size_t)row * DM) + lane; u32x2* o82 = (u32x2*)(hb + (size_t)row2 * DM) + lane;
#pragma unroll
            for (int j = 0; j < 4; ++j) {
                u32x2 w; w.x = cvtpk(v[j].x, v[j].y); w.y = cvtpk(v[j].z, v[j].w); o8[64 * j] = w;
                { const float r0 = bflo(w.x), r1 = bfhi(w.x), r2 = bflo(w.y), r3 = bfhi(w.y); s += (r0 * r0 + r1 * r1) + (r2 * r2 + r3 * r3); }
                u32x2 w2; w2.x = cvtpk(v2[j].x, v2[j].y); w2.y = cvtpk(v2[j].z, v2[j].w); o82[64 * j] = w2;
                { const float r0 = bflo(w2.x), r1 = bfhi(w2.x), r2 = bflo(w2.y), r3 = bfhi(w2.y); s2 += (r0 * r0 + r1 * r1) + (r2 * r2 + r3 * r3); }
            }
            s = wave_sum(s); s2 = wave_sum(s2);
            if (lane < 4) { ssq[(size_t)row * 4 + lane] = (lane == 0) ? s : 0.f; ssq[(size_t)row2 * 4 + lane] = (lane == 0) ? s2 : 0.f; }
        }
    }
    for (int it = gw; it < 2 * 1024; it += NGW) {
        const int l = it >> 10, row = it & 1023; const float* g = a.in[12] + l * DM; bf16_t* mo = (bf16_t*)(ws + WS_MEMN) + (size_t)l * 1024 * 1024 + (size_t)row * DM;
        const f32x4* xr = (const f32x4*)(a.in[1] + (size_t)row * DM) + lane; f32x4 v[4]; float s = 0.f;
#pragma unroll
        for (int j = 0; j < 4; ++j) { v[j] = xr[64 * j]; s += (v[j].x * v[j].x + v[j].y * v[j].y) + (v[j].z * v[j].z + v[j].w * v[j].w); }
        const float ri = __builtin_amdgcn_rsqf(wave_sum(s) * (1.f / 1024.f) + RMS_EPS);
#pragma unroll
        for (int j = 0; j < 4; ++j) { const f32x4 gg = *((const f32x4*)g + lane + 64 * j); u32x2 w; w.x = cvtpk(v[j].x * ri * gg.x, v[j].y * ri * gg.y); w.y = cvtpk(v[j].z * ri * gg.z, v[j].w * ri * gg.w); *((u32x2*)mo + lane + 64 * j) = w; }
    }
    {
        const int gt = blockIdx.x * 512 + tid;
        constexpr float ROPE64_HI[8] = {1.591549367e-01f, 3.086376376e-02f, 5.985185504e-03f, 1.160663669e-03f, 2.250790858e-04f, 4.364795313e-05f, 8.464330676e-06f, 1.641426252e-06f};
        constexpr float ROPE64_LO[8] = {6.420638327e-09f, -3.597993882e-10f, 2.087540496e-10f, -2.775752479e-11f, -6.755000964e-12f, -3.416928741e-13f, 1.318804142e-13f, 1.098673667e-14f};
        for (int tk = gt; tk < TT; tk += G * 512) {
            const float pos = (float)((const int*)a.in[2])[tk]; float* c64 = (float*)(ws + WS_CS64) + (size_t)tk * 16; float* c32 = (float*)(ws + WS_CS32) + (size_t)tk * 8;
#pragma unroll
            for (int i = 0; i < 8; ++i) { float cs, sn; rope_cs(pos, ROPE64_HI[i], ROPE64_LO[i], cs, sn); c64[2 * i] = cs; c64[2 * i + 1] = sn; }
#pragma unroll
            for (int i = 0; i < 4; ++i) { float cs, sn; rope_cs(pos, ROPE64_HI[2 * i], ROPE64_LO[2 * i], cs, sn); c32[2 * i] = cs; c32[2 * i + 1] = sn; }
        }
    }
    if (blockIdx.x == 0 && wid == 0) {
        int* ctl = (int*)(ws + WS_CTL);
        if (lane < 16) ctl[lane] = 0;
#pragma unroll
        for (int l = 0; l < 2; ++l) {
            float p1 = 0.f, p2 = 0.f;
            if (lane < 32) { p1 = a.in[6][l * 32 + lane] * a.in[7][l * 32 + lane]; p2 = a.in[8][l * 32 + lane] * a.in[9][l * 32 + lane]; }
            p1 = wave_sum(p1); p2 = wave_sum(p2);
            const float li = 0.8f - 0.6f * expf(-0.3f * (float)l);
            if (lane == 0) { ((float*)ctl)[16 + 2 * l] = expf(p1) - expf(p2) + li; ((float*)ctl)[17 + 2 * l] = 1.f - li; }
        }
    }
}

__device__ __forceinline__ void final_norm(const Args& a, int lane, int wid) {
    const int gw = blockIdx.x * 8 + wid, NGW = gridDim.x * 8; const float* ssq = (const float*)(a.ws + WS_SSQ); const float* g = a.in[16]; const bf16_t* hb = (const bf16_t*)(a.ws + WS_HB);
    f32x4 gv[2][2];
#pragma unroll
    for (int j = 0; j < 2; ++j) { gv[j][0] = *(const f32x4*)(g + 512 * j + lane * 8); gv[j][1] = *(const f32x4*)(g + 512 * j + lane * 8 + 4); }
    for (int row0 = gw; row0 < TT; row0 += 2 * NGW) {
        u32x4 v[2][2]; float ri[2];
#pragma unroll
        for (int q = 0; q < 2; ++q) { const int row = row0 + q * NGW; ri[q] = rinv_row(ssq, row);
#pragma unroll
            for (int j = 0; j < 2; ++j) v[q][j] = *(const u32x4*)(hb + (size_t)row * DM + 512 * j + lane * 8); }
#pragma unroll
        for (int q = 0; q < 2; ++q)
#pragma unroll
            for (int j = 0; j < 2; ++j) {
                const u32x4 w = v[q][j];
                f32x4 o0, o1; o0.x = bflo(w.x); o0.y = bfhi(w.x); o0.z = bflo(w.y); o0.w = bfhi(w.y); o1.x = bflo(w.z); o1.y = bfhi(w.z); o1.z = bflo(w.w); o1.w = bfhi(w.w);
                float* op = a.out + (size_t)(row0 + q * NGW) * DM + 512 * j + lane * 8;
                *(f32x4*)op = o0 * ri[q] * gv[j][0]; *(f32x4*)(op + 4) = o1 * ri[q] * gv[j][1];
            }
    }
}

__device__ __forceinline__ int pi32(int r) { return (r & ~12) | ((r & 4) << 1) | ((r & 8) >> 1); }
constexpr int N_PHASES = 12;
#ifndef PROBE_MIX
#define PROBE_MIX 0
#endif
#ifndef PH_MASK
#define PH_MASK 0x1FF
#endif
__device__ __forceinline__ bf16_t* wlayer(const Args& a, int l) { return (bf16_t*)(a.ws + WS_W) + (size_t)l * W_LAYER; }
__device__ __forceinline__ void make_ctx(ACtx& c, LAS unsigned char* lds) {
    const int tid = tid_opaque(), lane = tid & 63;
    c.tid = tid; c.lane = lane; c.wid = __builtin_amdgcn_readfirstlane(tid >> 6); c.r32 = lane & 31; c.hi = lane >> 5; c.r32p = pi32(lane & 31); c.lds = lds;
}
__device__ __forceinline__ void phase_in(const Args& a, LAS unsigned char* lds, int l) {
    const int G = grid_opaque(), bid = bid_opaque(); unsigned char* ws = a.ws;
    { pg8::Gemm g{(const bf16_t*)(ws + WS_HB), wlayer(a, l) + W_MAIN, TT, 3072, 1024}; pg8::StaticOrder S; S.init(TT, 3072, G, bid);
      EpiIn E{(bf16_t*)(ws + WS_P), (const float*)(ws + WS_SSQ), (const float*)(ws + WS_CS64), (const float*)(ws + WS_CS32), (bf16_t*)(ws + WS_KIMG), (float*)(ws + WS_KMEAN), (bf16_t*)a.out, (bf16_t*)a.out + (size_t)16 * 1024 * 1024};
      pg8::gemm_phase<EpiIn, pg8::StaticOrder, true, true>(lds, g, S, E); }
    { pg8::Gemm g{wlayer(a, l) + W_V, (const bf16_t*)(ws + WS_HB), 1024, TT, 1024}; pg8::StaticOrder S; S.init(1024, TT, G, bid);
      EpiVt E{(bf16_t*)(ws + WS_VT), (const float*)(ws + WS_SSQ)};
      pg8::gemm_phase<EpiVt, pg8::StaticOrder, true, true>(lds, g, S, E); }
}
__device__ __forceinline__ void phase_kmean(const Args& a, LAS unsigned char* lds, int l) {
    const int G = grid_opaque(), bid = bid_opaque(), tid_ = tid_opaque(), lane = tid_ & 63, wid = __builtin_amdgcn_readfirstlane(tid_ >> 6); unsigned char* ws = a.ws;
    for (int it = bid * 8 + wid; it < 768; it += G * 8) kmean_item(it, (const bf16_t*)(ws + WS_KIMG), (bf16_t*)(ws + WS_KMEAN), lane);
    bf16_t* memn = (bf16_t*)(ws + WS_MEMN) + (size_t)l * 1024 * 1024; bf16_t* kx = (bf16_t*)(ws + WS_KX) + (size_t)l * 1024 * 512; bf16_t* vxt = (bf16_t*)(ws + WS_VXT) + (size_t)l * 512 * 1024;
#pragma unroll 1
    for (int j = 0; j < 2; ++j) {
        pg8::Gemm g; g.A = j ? (wlayer(a, l) + W_XV) : memn; g.Bt = j ? memn : (wlayer(a, l) + W_XK); g.M = j ? 512 : 1024; g.N = j ? 1024 : 512; g.K = 1024;
        pg8::StaticOrder S; S.init(g.M, g.N, G, (bid + G - 8 - 16 * j) % G); EpiB16 E{j ? vxt : kx, j ? 1024 : 512, nullptr, 1.f};
        pg8::gemm_phase<EpiB16, pg8::StaticOrder, true, true>(lds, g, S, E);
    }
}
struct OneUnit {
    Unit u;
    __device__ __forceinline__ bool next(int i, Unit& o) const { if (i) return false; o = u; return true; }
    __device__ __forceinline__ void a_ready(const Unit&) const {}
    __device__ __forceinline__ void done(const Unit&) const {}
};
#ifndef MIX_TYPES
#define MIX_TYPES 7
#endif
__device__ __forceinline__ void phase_mix(const Args& a, LAS unsigned char* lds, int l, int rep, int types) {
    volatile LAS int* wq = (volatile LAS int*)(lds + LDS_MISC);
    const int x0 = (int)((unsigned)__builtin_amdgcn_s_getreg((3 << 11) | 20) & 7u);
    int nq = 0;
    for (;;) {
        unsigned char* ws = a.ws; asm volatile("" : "+s"(ws));
        int* ctl = (int*)(ws + WS_CTL);
        const bf16_t* P = (const bf16_t*)(ws + WS_P); const bf16_t* Vt = (const bf16_t*)(ws + WS_VT); bf16_t* mrg = (bf16_t*)(ws + WS_MRG);
        ACtx c; make_ctx(c, lds);
        const int q = (x0 + nq) & 7;
        if (c.tid == 0) *wq = __hip_atomic_fetch_add(ctl + 32 + (l * 2 + rep) * 8 + q, 1, __ATOMIC_RELAXED, __HIP_MEMORY_SCOPE_AGENT);
        __syncthreads();
        const int i = __builtin_amdgcn_readfirstlane(*wq);
        __syncthreads();
        if (i >= 258) { if (++nq >= 8) break; continue; }
        if (i >= 256) {
            const int it = (i - 256) + 2 * q, j = it >> 3, uu = it & 7;
            bf16_t* memn = (bf16_t*)(ws + WS_MEMN) + (size_t)l * 1024 * 1024;
            pg8::Gemm g; g.A = j ? (wlayer(a, l) + W_XV) : memn; g.Bt = j ? memn : (wlayer(a, l) + W_XK); g.M = j ? 512 : 1024; g.N = j ? 1024 : 512; g.K = 1024;
            OneUnit S; S.u.pm = j ? (uu & 1) : (uu & 3); S.u.pn = j ? (uu >> 1) : (uu >> 2);
            EpiB16 E{j ? ((bf16_t*)(ws + WS_VXT) + (size_t)l * 512 * 1024) : ((bf16_t*)(ws + WS_KX) + (size_t)l * 1024 * 512), j ? 1024 : 512, nullptr, 1.f};
            pg8::gemm_phase<EpiB16, OneUnit, true, true>(lds, g, S, E);
            __syncthreads();
            continue;
        }
        int type, bh, qb;
        if (i < 56) { type = 0; qb = 31 - (i >> 1); bh = q + 8 * (i & 1); }
        else if (i < 152) { const int j = i - 56; type = 1; qb = 31 - j / 3; bh = q + 8 * (j % 3); }
        else if (i < 160) { const int j = i - 152; type = 0; qb = 3 - (j >> 1); bh = q + 8 * (j & 1); }
        else { const int j = i - 160; type = 2; qb = 31 - j / 3; bh = q + 8 * (j % 3); }
        if (type == 0) { if (types & 1) diff_unit(c, bh >> 2, bh & 3, qb, P, (const bf16_t*)a.out + (size_t)16 * 1024 * 1024, Vt + (size_t)384 * TT, mrg, ((const float*)ctl)[16 + 2 * l], ((const float*)ctl)[17 + 2 * l], a.in[10] + l * 64); }
        else if (type == 1) { if (types & 2) moba_unit(c, bh / 6, bh % 6, qb, P, (const bf16_t*)(ws + WS_KIMG), Vt, (const float*)(ws + WS_KMEAN), mrg); }
        else if (types & 4) sb_unit(c, bh / 6, bh % 6, qb, P, (const bf16_t*)a.out, Vt + (size_t)640 * TT, mrg);
    }
}
__device__ __forceinline__ void phase_res(const Args& a, LAS unsigned char* lds, int l, bool o) {
    unsigned char* ws = a.ws;
    pg8::Gemm g; g.A = (const bf16_t*)(ws + (o ? WS_MRG : WS_OX)); g.Bt = wlayer(a, l) + (o ? W_OUT : W_XO); g.M = TT; g.N = 1024; g.K = o ? 1024 : 512;
    pg8::StaticOrder S; S.init(TT, 1024, grid_opaque(), bid_opaque());
    EpiRes E; E.h = (bf16_t*)(ws + WS_HB); E.ssq = (float*)(ws + WS_SSQ);
    E.red = (LAS float*)(lds + LDS_RED); E.tid = tid_opaque();
    pg8::gemm_phase<EpiRes, pg8::StaticOrder, true, true>(lds, g, S, E);
}
__device__ __forceinline__ void phase_xq(const Args& a, LAS unsigned char* lds, int l) {
    unsigned char* ws = a.ws;
    pg8::Gemm g{(const bf16_t*)(ws + WS_HB), wlayer(a, l) + W_XQ, TT, 512, 1024}; pg8::StaticOrder S; S.init(TT, 512, grid_opaque(), bid_opaque());
    EpiB16 E{(bf16_t*)(ws + WS_QX), 512, (const float*)(ws + WS_SSQ), 0.08838834764831845f * LOG2E};
    pg8::gemm_phase<EpiB16, pg8::StaticOrder, true, true>(lds, g, S, E);
    asm volatile("s_waitcnt vmcnt(0)" ::: "memory");
    __syncthreads();
    Unit u;
    if (S.next(0, u)) {
        ACtx c; make_ctx(c, lds);
        const bf16_t* kx = (const bf16_t*)(ws + WS_KX) + (size_t)l * 1024 * 512; const bf16_t* vxt = (const bf16_t*)(ws + WS_VXT) + (size_t)l * 512 * 1024;
#pragma unroll 1
        for (int hh = 0; hh < 2; ++hh) xattn_unit(c, u.pm >> 5, 2 * u.pn + hh, u.pm & 31, (const bf16_t*)(ws + WS_QX), kx, vxt, (bf16_t*)(ws + WS_OX));
    }
}
__device__ __forceinline__ void phase_xattn(const Args& a, LAS unsigned char* lds, int l) {
    unsigned char* ws = a.ws; ACtx c; make_ctx(c, lds);
    const bf16_t* kx = (const bf16_t*)(ws + WS_KX) + (size_t)l * 1024 * 512; const bf16_t* vxt = (const bf16_t*)(ws + WS_VXT) + (size_t)l * 512 * 1024;
    for (int i = bid_opaque(); i < 512; i += grid_opaque()) { const int qb = i & 31, bh = i >> 5; xattn_unit(c, bh >> 2, bh & 3, qb, (const bf16_t*)(ws + WS_QX), kx, vxt, (bf16_t*)(ws + WS_OX)); }
}
#define XB_TMO      128
#define XB_XCNT(j)  (256  + 64 * (j))
#define XB_XSUB(j)  (1280 + 64 * (j))
#define XB_XGEN(j)  (2304 + 64 * (j))
#define XB_TOP      3328
#define XB_TOPGEN   3392
#define XCD_BAR_WORDS 3456
#define XB_SPIN_CAP (1u << 18)

__device__ __forceinline__ unsigned xb_ld(unsigned* p)              { return __hip_atomic_load(p, __ATOMIC_RELAXED, __HIP_MEMORY_SCOPE_AGENT); }
__device__ __forceinline__ unsigned xb_add(unsigned* p, unsigned v) { return __hip_atomic_fetch_add(p, v, __ATOMIC_RELAXED, __HIP_MEMORY_SCOPE_AGENT); }
__device__ __forceinline__ unsigned xb_xcc_id() { return (unsigned)__builtin_amdgcn_s_getreg((3 << 11) | 20) & 0xFu; }
#define XB_SPIN(cond, bar) do { unsigned _sp = 0; while (cond) { __builtin_amdgcn_s_sleep(1); \
    if ((++_sp & 255u) == 0u) { if (xb_ld(&(bar)[XB_TMO])) break; if (_sp > XB_SPIN_CAP) { atomicAdd(&(bar)[XB_TMO], 1u); break; } } } } while (0)

struct XcdBarrier {
    unsigned* bar; unsigned x;
    volatile LAS unsigned* st;
};

__device__ __forceinline__ XcdBarrier xcd_barrier_post(unsigned* bar, volatile LAS unsigned* st) {
    XcdBarrier b; b.bar = bar; b.x = xb_xcc_id(); b.st = st;
    if (threadIdx.x == 0) (void)xb_add(&bar[XB_XCNT(b.x)], 1u);
    return b;
}
__device__ __forceinline__ void xcd_barrier_complete(unsigned* bar, unsigned x, unsigned& nloc, unsigned& nx) {
    const unsigned G = gridDim.x * gridDim.y * gridDim.z;
    unsigned sum, cnt, mine, sp = 0u;
    for (;;) {
        sum = 0u; cnt = 0u; mine = 0u;
#pragma unroll
        for (unsigned j = 0; j < 16; ++j) { const unsigned c = xb_ld(&bar[XB_XCNT(j)]); sum += c; cnt += (c > 0u) ? 1u : 0u; mine = (j == x) ? c : mine; }
        if (sum == G) break;
        __builtin_amdgcn_s_sleep(1);
        if ((++sp & 255u) == 0u) { if (xb_ld(&bar[XB_TMO])) break; if (sp > XB_SPIN_CAP) { atomicAdd(&bar[XB_TMO], 1u); break; } }
    }
    nloc = mine > 0u ? mine : 1u; nx = cnt > 0u ? cnt : 1u;
}

__device__ __forceinline__ void xcd_barrier(const XcdBarrier& b) {
    asm volatile("s_waitcnt vmcnt(0)" ::: "memory");
    __syncthreads();
    if (threadIdx.x == 0) {
        unsigned* bar = b.bar;
        __builtin_amdgcn_s_waitcnt(0);
        unsigned nloc = b.st[0], nx = b.st[1];
        if (nloc == 0u) { xcd_barrier_complete(bar, b.x, nloc, nx); b.st[0] = nloc; b.st[1] = nx; }
        const unsigned old = xb_add(&bar[XB_XSUB(b.x)], 1u);
        const unsigned gen = old / nloc;
        if (old + 1u == (gen + 1u) * nloc) {
            __builtin_amdgcn_fence(__ATOMIC_RELEASE, "agent");
            asm volatile("s_waitcnt vmcnt(0)" ::: "memory");
            const unsigned og = xb_add(&bar[XB_TOP], 1u);
            const unsigned tg = og / nx;
            if (og + 1u == (tg + 1u) * nx) xb_add(&bar[XB_TOPGEN], 1u);
            else XB_SPIN(xb_ld(&bar[XB_TOPGEN]) == tg, bar);
            __builtin_amdgcn_fence(__ATOMIC_ACQUIRE, "agent");
            xb_add(&bar[XB_XGEN(b.x)], 1u);
            asm volatile("s_waitcnt vmcnt(0)" ::: "memory");
        } else {
            XB_SPIN(xb_ld(&bar[XB_XGEN(b.x)]) == gen, bar);
            __builtin_amdgcn_fence(__ATOMIC_ACQUIRE, "agent");
            asm volatile("s_waitcnt vmcnt(0)" ::: "memory");
        }
    }
    __syncthreads();
}


__device__ __forceinline__ void grid_bar(unsigned* bar, unsigned k) {
    asm volatile("s_waitcnt vmcnt(0)" ::: "memory");
    __syncthreads();
    if (threadIdx.x == 0) {
        __builtin_amdgcn_fence(__ATOMIC_RELEASE, "agent");
        asm volatile("s_waitcnt vmcnt(0)" ::: "memory");
        const unsigned G = gridDim.x, g = blockIdx.x & 7u, ng = (G - g + 7u) >> 3;
        unsigned* sub = bar + 64 * (1 + g); unsigned* gen = bar + 64 * (9 + g); unsigned* top = bar + 64 * 17;
        const unsigned old = __hip_atomic_fetch_add(sub, 1u, __ATOMIC_RELAXED, __HIP_MEMORY_SCOPE_AGENT);
        if (old + 1u == k * ng) {
            const unsigned oldt = __hip_atomic_fetch_add(top, 1u, __ATOMIC_RELAXED, __HIP_MEMORY_SCOPE_AGENT);
            if (oldt + 1u == k * 8u) {
#pragma unroll
                for (int gg = 0; gg < 8; ++gg) __hip_atomic_store(bar + 64 * (9 + gg), k, __ATOMIC_RELAXED, __HIP_MEMORY_SCOPE_AGENT);
            }
        }
        while (__hip_atomic_load(gen, __ATOMIC_RELAXED, __HIP_MEMORY_SCOPE_AGENT) < k) __builtin_amdgcn_s_sleep(2);
        __builtin_amdgcn_fence(__ATOMIC_ACQUIRE, "agent");
        asm volatile("s_waitcnt vmcnt(0)" ::: "memory");
    }
    __syncthreads();
}
__global__ void __launch_bounds__(512, 2) fwd_kernel(Args a) {
    extern __shared__ __attribute__((aligned(16))) unsigned char lds_raw[];
    LAS unsigned char* lds = (LAS unsigned char*)lds_raw;
    volatile LAS unsigned* xst = (volatile LAS unsigned*)(lds + LDS_MISC + 256);
    if (threadIdx.x == 0) { xst[0] = 0u; xst[1] = 0u; }
    __syncthreads();
    XcdBarrier xbar = xcd_barrier_post((unsigned*)(a.ws + WS_CTL) + 1024, xst);
#pragma unroll 1
    for (int ph = a.ph_lo; ph < a.ph_hi; ++ph) {
        if (ph == 0) { const int t_ = tid_opaque(); prologue(a, lds, t_, t_ & 63, __builtin_amdgcn_readfirstlane(t_ >> 6)); }
        else if (ph == N_PHASES - 1) { const int t_ = tid_opaque(); final_norm(a, t_ & 63, __builtin_amdgcn_readfirstlane(t_ >> 6)); }
        else {
            const int l = (ph - 1) / 5, r = (ph - 1) % 5;
            if (r == 0) { if (PH_MASK & 1) phase_in(a, lds, l); }
            else if (r == 1) { phase_mix(a, lds, l, 0, MIX_TYPES);
#if PROBE_MIX
                __syncthreads(); phase_mix(a, lds, l, 1, PROBE_MIX);
#endif
            }
            else if (r == 2 || r == 4) { if (PH_MASK & 8) phase_res(a, lds, l, r == 2); }
            else { if (PH_MASK & 16) phase_xq(a, lds, l); }
        }
        if (ph + 1 < a.ph_hi) {
            if (a.ph_hi > 4096) cg::this_grid().sync();
            xcd_barrier(xbar);
        }
    }
}

#ifndef MK_PER_PHASE
#define MK_PER_PHASE 0
#endif
extern "C" void kernel_launch(void* const* d_in, const int* in_sizes, int n_in, void* d_out, int out_size, void* d_ws, size_t ws_size, hipStream_t stream) {
    static int grid = 0;
    if (grid == 0) {
        if (n_in != 17 || out_size != TT * DM || ws_size < WS_END) { fprintf(stderr, "kernel_launch: unexpected shapes (n_in %d out %d ws %zu)\n", n_in, out_size, ws_size); grid = -1; return; }
        int dev = 0, cus = 0, per_cu = 0;
        if (hipGetDevice(&dev) != hipSuccess || hipDeviceGetAttribute(&cus, hipDeviceAttributeMultiprocessorCount, dev) != hipSuccess) { grid = -1; return; }
        if (hipFuncSetAttribute((const void*)fwd_kernel, hipFuncAttributeMaxDynamicSharedMemorySize, LDS_BYTES) != hipSuccess) { fprintf(stderr, "kernel_launch: hipFuncSetAttribute failed\n"); grid = -1; return; }
        if (hipOccupancyMaxActiveBlocksPerMultiprocessor(&per_cu, (const void*)fwd_kernel, 512, LDS_BYTES) != hipSuccess || per_cu < 1) { fprintf(stderr, "kernel_launch: occupancy query says %d\n", per_cu); (void)hipGetLastError(); }
        grid = cus;
    }
    if (grid < 0) return;
    Args a{};
    for (int i = 0; i < 17; ++i) a.in[i] = (const float*)d_in[i];
    a.out = (float*)d_out; a.ws = (unsigned char*)d_ws;
#if MK_PER_PHASE
    for (int ph = 0; ph < N_PHASES; ++ph) { a.ph_lo = ph; a.ph_hi = ph + 1; hipLaunchKernelGGL(fwd_kernel, dim3(grid), dim3(512), LDS_BYTES, stream, a); }
#else
    a.ph_lo = 0; a.ph_hi = N_PHASES;
    (void)hipMemsetAsync(d_ws, 0, 32768, stream);
    void* args[] = {&a};
    hipError_t e = hipLaunchCooperativeKernel((const void*)fwd_kernel, dim3(grid), dim3(512), args, LDS_BYTES, stream);
    if (e != hipSuccess) fprintf(stderr, "kernel_launch: cooperative launch failed: %s (grid %d)\n", hipGetErrorString(e), grid);
#endif
}
```

```cpp
#include <hip/hip_runtime.h>
#include <hip/hip_cooperative_groups.h>
#include <cstdio>
#include <cstdint>
namespace cg = cooperative_groups;
__device__ __forceinline__ int tid_opaque() { int t = threadIdx.x; asm volatile("" : "+v"(t)); return t; }
__device__ __forceinline__ int bid_opaque() { int b = blockIdx.x; asm volatile("" : "+s"(b)); return b; }
__device__ __forceinline__ int grid_opaque() { int b = gridDim.x; asm volatile("" : "+s"(b)); return b; }
namespace pg8 {
#define PG8_LAS __attribute__((address_space(3)))
typedef unsigned short bf16_t;
typedef short bf16x8 __attribute__((ext_vector_type(8)));
typedef float f32x4 __attribute__((ext_vector_type(4)));
typedef unsigned u32x4 __attribute__((ext_vector_type(4)));
constexpr int BM = 256, BK = 64, HALF = 128, HTB = HALF * BK * 2  , STAGE_BYTES = 8 * HTB, NXCD = 8, WGM = 8;

__host__ __device__ __forceinline__ int lds_byte(int r, int c) { const int st = (r >> 4) * 2 + (c >> 5), rr = r & 15, cc = c & 31, ob = rr * 64 + cc * 2; return st * 1024 + (ob ^ (((ob >> 9) & 1) << 5)); }
__host__ __device__ __forceinline__ void stage_rc(int b, int& R, int& C) { const int st = b / 1024, sb = b % 1024, swz = sb ^ (((sb >> 9) & 1) << 5); R = (st >> 1) * 16 + swz / 64; C = (st & 1) * 32 + (swz % 64) / 2; }
__host__ __device__ __forceinline__ int perm32(int rho) { const int n = rho >> 4, i = rho & 15; return 8 * (i >> 2) + 4 * n + (i & 3); }

struct Unit { int pm, pn; };
struct Gemm { const bf16_t* A; const bf16_t* Bt; int M, N, K; };

struct StaticOrder {
    int nM, nN, nwg, G, c;
    __host__ __device__ void init(int M, int N, int G_, int c_) { nM = M / BM; nN = N / BM; nwg = nM * nN; G = G_; c = c_; }
    __host__ __device__ bool next(int i, Unit& u) const {
        const long L = (long)i * G + c; if (L >= nwg) return false;
        int wgid = (int)L; { const int q = nwg / NXCD, r = nwg % NXCD, xcd = wgid % NXCD, off = wgid / NXCD; wgid = (xcd < r ? xcd * (q + 1) : r * (q + 1) + (xcd - r) * q) + off; }
        const int nig = WGM * nN, gid = wgid / nig, fm = gid * WGM, gsz = (nM - fm) < WGM ? (nM - fm) : WGM;
        u.pm = fm + ((wgid % nig) % gsz); u.pn = (wgid % nig) / gsz; return true;
    }
    __device__ __forceinline__ void a_ready(const Unit&) const {}
    __device__ __forceinline__ void done(const Unit&) const {}
};

__device__ __forceinline__ unsigned cvt_pk_bf16(float lo, float hi) { unsigned r; asm volatile("v_cvt_pk_bf16_f32 %0, %1, %2" : "=v"(r) : "v"(lo), "v"(hi)); return r; }
typedef float f32x2 __attribute__((ext_vector_type(2)));
template <class Epi, class Sched, bool ALIGN_EPI = false, bool SP2 = false>
__device__ __forceinline__ void gemm_phase(PG8_LAS unsigned char* lds, const Gemm g, const Sched& S, const Epi& E) {
    const int tid = tid_opaque(), wid = __builtin_amdgcn_readfirstlane(tid >> 6), lane = tid & 63, wr = wid >> 2, wc = wid & 3, fr = lane & 15, fq = lane >> 4;
    const int K = g.K, nt = K / BK;
    unsigned voffA[2], voffB[2];
#pragma unroll
    for (int i = 0; i < 2; ++i) { int R, C; stage_rc(tid * 16 + i * 8192, R, C); const int Rb = Epi::PERM ? ((R & ~31) + perm32(R & 31)) : R;
        voffA[i] = (unsigned)(R * K + C) * 2u; voffB[i] = (unsigned)(Rb * K + C) * 2u; }
    const size_t kstep = (size_t)(BK * 2);
    const size_t hstep = (size_t)HALF * K * 2;
    const size_t tstep = 2 * hstep;
    const unsigned ldsw = (unsigned)wid * 1024u;
    const int aoff = lds_byte(wr * 64 + fr, fq * 8), boff = lds_byte(wc * 32 + fr, fq * 8);
#define PG8_SA(b, h) (((b) * 2 + (h)) * HTB)
#define PG8_SB(b, h) ((4 + (b) * 2 + (h)) * HTB)
#define PG8_STAGE(bufoff, gbase, voff) do { _Pragma("unroll") for (int _i = 0; _i < 2; ++_i) \
        __builtin_amdgcn_global_load_lds((const unsigned*)((const char*)(gbase) + (voff)[_i]), (PG8_LAS unsigned*)(lds + (bufoff) + ldsw + _i * 8192), 16, 0, 0); } while (0)
#define PG8_LDA(dst, b, h) do { _Pragma("unroll") for (int m = 0; m < 4; ++m) _Pragma("unroll") for (int k = 0; k < 2; ++k) dst[m][k] = *(const PG8_LAS bf16x8*)(lds + PG8_SA(b, h) + aoff + m * 2048 + k * 1024); } while (0)
#define PG8_LDB(dst, b, h) do { _Pragma("unroll") for (int n = 0; n < 2; ++n) _Pragma("unroll") for (int k = 0; k < 2; ++k) dst[n][k] = *(const PG8_LAS bf16x8*)(lds + PG8_SB(b, h) + boff + n * 2048 + k * 1024); } while (0)
#define PG8_MMA(ai, bj, At, Bt) do { __builtin_amdgcn_s_setprio(1); _Pragma("unroll") for (int m = 0; m < 4; ++m) _Pragma("unroll") for (int n = 0; n < 2; ++n) _Pragma("unroll") for (int k = 0; k < 2; ++k) \
        acc[ai][bj][m][n] = __builtin_amdgcn_mfma_f32_16x16x32_bf16(Bt[n][k], At[m][k], acc[ai][bj][m][n], 0, 0, 0); __builtin_amdgcn_s_setprio(0); } while (0)
#define PG8_WAIT_V(n) asm volatile("s_waitcnt vmcnt(" #n ")" ::: "memory")
#define PG8_WAIT_L(n) asm volatile("s_waitcnt lgkmcnt(" #n ")" ::: "memory")
#define PG8_BAR __builtin_amdgcn_s_barrier()
#define PG8_SCHED __builtin_amdgcn_sched_barrier(0)
    Unit cur, nxt; int ui = 0;
    if (!S.next(0, cur)) return;
    f32x4 acc[2][2][4][2];
#pragma unroll
    for (int a = 0; a < 2; ++a)
#pragma unroll
        for (int b = 0; b < 2; ++b)
#pragma unroll
            for (int m = 0; m < 4; ++m)
#pragma unroll
                for (int n = 0; n < 2; ++n) acc[a][b][m][n] = (f32x4){0.f, 0.f, 0.f, 0.f};
    bf16x8 At[4][2], B0[2][2], B1[2][2];
    const char* cA = (const char*)g.A + (size_t)cur.pm * tstep; const char* cB = (const char*)g.Bt + (size_t)cur.pn * tstep;
    S.a_ready(cur);
    if constexpr (SP2) {
        PG8_STAGE(PG8_SB(0, 0), cB, voffB); PG8_STAGE(PG8_SB(0, 1), cB + hstep, voffB); PG8_STAGE(PG8_SA(0, 0), cA, voffA); PG8_STAGE(PG8_SA(0, 1), cA + hstep, voffA);
        if (wr == 1) PG8_BAR;
        PG8_WAIT_V(2); PG8_BAR;
        PG8_STAGE(PG8_SB(1, 0), cB + kstep, voffB); PG8_STAGE(PG8_SA(1, 0), cA + kstep, voffA); PG8_STAGE(PG8_SB(1, 1), cB + hstep + kstep, voffB);
        PG8_WAIT_V(6); PG8_BAR;
    } else {
        PG8_STAGE(PG8_SB(0, 0), cB, voffB); PG8_STAGE(PG8_SA(0, 0), cA, voffA); PG8_STAGE(PG8_SB(0, 1), cB + hstep, voffB); PG8_STAGE(PG8_SA(0, 1), cA + hstep, voffA);
        if (wr == 1) PG8_BAR;
        PG8_WAIT_V(4); PG8_BAR;
        PG8_STAGE(PG8_SB(1, 0), cB + kstep, voffB); PG8_STAGE(PG8_SA(1, 0), cA + kstep, voffA); PG8_STAGE(PG8_SB(1, 1), cB + hstep + kstep, voffB);
        PG8_WAIT_V(6); PG8_BAR;
    }
    for (;;) {
        const bool has_next = S.next(ui + 1, nxt);
        const char* nA = has_next ? (const char*)g.A + (size_t)nxt.pm * tstep : cA; const char* nB = has_next ? (const char*)g.Bt + (size_t)nxt.pn * tstep : cB;
        for (int t = 0; t < nt; t += 2) {
            const bool last = (t == nt - 2);
            const char* a1 = cA + (size_t)(t + 1) * kstep;
            const char* a2 = last ? nA : cA + (size_t)(t + 2) * kstep; const char* b2 = last ? nB : cB + (size_t)(t + 2) * kstep;
            const char* a3 = a2 + kstep; const char* b3 = b2 + kstep;
            if (last && has_next) S.a_ready(nxt);
            if constexpr (SP2) {
            PG8_LDB(B0, 0, 0); PG8_LDB(B1, 0, 1); PG8_SCHED; PG8_LDA(At, 0, 0); PG8_STAGE(PG8_SA(1, 1), a1 + hstep, voffA);
            PG8_WAIT_V(8); PG8_WAIT_L(0); PG8_BAR; PG8_MMA(0, 0, At, B0); PG8_MMA(0, 1, At, B1); PG8_BAR; PG8_SCHED;
            PG8_LDA(At, 0, 1); PG8_STAGE(PG8_SB(0, 0), b2, voffB); PG8_STAGE(PG8_SB(0, 1), b2 + hstep, voffB); PG8_STAGE(PG8_SA(0, 0), a2, voffA);
            PG8_WAIT_V(8); PG8_WAIT_L(0); PG8_BAR; PG8_MMA(1, 0, At, B0); PG8_MMA(1, 1, At, B1); PG8_BAR; PG8_SCHED;
            PG8_LDB(B0, 1, 0); PG8_LDB(B1, 1, 1); PG8_SCHED; PG8_LDA(At, 1, 0); PG8_STAGE(PG8_SA(0, 1), a2 + hstep, voffA);
            PG8_WAIT_V(8); PG8_WAIT_L(0); PG8_BAR; PG8_MMA(0, 0, At, B0); PG8_MMA(0, 1, At, B1); PG8_BAR; PG8_SCHED;
            PG8_LDA(At, 1, 1); PG8_STAGE(PG8_SB(1, 0), b3, voffB); PG8_STAGE(PG8_SB(1, 1), b3 + hstep, voffB); PG8_STAGE(PG8_SA(1, 0), a3, voffA);
            PG8_WAIT_V(8); PG8_WAIT_L(0); PG8_BAR; PG8_MMA(1, 0, At, B0); PG8_MMA(1, 1, At, B1); PG8_BAR; PG8_SCHED;
            } else {
            PG8_LDB(B0, 0, 0); PG8_SCHED; PG8_LDA(At, 0, 0); PG8_STAGE(PG8_SA(1, 1), a1 + hstep, voffA);
            PG8_WAIT_L(8); PG8_BAR; PG8_WAIT_L(0); PG8_MMA(0, 0, At, B0); PG8_BAR; PG8_SCHED;
            PG8_LDB(B1, 0, 1); PG8_STAGE(PG8_SB(0, 0), b2, voffB);
            PG8_BAR; PG8_WAIT_L(0); PG8_MMA(0, 1, At, B1); PG8_BAR;
            PG8_LDA(At, 0, 1); PG8_STAGE(PG8_SA(0, 0), a2, voffA);
            PG8_BAR; PG8_WAIT_L(0); PG8_MMA(1, 0, At, B0); PG8_BAR; PG8_SCHED;
            PG8_STAGE(PG8_SB(0, 1), b2 + hstep, voffB);
            PG8_WAIT_V(6); PG8_BAR; PG8_MMA(1, 1, At, B1); PG8_BAR;
            PG8_LDB(B0, 1, 0); PG8_SCHED; PG8_LDA(At, 1, 0); PG8_STAGE(PG8_SA(0, 1), a2 + hstep, voffA);
            PG8_WAIT_L(8); PG8_BAR; PG8_WAIT_L(0); PG8_MMA(0, 0, At, B0); PG8_BAR; PG8_SCHED;
            PG8_LDB(B1, 1, 1); PG8_STAGE(PG8_SB(1, 0), b3, voffB);
            PG8_BAR; PG8_WAIT_L(0); PG8_MMA(0, 1, At, B1); PG8_BAR;
            PG8_LDA(At, 1, 1); PG8_STAGE(PG8_SA(1, 0), a3, voffA);
            PG8_BAR; PG8_WAIT_L(0); PG8_MMA(1, 0, At, B0); PG8_BAR; PG8_SCHED;
            PG8_STAGE(PG8_SB(1, 1), b3 + hstep, voffB);
            PG8_WAIT_V(6); PG8_BAR; PG8_MMA(1, 1, At, B1); PG8_BAR;
            }
        }
        if constexpr (ALIGN_EPI) { if (wr == 0) PG8_BAR; }
        if constexpr (!Epi::AFTER_DRAIN) { E(acc, cur, wr, wc, fr, fq); S.done(cur); }
        if (!has_next) break;
#pragma unroll
        for (int a = 0; a < 2; ++a)
#pragma unroll
            for (int b = 0; b < 2; ++b)
#pragma unroll
                for (int m = 0; m < 4; ++m)
#pragma unroll
                    for (int n = 0; n < 2; ++n) acc[a][b][m][n] = (f32x4){0.f, 0.f, 0.f, 0.f};
        cur = nxt; cA = nA; cB = nB; ++ui;
        if constexpr (ALIGN_EPI) { if (wr == 1) PG8_BAR; }
    }
    PG8_WAIT_V(0);
    if constexpr (!ALIGN_EPI) { if (wr == 0) PG8_BAR; }
    PG8_BAR;
    if constexpr (Epi::AFTER_DRAIN) { E.fused(acc, cur, wr, wc, fr, fq, lds, wid, lane); S.done(cur); }
#undef PG8_SA
#undef PG8_SB
#undef PG8_STAGE
#undef PG8_LDA
#undef PG8_LDB
#undef PG8_MMA
#undef PG8_WAIT_V
#undef PG8_WAIT_L
#undef PG8_BAR
#undef PG8_SCHED
}
}

using pg8::bf16_t; using pg8::bf16x8; using pg8::f32x4; using pg8::u32x4; using pg8::Unit;
typedef float f32x16 __attribute__((ext_vector_type(16)));
typedef unsigned u32x2 __attribute__((ext_vector_type(2)));
typedef float f32x2_t __attribute__((ext_vector_type(2)));
typedef __bf16 bf16x2_t __attribute__((ext_vector_type(2)));
#define LAS __attribute__((address_space(3)))
constexpr int TT = 32768, DM = 1024, SEQ = 8192, NBATCH = 4, MEML = 256;
constexpr int PW = 3072;
constexpr float RMS_EPS = 1e-6f;
constexpr float LOG2E = 1.4426950408889634f;
constexpr float NEGF = -1.0e30f;
constexpr size_t MiB = (size_t)1 << 20;
constexpr size_t WS_CTL = 0, WS_SSQ = 1 * MiB, WS_CS64 = 3 * MiB, WS_CS32 = 5 * MiB, WS_KMEAN = 6 * MiB, WS_MEMN = 8 * MiB, WS_KX = 12 * MiB, WS_VXT = 14 * MiB,
                 WS_W = 16 * MiB, WS_HB = 48 * MiB, WS_P = 112 * MiB, WS_VT = 304 * MiB, WS_MRG = 368 * MiB, WS_QX = 432 * MiB, WS_OX = 432 * MiB  , WS_KIMG = 464 * MiB, WS_END = 496 * MiB;
constexpr size_t W_MAIN = 0, W_V = (size_t)3072 * 1024, W_OUT = W_V + (size_t)1024 * 1024, W_XQ = W_OUT + (size_t)1024 * 1024, W_XK = W_XQ + (size_t)512 * 1024,
                 W_XV = W_XK + (size_t)512 * 1024, W_XO = W_XV + (size_t)512 * 1024, W_LAYER = W_XO + (size_t)1024 * 512;
static_assert(W_LAYER * 2 * 2 <= 32 * MiB, "weights fit");
constexpr int LDS_BYTES = 155648;
constexpr int LDS_MISC = 143360, LDS_RED = 143360 + 1024;

__device__ __forceinline__ unsigned cvtpk(float lo, float hi) { f32x2_t v = {lo, hi}; bf16x2_t b = __builtin_convertvector(v, bf16x2_t); return __builtin_bit_cast(unsigned, b); }
__device__ __forceinline__ float bflo(unsigned w) { return __uint_as_float(w << 16); }
__device__ __forceinline__ float bfhi(unsigned w) { return __uint_as_float(w & 0xffff0000u); }
__device__ __forceinline__ float ex2(float x) { return __builtin_amdgcn_exp2f(x); }
__device__ __forceinline__ float lg2(float x) { return __builtin_amdgcn_logf(x); }
__device__ __forceinline__ float rinv_row(const float* ssq, int row) {
    const f32x4 s = *(const f32x4*)(ssq + (size_t)row * 4);
    return __builtin_amdgcn_rsqf(((s.x + s.y) + (s.z + s.w)) * (1.f / 1024.f) + RMS_EPS);
}
__device__ __forceinline__ float silu_f(float y) { return y * __builtin_amdgcn_rcpf(1.f + ex2(-y * LOG2E)); }
#define ROT2(x1, x2, c, s) do { const float a_ = (x1) * (c) - (x2) * (s), b_ = (x2) * (c) + (x1) * (s); (x1) = a_; (x2) = b_; } while (0)

struct EpiIn {
    static constexpr bool PERM = true, AFTER_DRAIN = false;
    bf16_t* P; const float* ssq; const float* cs64; const float* cs32; bf16_t* Kimg; float* kpart; bf16_t* Ksb; bf16_t* Kdf;
    __device__ __forceinline__ void operator()(const f32x4 (&acc)[2][2][4][2], const Unit& u, int wr, int wc, int fr, int fq) const {
        const int row0 = u.pm * 256 + wr * 64 + fr;
        float rinv[2][4];
#pragma unroll
        for (int ai = 0; ai < 2; ++ai)
#pragma unroll
            for (int m = 0; m < 4; ++m) rinv[ai][m] = rinv_row(ssq, row0 + ai * 128 + m * 16);
#pragma unroll
        for (int bj = 0; bj < 2; ++bj) {
            const int seg = u.pn * 2 + bj;
            const int c0 = seg * 128 + wc * 32 + fq * 8;
            int kind; float sc = 1.f;
            if (seg < 3) { kind = 1; sc = 0.125f * LOG2E; } else if (seg < 6) { kind = 1; } else if (seg < 9) { kind = 3; }
            else if (seg < 11) { kind = 2; sc = 0.17677669529663687f * LOG2E; } else if (seg < 13) { kind = 2; } else if (seg < 15) { kind = 3; }
            else if (seg < 18) { kind = 0; sc = 0.125f * LOG2E; } else if (seg < 21) { kind = 0; } else { kind = 3; }
            const bool rope = (kind == 1 && (c0 & 63) < 16) || (kind == 2 && (c0 & 31) == 0);
            f32x4 cs0 = {0.f, 0.f, 0.f, 0.f}, cs1 = {0.f, 0.f, 0.f, 0.f};
#pragma unroll
            for (int ai = 0; ai < 2; ++ai)
#pragma unroll
                for (int m = 0; m < 4; ++m) {
                    const int row = row0 + ai * 128 + m * 16; const float s = rinv[ai][m];
                    f32x4 v0 = acc[ai][bj][m][0] * s, v1 = acc[ai][bj][m][1] * s;
                    if (kind == 3) {
                        v0.x = silu_f(v0.x); v0.y = silu_f(v0.y); v0.z = silu_f(v0.z); v0.w = silu_f(v0.w);
                        v1.x = silu_f(v1.x); v1.y = silu_f(v1.y); v1.z = silu_f(v1.z); v1.w = silu_f(v1.w);
                    } else {
                        if (rope) {
                            const float* t = (kind == 1) ? (cs64 + (size_t)row * 16 + (c0 & 63)) : (cs32 + (size_t)row * 8);
                            const f32x4 t0 = *(const f32x4*)t, t1 = *(const f32x4*)(t + 4);
                            ROT2(v0.x, v0.y, t0.x, t0.y); ROT2(v0.z, v0.w, t0.z, t0.w); ROT2(v1.x, v1.y, t1.x, t1.y); ROT2(v1.z, v1.w, t1.z, t1.w);
                        }
                        v0 = v0 * sc; v1 = v1 * sc;
                        cs0 = cs0 + v0; cs1 = cs1 + v1;
                    }
                    u32x4 w; w.x = cvtpk(v0.x, v0.y); w.y = cvtpk(v0.z, v0.w); w.z = cvtpk(v1.x, v1.y); w.w = cvtpk(v1.z, v1.w);
                    bf16_t* dst = P + (size_t)row * PW + c0;
                    if (seg >= 3 && seg < 6) {
                        const int cc = c0 - 384, hh = cc >> 6, ch = (cc & 63) >> 3, bb = row >> 13, s = row & 8191;
                        dst = Kimg + ((((size_t)(bb * 6 + hh) * 128 + (s >> 6)) * 8 + ch) * 64 + (s & 63)) * 8;
                    }
                    if (seg >= 11 && seg < 13) {
                        const int cc = c0 - 1408, hh = cc >> 6, ch = (cc & 63) >> 3, bb = row >> 13, s = row & 8191;
                        dst = Kdf + ((((size_t)(bb * 4 + hh) * 128 + (s >> 6)) * 8 + ch) * 64 + (s & 63)) * 8;
                    }
                    if (seg >= 18 && seg < 21) {
                        const int cc = c0 - 2304, hh = cc >> 6, ch = (cc & 63) >> 3, bb = row >> 13, s = row & 8191;
                        dst = Ksb + ((((size_t)(bb * 6 + hh) * 128 + (s >> 6)) * 8 + ch) * 64 + (s & 63)) * 8;
                    }
                    *(u32x4*)dst = w;
                }
            if (seg >= 3 && seg < 6) {
#pragma unroll
                for (int o = 1; o < 16; o <<= 1) {
                    cs0.x += __shfl_xor(cs0.x, o); cs0.y += __shfl_xor(cs0.y, o); cs0.z += __shfl_xor(cs0.z, o); cs0.w += __shfl_xor(cs0.w, o);
                    cs1.x += __shfl_xor(cs1.x, o); cs1.y += __shfl_xor(cs1.y, o); cs1.z += __shfl_xor(cs1.z, o); cs1.w += __shfl_xor(cs1.w, o);
                }
                if (fr == 0) {
                    const int cc = c0 - 384, hh = cc >> 6, bb = u.pm >> 5, blk = u.pm & 31;
                    float* kp = kpart + ((((size_t)(bb * 6 + hh) * 32 + blk) * 2 + wr) * 64 + (cc & 63));
                    *(f32x4*)kp = cs0; *(f32x4*)(kp + 4) = cs1;
                }
            }
        }
    }
};
struct EpiVt {
    static constexpr bool PERM = true, AFTER_DRAIN = false;
    bf16_t* Vt; const float* ssq;
    __device__ __forceinline__ void operator()(const f32x4 (&acc)[2][2][4][2], const Unit& u, int wr, int wc, int fr, int fq) const {
        const int row0 = u.pm * 256 + wr * 64 + fr;
#pragma unroll
        for (int bj = 0; bj < 2; ++bj) {
            const int c0 = u.pn * 256 + bj * 128 + wc * 32 + fq * 8;
            float ri[8];
#pragma unroll
            for (int j = 0; j < 8; ++j) ri[j] = rinv_row(ssq, c0 + j);
#pragma unroll
            for (int ai = 0; ai < 2; ++ai)
#pragma unroll
                for (int m = 0; m < 4; ++m) {
                    const int row = row0 + ai * 128 + m * 16;
                    const f32x4 v0 = acc[ai][bj][m][0], v1 = acc[ai][bj][m][1];
                    u32x4 w; w.x = cvtpk(v0.x * ri[0], v0.y * ri[1]); w.y = cvtpk(v0.z * ri[2], v0.w * ri[3]); w.z = cvtpk(v1.x * ri[4], v1.y * ri[5]); w.w = cvtpk(v1.z * ri[6], v1.w * ri[7]);
                    bf16_t* dst = Vt + (size_t)row * TT + c0;
                    if (2 * u.pm + ai < 3) {
                        const int hh = row >> 6, d = row & 63, bb = c0 >> 13, s = c0 & 8191;
                        dst = Vt + ((((size_t)(bb * 6 + hh) * 128 + (s >> 6)) * 8 + ((s & 63) >> 3)) * 64 + d) * 8;
                    }
                    if (2 * u.pm + ai == 3 || 2 * u.pm + ai == 4) {
                        const int rr = row - 384, hh = rr >> 6, d = rr & 63, bb = c0 >> 13, s = c0 & 8191;
                        dst = Vt + (size_t)384 * TT + ((((size_t)(bb * 4 + hh) * 128 + (s >> 6)) * 8 + ((s & 63) >> 3)) * 64 + d) * 8;
                    }
                    if (2 * u.pm + ai >= 5) {
                        const int rr = row - 640, hh = rr >> 6, d = rr & 63, bb = c0 >> 13, s = c0 & 8191;
                        dst = Vt + (size_t)640 * TT + ((((size_t)(bb * 6 + hh) * 128 + (s >> 6)) * 8 + ((s & 63) >> 3)) * 64 + d) * 8;
                    }
                    *(u32x4*)dst = w;
                }
        }
    }
};
struct EpiRes {
    static constexpr bool PERM = true, AFTER_DRAIN = false;
    bf16_t* h; float* ssq; LAS float* red; int tid;
    __device__ __forceinline__ void operator()(const f32x4 (&acc)[2][2][4][2], const Unit& u, int wr, int wc, int fr, int fq) const {
        const int row0 = u.pm * 256 + wr * 64 + fr, col0 = u.pn * 256 + wc * 32 + 8 * fq;
#pragma unroll
        for (int ai = 0; ai < 2; ++ai)
#pragma unroll
            for (int m = 0; m < 4; ++m) {
                const int row = row0 + ai * 128 + m * 16; float ss = 0.f;
#pragma unroll
                for (int bj = 0; bj < 2; ++bj) {
                    bf16_t* p = h + (size_t)row * DM + col0 + bj * 128;
                    const u32x4 v = *(const u32x4*)p; const f32x4 a0 = acc[ai][bj][m][0], a1 = acc[ai][bj][m][1];
                    const float h0 = bflo(v.x) + a0.x, h1 = bfhi(v.x) + a0.y, h2 = bflo(v.y) + a0.z, h3 = bfhi(v.y) + a0.w, h4 = bflo(v.z) + a1.x, h5 = bfhi(v.z) + a1.y, h6 = bflo(v.w) + a1.z, h7 = bfhi(v.w) + a1.w;
                    u32x4 w; w.x = cvtpk(h0, h1); w.y = cvtpk(h2, h3); w.z = cvtpk(h4, h5); w.w = cvtpk(h6, h7);
                    *(u32x4*)p = w;
                    const float r0 = bflo(w.x), r1 = bfhi(w.x), r2 = bflo(w.y), r3 = bfhi(w.y), r4 = bflo(w.z), r5 = bfhi(w.z), r6 = bflo(w.w), r7 = bfhi(w.w);
                    ss += ((r0 * r0 + r1 * r1) + (r2 * r2 + r3 * r3)) + ((r4 * r4 + r5 * r5) + (r6 * r6 + r7 * r7));
                }
                ss += __shfl_xor(ss, 16); ss += __shfl_xor(ss, 32);
                if (fq == 0) red[(ai * 128 + wr * 64 + m * 16 + fr) * 4 + wc] = ss;
            }
        asm volatile("s_waitcnt lgkmcnt(0)" ::: "memory"); __builtin_amdgcn_s_barrier(); asm volatile("" ::: "memory");
        if (tid < 256) { const f32x4 v = *(const LAS f32x4*)(red + tid * 4); ssq[(size_t)(u.pm * 256 + tid) * 4 + u.pn] = (v.x + v.y) + (v.z + v.w); }
    }
};
struct EpiB16 {
    static constexpr bool PERM = true, AFTER_DRAIN = false;
    bf16_t* O; int ldc; const float* ssq; float scale;
    __device__ __forceinline__ void operator()(const f32x4 (&acc)[2][2][4][2], const Unit& u, int wr, int wc, int fr, int fq) const {
        const int row0 = u.pm * 256 + wr * 64 + fr;
#pragma unroll
        for (int ai = 0; ai < 2; ++ai)
#pragma unroll
            for (int m = 0; m < 4; ++m) {
                const int row = row0 + ai * 128 + m * 16; const float s = ssq ? scale * rinv_row(ssq, row) : scale;
#pragma unroll
                for (int bj = 0; bj < 2; ++bj) {
                    const int c0 = u.pn * 256 + bj * 128 + wc * 32 + fq * 8;
                    const f32x4 v0 = acc[ai][bj][m][0] * s, v1 = acc[ai][bj][m][1] * s;
                    u32x4 w; w.x = cvtpk(v0.x, v0.y); w.y = cvtpk(v0.z, v0.w); w.z = cvtpk(v1.x, v1.y); w.w = cvtpk(v1.z, v1.w);
                    *(u32x4*)(O + (size_t)row * ldc + c0) = w;
                }
            }
    }
};

struct ACtx { int tid, lane, wid, r32, hi, r32p; LAS unsigned char* lds; };
#define MFMA32(a, b, c) __builtin_amdgcn_mfma_f32_32x32x16_bf16((a), (b), (c), 0, 0, 0)

template <int ROWS, int CH> struct Stage {
    static constexpr int N = ROWS * CH / 512;
    u32x4 r[N];
    __device__ __forceinline__ void load(const bf16_t* g, size_t pitch, int tid) {
#pragma unroll
        for (int i = 0; i < N; ++i) { const int idx = tid + i * 512, rl = idx & 7, c = (idx >> 3) & (CH - 1), rh = idx / (8 * CH); r[i] = *(const u32x4*)(g + (size_t)(rh * 8 + rl) * pitch + c * 8); }
    }
    __device__ __forceinline__ void store(LAS unsigned char* dst, int tid) const {
#pragma unroll
        for (int i = 0; i < N; ++i) { const int idx = tid + i * 512, rl = idx & 7, c = (idx >> 3) & (CH - 1), rh = idx / (8 * CH); *(LAS u32x4*)(dst + c * (ROWS * 16) + (rh * 8 + rl) * 16) = r[i]; }
    }
};
template <int ROWS, int CH> __device__ __forceinline__ void stage_glds(const bf16_t* g, size_t pitch, LAS unsigned char* dst, const ACtx& c) {
    constexpr int RB = ROWS / 64, NP = RB * CH / 8;
#pragma unroll
    for (int i = 0; i < NP; ++i) {
        const int p = c.wid + 8 * i, chunk = p / RB, rb = p % RB;
        __builtin_amdgcn_global_load_lds((const unsigned*)(g + (size_t)(rb * 64 + c.lane) * pitch + chunk * 8), (LAS unsigned*)(dst + chunk * (ROWS * 16) + rb * 1024), 16, 0, 0);
    }
}
__device__ __forceinline__ bf16x8 pack8(float a0, float a1, float a2, float a3, float a4, float a5, float a6, float a7) {
    u32x4 w; w.x = cvtpk(a0, a1); w.y = cvtpk(a2, a3); w.z = cvtpk(a4, a5); w.w = cvtpk(a6, a7); return __builtin_bit_cast(bf16x8, w);
}
template <int NK, int KSTR = 1024> __device__ __forceinline__ void qk_tile(f32x16& p0, f32x16& p1, const LAS unsigned char* Ks, int cb, const bf16x8* qr, const ACtx& c) {
    f32x16 z;
#pragma unroll
    for (int r = 0; r < 16; ++r) z[r] = 0.f;
    p0 = z; p1 = z;
    __builtin_amdgcn_s_setprio(1);
#pragma unroll
    for (int d0 = 0; d0 < NK; ++d0) {
        const LAS unsigned char* a = Ks + (cb + 2 * d0 + c.hi) * KSTR + c.r32p * 16;
        const bf16x8 k0 = *(const LAS bf16x8*)a, k1 = *(const LAS bf16x8*)(a + 512);
        p0 = MFMA32(k0, qr[d0], p0); p1 = MFMA32(k1, qr[d0], p1);
    }
    __builtin_amdgcn_s_setprio(0);
}
template <int DVB, int VSTR = 512 * DVB> __device__ __forceinline__ void pv_tile(f32x16* o, const LAS unsigned char* Vs, const f32x16& p0, const f32x16& p1, const ACtx& c) {
    bf16x8 pf[4];
    pf[0] = pack8(p0[0], p0[1], p0[2], p0[3], p0[4], p0[5], p0[6], p0[7]); pf[1] = pack8(p0[8], p0[9], p0[10], p0[11], p0[12], p0[13], p0[14], p0[15]);
    pf[2] = pack8(p1[0], p1[1], p1[2], p1[3], p1[4], p1[5], p1[6], p1[7]); pf[3] = pack8(p1[8], p1[9], p1[10], p1[11], p1[12], p1[13], p1[14], p1[15]);
#pragma unroll
    for (int s = 0; s < 4; ++s)
#pragma unroll
        for (int d0 = 0; d0 < DVB; ++d0) {
            const bf16x8 v = *(const LAS bf16x8*)(Vs + (2 * s + c.hi) * VSTR + (32 * d0 + c.r32) * 16);
            o[d0] = MFMA32(v, pf[s], o[d0]);
        }
}
__device__ __forceinline__ float softmax_step(f32x16& p0, f32x16& p1, float& m, float& l) {
    float mx = fmaxf(p0[0], p1[0]);
#pragma unroll
    for (int r = 1; r < 16; ++r) mx = fmaxf(mx, fmaxf(p0[r], p1[r]));
    mx = fmaxf(mx, __shfl_xor(mx, 32));
    const float mn = fmaxf(m, mx), alpha = ex2(m - mn); m = mn;
    float rs = 0.f;
#pragma unroll
    for (int r = 0; r < 16; ++r) { p0[r] = ex2(p0[r] - mn); p1[r] = ex2(p1[r] - mn); rs += p0[r] + p1[r]; }
    l = l * alpha + rs;
    return alpha;
}
__device__ __forceinline__ void scale_o(f32x16& o, float a) {
#pragma unroll
    for (int r = 0; r < 16; ++r) o[r] *= a;
}
__device__ __forceinline__ void zero16(f32x16& o) {
#pragma unroll
    for (int r = 0; r < 16; ++r) o[r] = 0.f;
}
__device__ __forceinline__ void xhalf(float v, float& lo, float& hi) { auto r = __builtin_amdgcn_permlane32_swap(__float_as_uint(v), __float_as_uint(v), false, false); lo = __uint_as_float(r[0]); hi = __uint_as_float(r[1]); }
__device__ __forceinline__ float xhalf_partner(float v, int hi_lane) { float lo, hi; xhalf(v, lo, hi); return hi_lane ? lo : hi; }
__device__ __forceinline__ unsigned xhalf_or(unsigned v) { auto r = __builtin_amdgcn_permlane32_swap(v, v, false, false); return r[0] | r[1]; }
struct Soft { float m; int zm; float l; };
__device__ __forceinline__ void soft_init(Soft& s) { s.m = 0.f; s.zm = 1; s.l = 0.f; }
__device__ __forceinline__ float max3f(float a, float b, float c) { float r; asm("v_max3_f32 %0, %1, %2, %3" : "=v"(r) : "v"(a), "v"(b), "v"(c)); return r; }
template <int NO> __device__ __forceinline__ void soft_step(Soft& s, f32x16& p0, f32x16& p1, f32x16* o, bool first) {
    float a = max3f(p0[0], p0[1], p1[0]), b = max3f(p0[2], p0[3], p1[1]); a = max3f(a, p1[2], p1[3]);
#pragma unroll
    for (int r = 4; r < 16; r += 4) { a = max3f(a, p0[r], p0[r + 1]); b = max3f(b, p0[r + 2], p0[r + 3]); a = max3f(a, p1[r], p1[r + 1]); b = max3f(b, p1[r + 2], p1[r + 3]); }
    float mx = max3f(a, b, b);
    { float lo_, hi_; xhalf(mx, lo_, hi_); mx = max3f(lo_, hi_, hi_); }
    const float d = mx - s.m;
    const bool up = d > 32.f, dn = first && (d < -32.f) && (mx > -1.0e29f);
    if (__any(up || dn)) {
        const float mn = (up || dn) ? mx : s.m; const float alpha = ex2(s.m - mn); s.m = mn;
        s.l *= alpha;
#pragma unroll
        for (int i = 0; i < NO; ++i) scale_o(o[i], alpha);
        s.zm = __all(s.m == 0.f);
    }
    if (s.zm) {
#pragma unroll
        for (int r = 0; r < 16; ++r) { p0[r] = ex2(p0[r]); p1[r] = ex2(p1[r]); }
    } else {
        const float m = s.m;
#pragma unroll
        for (int r = 0; r < 16; ++r) { p0[r] = ex2(p0[r] - m); p1[r] = ex2(p1[r] - m); }
    }
}
__device__ __forceinline__ bf16x8 ones8() { u32x4 w; w.x = 0x3F803F80u; w.y = 0x3F803F80u; w.z = 0x3F803F80u; w.w = 0x3F803F80u; return __builtin_bit_cast(bf16x8, w); }
template <int DVB, int VSTR> __device__ __forceinline__ void pv_tile_l(f32x16* o, float& l, const LAS unsigned char* Vs, const f32x16& p0, const f32x16& p1, const ACtx& c) {
    bf16x8 pf[4];
    pf[0] = pack8(p0[0], p0[1], p0[2], p0[3], p0[4], p0[5], p0[6], p0[7]); pf[1] = pack8(p0[8], p0[9], p0[10], p0[11], p0[12], p0[13], p0[14], p0[15]);
    pf[2] = pack8(p1[0], p1[1], p1[2], p1[3], p1[4], p1[5], p1[6], p1[7]); pf[3] = pack8(p1[8], p1[9], p1[10], p1[11], p1[12], p1[13], p1[14], p1[15]);
    const bf16x8 one = ones8();
    f32x16 la; zero16(la);
    __builtin_amdgcn_s_setprio(1);
#pragma unroll
    for (int s = 0; s < 4; ++s) {
        la = MFMA32(one, pf[s], la);
#pragma unroll
        for (int d0 = 0; d0 < DVB; ++d0) {
            const bf16x8 v = *(const LAS bf16x8*)(Vs + (2 * s + c.hi) * VSTR + (32 * d0 + c.r32) * 16);
            o[d0] = MFMA32(v, pf[s], o[d0]);
        }
    }
    __builtin_amdgcn_s_setprio(0);
    l += la[0];
}
template <bool STRICT> __device__ __forceinline__ void mask_causal(f32x16& p0, f32x16& p1, int kbase, int q, int hi) {
#pragma unroll
    for (int r = 0; r < 16; ++r) {
        const int key = kbase + 16 * (r >> 3) + 8 * hi + (r & 7);
        const bool v0 = STRICT ? (key < q) : (key <= q), v1 = STRICT ? (key + 32 < q) : (key + 32 <= q);
        p0[r] = v0 ? p0[r] : NEGF; p1[r] = v1 ? p1[r] : NEGF;
    }
}
__device__ __forceinline__ void top3_insert(float& t1, float& t2, float& t3, float v) {
    const float a = fmaxf(t1, v), b = fminf(t1, v); t1 = a; const float c = fmaxf(t2, b), d = fminf(t2, b); t2 = c; t3 = fmaxf(t3, d);
}

__device__ __forceinline__ void store_gated_rows(const ACtx& c, LAS unsigned char* stg, const f32x16* o, const bf16_t* Gp0, bf16_t* Op0, size_t gpitch) {
#pragma unroll
    for (int d0 = 0; d0 < 2; ++d0)
#pragma unroll
        for (int r4 = 0; r4 < 4; ++r4) {
            u32x2 w; w.x = cvtpk(o[d0][4 * r4], o[d0][4 * r4 + 1]); w.y = cvtpk(o[d0][4 * r4 + 2], o[d0][4 * r4 + 3]);
            *(LAS u32x2*)(stg + c.r32 * 128 + (((4 * d0 + r4) ^ (c.r32 & 7)) * 16) + c.hi * 8) = w;
        }
    asm volatile("s_waitcnt lgkmcnt(0)" ::: "memory");
#pragma unroll
    for (int i = 0; i < 4; ++i) {
        const int row = i * 8 + (c.lane >> 3), ch = c.lane & 7;
        const u32x4 v = *(const LAS u32x4*)(stg + row * 128 + ((ch ^ (row & 7)) * 16));
        const u32x4 g = *(const u32x4*)(Gp0 + (size_t)row * gpitch + ch * 8);
        u32x4 w; w.x = cvtpk(bflo(v.x) * bflo(g.x), bfhi(v.x) * bfhi(g.x)); w.y = cvtpk(bflo(v.y) * bflo(g.y), bfhi(v.y) * bfhi(g.y));
        w.z = cvtpk(bflo(v.z) * bflo(g.z), bfhi(v.z) * bfhi(g.z)); w.w = cvtpk(bflo(v.w) * bflo(g.w), bfhi(v.w) * bfhi(g.w));
        *(u32x4*)(Op0 + (size_t)row * DM + ch * 8) = w;
    }
    asm volatile("s_waitcnt lgkmcnt(0)" ::: "memory");
}
constexpr int MOBA_PART = 32768, MOBA_REC = 136;
template <int NP> __device__ __forceinline__ void stage_linear(const bf16_t* g, LAS unsigned char* dst, const ACtx& c) {
#pragma unroll
    for (int i = 0; i < NP; ++i) { const int p = c.wid + 8 * i; __builtin_amdgcn_global_load_lds((const unsigned*)(g + (size_t)p * 512 + c.lane * 8), (LAS unsigned*)(dst + p * 1024), 16, 0, 0); }
}
__device__ __forceinline__ void moba_unit(const ACtx& c, int b, int h, int qb, const bf16_t* P, const bf16_t* Kimg, const bf16_t* Vimg, const float* kpart, bf16_t* merged) {
    const size_t tok0 = (size_t)b * SEQ;
    const int qrel = c.wid * 32 + c.r32;
    const size_t qtok = tok0 + qb * 256 + qrel;
    const bf16_t* Kg = Kimg + (size_t)(b * 6 + h) * 128 * 4096;
    const bf16_t* Vg = Vimg + (size_t)(b * 6 + h) * 128 * 4096;
    const bf16_t* Qp = P + qtok * PW + h * 64;
    unsigned sel = 0u;
    if (qb > 0) {
        {
            bf16x8 qr[4];
#pragma unroll
            for (int d0 = 0; d0 < 4; ++d0) qr[d0] = *(const bf16x8*)(Qp + d0 * 16 + c.hi * 8);
            f32x16 g; zero16(g);
            const float* km = kpart + ((size_t)(b * 6 + h) * 32 + c.r32) * 128;
#pragma unroll
            for (int d0 = 0; d0 < 4; ++d0) {
                const float* kq = km + d0 * 16 + c.hi * 8;
                const f32x4 a0 = *(const f32x4*)kq + *(const f32x4*)(kq + 64), a1 = *(const f32x4*)(kq + 4) + *(const f32x4*)(kq + 68);
                const float sc = 1.f / 256.f;
                const bf16x8 kf = pack8(a0.x * sc, a0.y * sc, a0.z * sc, a0.w * sc, a1.x * sc, a1.y * sc, a1.z * sc, a1.w * sc); g = MFMA32(kf, qr[d0], g);
            }
            float t1 = NEGF, t2 = NEGF, t3 = NEGF;
#pragma unroll
            for (int r = 0; r < 16; ++r) { const int blk = (r & 3) + 8 * (r >> 2) + 4 * c.hi; const float v = (blk < qb) ? g[r] : NEGF; g[r] = v; top3_insert(t1, t2, t3, v); }
            const float u1 = xhalf_partner(t1, c.hi), u2 = xhalf_partner(t2, c.hi), u3 = xhalf_partner(t3, c.hi);
            top3_insert(t1, t2, t3, u1); top3_insert(t1, t2, t3, u2); top3_insert(t1, t2, t3, u3);
            unsigned seq = 0u;
#pragma unroll
            for (int r = 0; r < 16; ++r) { const int blk = (r & 3) + 8 * (r >> 2) + 4 * c.hi; if (blk < qb) { if (g[r] > t3) sel |= 1u << blk; else if (g[r] == t3) seq |= 1u << blk; } }
            sel = xhalf_or(sel); seq = xhalf_or(seq);
            { const int need = 3 - __popc(sel); while (__popc(seq) > need) seq &= ~(0x80000000u >> __clz((int)seq)); }
            sel |= seq;
        }
        LAS int* cnt = (LAS int*)c.lds; LAS unsigned short* list = (LAS unsigned short*)(c.lds + 1024);
        if (c.tid < 32) cnt[c.tid] = 0;
        __syncthreads();
        if (c.hi == 0) {
            unsigned s = sel; int slot = 0;
            while (s) { const int blk = __ffs((int)s) - 1; s &= s - 1u; const int pos = __hip_atomic_fetch_add(cnt + blk, 1, __ATOMIC_RELAXED, __HIP_MEMORY_SCOPE_WORKGROUP); list[blk * 256 + pos] = (unsigned short)(qrel | (slot << 8)); ++slot; }
        }
        __syncthreads();
        int item = 0;
#pragma unroll 1
        for (int j = 0; j < qb; ++j) {
            const int n = __builtin_amdgcn_readfirstlane(cnt[j]); const int ntile = (n + 31) >> 5;
#pragma unroll 1
            for (int tl = 0; tl < ntile; ++tl, ++item) {
                if ((item & 7) != c.wid) continue;
                const int idx = 32 * tl + c.r32; const bool valid = idx < n;
                const unsigned e = list[j * 256 + (valid ? idx : 0)]; const int ql = e & 255, slot = e >> 8;
                const bf16_t* Qg = P + (tok0 + qb * 256 + ql) * PW + h * 64;
                bf16x8 qg[4];
#pragma unroll
                for (int d0 = 0; d0 < 4; ++d0) qg[d0] = *(const bf16x8*)(Qg + d0 * 16 + c.hi * 8);
                Soft s2; soft_init(s2); f32x16 o2[2]; zero16(o2[0]); zero16(o2[1]);
                const bf16_t* kp = Kg + (size_t)(j * 4) * 4096 + (c.hi * 64 + c.r32p) * 8;
                const bf16_t* vp = Vg + (size_t)(j * 4) * 4096 + (c.hi * 64 + c.r32) * 8;
                bf16x8 kc[8];
#pragma unroll
                for (int i = 0; i < 4; ++i) { kc[2 * i] = *(const bf16x8*)(kp + i * 1024); kc[2 * i + 1] = *(const bf16x8*)(kp + i * 1024 + 256); }
#pragma unroll 1
                for (int kt = 0; kt < 4; ++kt) {
                    bf16x8 vc[8];
                    { const bf16_t* vq = vp + (size_t)kt * 4096;
#pragma unroll
                      for (int i = 0; i < 4; ++i) { vc[2 * i] = *(const bf16x8*)(vq + i * 1024); vc[2 * i + 1] = *(const bf16x8*)(vq + i * 1024 + 256); } }
                    f32x16 p0, p1; zero16(p0); zero16(p1);
#pragma unroll
                    for (int d0 = 0; d0 < 4; ++d0) { p0 = MFMA32(kc[2 * d0], qg[d0], p0); p1 = MFMA32(kc[2 * d0 + 1], qg[d0], p1); }
                    if (kt < 3) {
                        const bf16_t* kq = kp + (size_t)(kt + 1) * 4096;
#pragma unroll
                        for (int i = 0; i < 4; ++i) { kc[2 * i] = *(const bf16x8*)(kq + i * 1024); kc[2 * i + 1] = *(const bf16x8*)(kq + i * 1024 + 256); }
                    }
                    soft_step<2>(s2, p0, p1, o2, kt == 0);
                    bf16x8 pf[4]; const bf16x8 one = ones8(); f32x16 la; zero16(la);
                    pf[0] = pack8(p0[0], p0[1], p0[2], p0[3], p0[4], p0[5], p0[6], p0[7]); pf[1] = pack8(p0[8], p0[9], p0[10], p0[11], p0[12], p0[13], p0[14], p0[15]);
                    pf[2] = pack8(p1[0], p1[1], p1[2], p1[3], p1[4], p1[5], p1[6], p1[7]); pf[3] = pack8(p1[8], p1[9], p1[10], p1[11], p1[12], p1[13], p1[14], p1[15]);
#pragma unroll
                    for (int s = 0; s < 4; ++s) {
                        la = MFMA32(one, pf[s], la);
                        o2[0] = MFMA32(vc[2 * s], pf[s], o2[0]); o2[1] = MFMA32(vc[2 * s + 1], pf[s], o2[1]);
                    }
                    s2.l += la[0];
                }
                const float m2 = s2.m, l2 = s2.l;
                if (valid) {
                    LAS unsigned char* rec = c.lds + MOBA_PART + (ql * 3 + slot) * MOBA_REC;
#pragma unroll
                    for (int d0 = 0; d0 < 2; ++d0)
#pragma unroll
                        for (int r4 = 0; r4 < 4; ++r4) { u32x2 w; w.x = cvtpk(o2[d0][4 * r4], o2[d0][4 * r4 + 1]); w.y = cvtpk(o2[d0][4 * r4 + 2], o2[d0][4 * r4 + 3]); *(LAS u32x2*)(rec + (32 * d0 + 8 * r4 + 4 * c.hi) * 2) = w; }
                    if (c.hi == 0) { *(LAS float*)(rec + 128) = m2; *(LAS float*)(rec + 132) = l2; }
                }
            }
        }
        __syncthreads();
    }
    Soft sm; soft_init(sm); f32x16 o[2]; zero16(o[0]); zero16(o[1]);
    {
        bf16x8 qr[4];
#pragma unroll
        for (int d0 = 0; d0 < 4; ++d0) qr[d0] = *(const bf16x8*)(Qp + d0 * 16 + c.hi * 8);
        const bf16_t* kp = Kg + (size_t)(qb * 4) * 4096 + (c.hi * 64 + c.r32p) * 8;
        const bf16_t* vp = Vg + (size_t)(qb * 4) * 4096 + (c.hi * 64 + c.r32) * 8;
        const int ntl = ((32 * c.wid + 31) >> 6) + 1;
        bf16x8 kc[8];
#pragma unroll
        for (int i = 0; i < 4; ++i) { kc[2 * i] = *(const bf16x8*)(kp + i * 1024); kc[2 * i + 1] = *(const bf16x8*)(kp + i * 1024 + 256); }
#pragma unroll 1
        for (int kt = 0; kt < ntl; ++kt) {
            bf16x8 vc[8];
            { const bf16_t* vq = vp + (size_t)kt * 4096;
#pragma unroll
              for (int i = 0; i < 4; ++i) { vc[2 * i] = *(const bf16x8*)(vq + i * 1024); vc[2 * i + 1] = *(const bf16x8*)(vq + i * 1024 + 256); } }
            f32x16 p0, p1; zero16(p0); zero16(p1);
#pragma unroll
            for (int d0 = 0; d0 < 4; ++d0) { p0 = MFMA32(kc[2 * d0], qr[d0], p0); p1 = MFMA32(kc[2 * d0 + 1], qr[d0], p1); }
            if (kt + 1 < ntl) {
                const bf16_t* kq = kp + (size_t)(kt + 1) * 4096;
#pragma unroll
                for (int i = 0; i < 4; ++i) { kc[2 * i] = *(const bf16x8*)(kq + i * 1024); kc[2 * i + 1] = *(const bf16x8*)(kq + i * 1024 + 256); }
            }
            if (64 * kt + 63 > 32 * c.wid) mask_causal<false>(p0, p1, 64 * kt, qrel, c.hi);
            soft_step<2>(sm, p0, p1, o, kt == 0);
            bf16x8 pf[4]; const bf16x8 one = ones8(); f32x16 la; zero16(la);
            pf[0] = pack8(p0[0], p0[1], p0[2], p0[3], p0[4], p0[5], p0[6], p0[7]); pf[1] = pack8(p0[8], p0[9], p0[10], p0[11], p0[12], p0[13], p0[14], p0[15]);
            pf[2] = pack8(p1[0], p1[1], p1[2], p1[3], p1[4], p1[5], p1[6], p1[7]); pf[3] = pack8(p1[8], p1[9], p1[10], p1[11], p1[12], p1[13], p1[14], p1[15]);
#pragma unroll
            for (int s = 0; s < 4; ++s) { la = MFMA32(one, pf[s], la); o[0] = MFMA32(vc[2 * s], pf[s], o[0]); o[1] = MFMA32(vc[2 * s + 1], pf[s], o[1]); }
            sm.l += la[0];
        }
    }
    float l = sm.l;
    if (qb > 0) {
        const float m = sm.m;
        const int nsel = __popc(sel);
        const LAS unsigned char* rec0 = c.lds + MOBA_PART + (qrel * 3) * MOBA_REC;
        float ms0 = NEGF, ms1 = NEGF, ms2 = NEGF;
        if (nsel > 0) ms0 = *(const LAS float*)(rec0 + 128);
        if (nsel > 1) ms1 = *(const LAS float*)(rec0 + MOBA_REC + 128);
        if (nsel > 2) ms2 = *(const LAS float*)(rec0 + 2 * MOBA_REC + 128);
        const float M = fmaxf(fmaxf(m, ms0), fmaxf(ms1, ms2));
        const float w0 = ex2(m - M); l *= w0; scale_o(o[0], w0); scale_o(o[1], w0);
#pragma unroll
        for (int s = 0; s < 3; ++s) {
            if (s < nsel) {
                const LAS unsigned char* rec = rec0 + s * MOBA_REC;
                const float ws = ex2((s == 0 ? ms0 : (s == 1 ? ms1 : ms2)) - M);
                l += ws * *(const LAS float*)(rec + 132);
#pragma unroll
                for (int d0 = 0; d0 < 2; ++d0)
#pragma unroll
                    for (int r4 = 0; r4 < 4; ++r4) { const u32x2 v = *(const LAS u32x2*)(rec + (32 * d0 + 8 * r4 + 4 * c.hi) * 2);
                        o[d0][4 * r4] += ws * bflo(v.x); o[d0][4 * r4 + 1] += ws * bfhi(v.x); o[d0][4 * r4 + 2] += ws * bflo(v.y); o[d0][4 * r4 + 3] += ws * bfhi(v.y); }
            }
        }
    }
    const float inv = 1.f / l;
    scale_o(o[0], inv); scale_o(o[1], inv);
    { const size_t qt0 = tok0 + qb * 256 + c.wid * 32;
      store_gated_rows(c, c.lds + c.wid * 4096, o, P + qt0 * PW + 768 + h * 64, merged + qt0 * DM + h * 64, PW); }
    __syncthreads();
}

__device__ __forceinline__ void diff_sub(const bool MASK, const ACtx& c, const LAS unsigned char* Ks, const LAS unsigned char* Vs, const bf16x8 (&qr)[2][2], int kbase, int qabs,
                                                             Soft& s0, Soft& s1, f32x16* oa, f32x16* ob, bool first) {
    f32x16 p0, p1, r0, r1;
    qk_tile<2, 1024>(p0, p1, Ks, 0, qr[0], c);
    qk_tile<2, 1024>(r0, r1, Ks, 4, qr[1], c);
    if (MASK) { mask_causal<false>(p0, p1, kbase, qabs, c.hi); mask_causal<false>(r0, r1, kbase, qabs, c.hi); }
    soft_step<2>(s0, p0, p1, oa, first);
    { float sa = 0.f;
#pragma unroll
      for (int r = 0; r < 16; ++r) sa += p0[r] + p1[r];
      s0.l += sa; }
    pv_tile<2, 1024>(oa, Vs, p0, p1, c);
    soft_step<2>(s1, r0, r1, ob, first);
    { float sb = 0.f;
#pragma unroll
      for (int r = 0; r < 16; ++r) sb += r0[r] + r1[r];
      s1.l += sb; }
    pv_tile<2, 1024>(ob, Vs, r0, r1, c);
}
__device__ __forceinline__ void diff_unit(const ACtx& c, int b, int h, int qb, const bf16_t* P, const bf16_t* Kdf, const bf16_t* Vdf, bf16_t* merged, float lam, float one_m_li, const float* hng) {
    const size_t tok0 = (size_t)b * SEQ;
    const int q0w = qb * 256 + c.wid * 32, qabs = q0w + c.r32;
    const size_t qtok = tok0 + qabs;
    const bf16_t* Qp = P + qtok * PW + 1152 + h * 64;
    bf16x8 qr[2][2];
#pragma unroll
    for (int sh = 0; sh < 2; ++sh)
#pragma unroll
        for (int d0 = 0; d0 < 2; ++d0) qr[sh][d0] = *(const bf16x8*)(Qp + sh * 32 + d0 * 16 + c.hi * 8);
    const int NT = 2 * qb + 2;
    const bf16_t* Kg = Kdf + (size_t)(b * 4 + h) * 128 * 4096;
    const bf16_t* Vg = Vdf + (size_t)(b * 4 + h) * 128 * 4096;
    stage_linear<2>(Kg, c.lds, c); stage_linear<2>(Vg, c.lds + 32768, c);
    __syncthreads();
    Soft s0, s1; soft_init(s0); soft_init(s1); f32x16 oa[2], ob[2]; zero16(oa[0]); zero16(oa[1]); zero16(ob[0]); zero16(ob[1]);
#pragma unroll 1
    for (int t = 0; t < NT; ++t) {
        const int cur = t & 1;
        if (t + 1 < NT) { stage_linear<2>(Kg + (size_t)(2 * t + 2) * 4096, c.lds + (cur ^ 1) * 16384, c); stage_linear<2>(Vg + (size_t)(2 * t + 2) * 4096, c.lds + 32768 + (cur ^ 1) * 16384, c); }
#pragma unroll
        for (int u = 0; u < 2; ++u) {
            const int kbase = 128 * t + 64 * u;
            if (kbase <= q0w + 31) {
                const LAS unsigned char* Ks = c.lds + cur * 16384 + u * 8192; const LAS unsigned char* Vs = c.lds + 32768 + cur * 16384 + u * 8192;
                diff_sub(kbase + 63 > q0w, c, Ks, Vs, qr, kbase, qabs, s0, s1, oa, ob, kbase == 0);
            }
        }
        __syncthreads();
    }
    { float lo_, hi_; xhalf(s0.l, lo_, hi_); s0.l = lo_ + hi_; xhalf(s1.l, lo_, hi_); s1.l = lo_ + hi_; }
    const float a0 = 1.f / s0.l, a1 = lam / s1.l;
    float ss = 0.f;
#pragma unroll
    for (int d0 = 0; d0 < 2; ++d0)
#pragma unroll
        for (int r = 0; r < 16; ++r) { const float f = oa[d0][r] * a0 - ob[d0][r] * a1; oa[d0][r] = f; ss += f * f; }
    { float lo_, hi_; xhalf(ss, lo_, hi_); ss = lo_ + hi_; }
    const float rn = __builtin_amdgcn_rsqf(ss * (1.f / 64.f) + RMS_EPS) * one_m_li;
#pragma unroll
    for (int d0 = 0; d0 < 2; ++d0)
#pragma unroll
        for (int r4 = 0; r4 < 4; ++r4) {
            const int d = 32 * d0 + 8 * r4 + 4 * c.hi; const f32x4 hg = *(const f32x4*)(hng + d);
            oa[d0][4 * r4] *= rn * hg.x; oa[d0][4 * r4 + 1] *= rn * hg.y; oa[d0][4 * r4 + 2] *= rn * hg.z; oa[d0][4 * r4 + 3] *= rn * hg.w;
        }
    { const size_t qt0 = tok0 + q0w;
      store_gated_rows(c, c.lds + c.wid * 4096, oa, P + qt0 * PW + 1664 + h * 64, merged + qt0 * DM + 384 + h * 64, PW); }
    __syncthreads();
}

__device__ __forceinline__ void sb_elem(float z, bool valid, float& a, float& lb) {
    const float e = ex2(-fabsf(z)); const float sp = fmaxf(z, 0.f) + lg2(1.f + e);
    a = valid ? -sp : 0.f; lb = valid ? (z - sp) : NEGF;
}
__device__ __forceinline__ void sb_unit(const ACtx& c, int b, int h, int qb, const bf16_t* P, const bf16_t* Ksb, const bf16_t* Vsb, bf16_t* merged) {
    const size_t tok0 = (size_t)b * SEQ;
    const int q0w = qb * 256 + c.wid * 32, qabs = q0w + c.r32;
    const size_t qtok = tok0 + qabs;
    const bf16_t* Qp = P + qtok * PW + 1920 + h * 64;
    bf16x8 qr[4];
#pragma unroll
    for (int d0 = 0; d0 < 4; ++d0) qr[d0] = *(const bf16x8*)(Qp + d0 * 16 + c.hi * 8);
    const bf16_t* kp = Ksb + (size_t)(b * 6 + h) * 128 * 4096 + (c.hi * 64 + c.r32p) * 8;
    const bf16_t* vp = Vsb + (size_t)(b * 6 + h) * 128 * 4096 + (c.hi * 64 + c.r32) * 8;
    float R = 0.f; f32x16 o[2]; zero16(o[0]); zero16(o[1]);
    int t = (q0w + 30) >> 6;
    {
        bf16x8 kc[8];
#pragma unroll
        for (int i = 0; i < 4; ++i) { kc[2 * i] = *(const bf16x8*)(kp + (size_t)t * 4096 + i * 1024); kc[2 * i + 1] = *(const bf16x8*)(kp + (size_t)t * 4096 + i * 1024 + 256); }
#pragma unroll 1
        for (;;) {
            bf16x8 vc[8];
#pragma unroll
            for (int i = 0; i < 4; ++i) { vc[2 * i] = *(const bf16x8*)(vp + (size_t)t * 4096 + i * 1024); vc[2 * i + 1] = *(const bf16x8*)(vp + (size_t)t * 4096 + i * 1024 + 256); }
            f32x16 p0, p1; zero16(p0); zero16(p1);
#pragma unroll
            for (int d0 = 0; d0 < 4; ++d0) { p0 = MFMA32(kc[2 * d0], qr[d0], p0); p1 = MFMA32(kc[2 * d0 + 1], qr[d0], p1); }
            if (t > 0) {
#pragma unroll
                for (int i = 0; i < 4; ++i) { kc[2 * i] = *(const bf16x8*)(kp + (size_t)(t - 1) * 4096 + i * 1024); kc[2 * i + 1] = *(const bf16x8*)(kp + (size_t)(t - 1) * 4096 + i * 1024 + 256); }
            }
            const bool needmask = (64 * t + 63 >= q0w);
            f32x16 a0, a1;
#pragma unroll
            for (int r = 0; r < 16; ++r) {
                const int key = 64 * t + 16 * (r >> 3) + 8 * c.hi + (r & 7);
                float a, lb;
                sb_elem(p0[r], !needmask || (key < qabs), a, lb); a0[r] = a; p0[r] = lb;
                sb_elem(p1[r], !needmask || (key + 32 < qabs), a, lb); a1[r] = a; p1[r] = lb;
            }
            float gs0 = 0.f, gs1 = 0.f, gs2 = 0.f, gs3 = 0.f;
#pragma unroll
            for (int i = 0; i < 8; ++i) { gs0 += a0[i]; gs1 += a0[8 + i]; gs2 += a1[i]; gs3 += a1[8 + i]; }
            const float pg0 = xhalf_partner(gs0, c.hi), pg1 = xhalf_partner(gs1, c.hi), pg2 = xhalf_partner(gs2, c.hi), pg3 = xhalf_partner(gs3, c.hi);
            const float so2 = gs3, so1 = so2 + gs2, so0 = so1 + gs1;
            const float pe2 = pg3, pe1 = pe2 + pg2, pe0 = pe1 + pg1;
            const float totO = so0 + gs0, totP = pe0 + pg0;
            float base0 = R + so0 + (c.hi ? pe0 : totP);
            float base1 = R + so1 + (c.hi ? pe1 : pe0);
            float base2 = R + so2 + (c.hi ? pe2 : pe1);
            float base3 = R + (c.hi ? 0.f : pe2);
#pragma unroll
            for (int i = 7; i >= 0; --i) {
                p0[i] = ex2(p0[i] + base0); base0 += a0[i];
                p0[8 + i] = ex2(p0[8 + i] + base1); base1 += a0[8 + i];
                p1[i] = ex2(p1[i] + base2); base2 += a1[i];
                p1[8 + i] = ex2(p1[8 + i] + base3); base3 += a1[8 + i];
            }
            R += c.hi ? (totP + totO) : (totO + totP);
            bf16x8 pf[4];
            pf[0] = pack8(p0[0], p0[1], p0[2], p0[3], p0[4], p0[5], p0[6], p0[7]); pf[1] = pack8(p0[8], p0[9], p0[10], p0[11], p0[12], p0[13], p0[14], p0[15]);
            pf[2] = pack8(p1[0], p1[1], p1[2], p1[3], p1[4], p1[5], p1[6], p1[7]); pf[3] = pack8(p1[8], p1[9], p1[10], p1[11], p1[12], p1[13], p1[14], p1[15]);
#pragma unroll
            for (int s = 0; s < 4; ++s) { o[0] = MFMA32(vc[2 * s], pf[s], o[0]); o[1] = MFMA32(vc[2 * s + 1], pf[s], o[1]); }
            if (t == 0 || __all(R < -150.f)) break;
            --t;
        }
    }
    { const size_t qt0 = tok0 + q0w;
      store_gated_rows(c, c.lds + c.wid * 4096, o, P + qt0 * PW + 2688 + h * 64, merged + qt0 * DM + 640 + h * 64, PW); }
}

__device__ __forceinline__ void xattn_unit(const ACtx& c, int b, int hx, int qb, const bf16_t* QX, const bf16_t* KX, const bf16_t* VXT, bf16_t* OX) {
    const size_t qtok = (size_t)b * SEQ + qb * 256 + c.wid * 32 + c.r32;
    const bf16_t* Qp = QX + qtok * 512 + hx * 128;
    bf16x8 qr[8];
#pragma unroll
    for (int d0 = 0; d0 < 8; ++d0) qr[d0] = *(const bf16x8*)(Qp + d0 * 16 + c.hi * 8);
    const bf16_t* Kg = KX + (size_t)(b * MEML) * 512 + hx * 128;
    const bf16_t* Vg = VXT + (size_t)(hx * 128) * 1024 + b * MEML;
    stage_glds<256, 16>(Kg, 512, c.lds, c); stage_glds<128, 32>(Vg, 1024, c.lds + 65536, c);
    __syncthreads();
    Soft sm; soft_init(sm); f32x16 o[4]; zero16(o[0]); zero16(o[1]); zero16(o[2]); zero16(o[3]);
#pragma unroll 1
    for (int t = 0; t < 4; ++t) {
        f32x16 p0, p1; qk_tile<8, 4096>(p0, p1, c.lds + t * 1024, 0, qr, c);
        soft_step<4>(sm, p0, p1, o, t == 0);
        pv_tile_l<4, 2048>(o, sm.l, c.lds + 65536 + t * 16384, p0, p1, c);
    }
    __syncthreads();
    const float inv = 1.f / sm.l;
    bf16_t* Op = OX + qtok * 512 + hx * 128;
#pragma unroll
    for (int d0 = 0; d0 < 4; ++d0)
#pragma unroll
        for (int r4 = 0; r4 < 4; ++r4) {
            const int d = 32 * d0 + 8 * r4 + 4 * c.hi;
            u32x2 w; w.x = cvtpk(o[d0][4 * r4] * inv, o[d0][4 * r4 + 1] * inv); w.y = cvtpk(o[d0][4 * r4 + 2] * inv, o[d0][4 * r4 + 3] * inv);
            *(u32x2*)(Op + d) = w;
        }
}

__device__ __forceinline__ float wave_sum(float v) {
#pragma unroll
    for (int o = 1; o < 64; o <<= 1) v += __shfl_xor(v, o);
    return v;
}
__device__ __forceinline__ void kmean_item(int item, const bf16_t* Kimg, bf16_t* kmean, int lane) {
    const int blk = item & 31, bh = item >> 5;
    const bf16_t* img = Kimg + ((size_t)bh * 128 + blk * 4) * 4096;
    const int kl = lane >> 3, cc = lane & 7;
    float s0 = 0.f, s1 = 0.f, s2 = 0.f, s3 = 0.f, s4 = 0.f, s5 = 0.f, s6 = 0.f, s7 = 0.f;
#pragma unroll 8
    for (int it = 0; it < 32; ++it) {
        const int key = it * 8 + kl;
        const u32x4 v = *(const u32x4*)(img + ((size_t)((key >> 6) * 8 + cc) * 64 + (key & 63)) * 8);
        s0 += bflo(v.x); s1 += bfhi(v.x); s2 += bflo(v.y); s3 += bfhi(v.y); s4 += bflo(v.z); s5 += bfhi(v.z); s6 += bflo(v.w); s7 += bfhi(v.w);
    }
#pragma unroll
    for (int o = 8; o < 64; o <<= 1) { s0 += __shfl_xor(s0, o); s1 += __shfl_xor(s1, o); s2 += __shfl_xor(s2, o); s3 += __shfl_xor(s3, o); s4 += __shfl_xor(s4, o); s5 += __shfl_xor(s5, o); s6 += __shfl_xor(s6, o); s7 += __shfl_xor(s7, o); }
    if (lane < 8) { const float k = 1.f / 256.f; u32x4 w; w.x = cvtpk(s0 * k, s1 * k); w.y = cvtpk(s2 * k, s3 * k); w.z = cvtpk(s4 * k, s5 * k); w.w = cvtpk(s6 * k, s7 * k); *(u32x4*)(kmean + (size_t)item * 64 + cc * 8) = w; }
}
__device__ __forceinline__ int src_main(int n) {
    int base, j, kind;
    if (n < 384) { base = 0; j = n; kind = 1; } else if (n < 768) { base = 384; j = n - 384; kind = 1; } else if (n < 1152) { base = 1152; j = n - 768; kind = 0; }
    else if (n < 1408) { base = 1536; j = n - 1152; kind = 2; } else if (n < 1664) { base = 1792; j = n - 1408; kind = 2; } else if (n < 1920) { base = 2304; j = n - 1664; kind = 0; }
    else if (n < 2304) { base = 2560; j = n - 1920; kind = 0; } else if (n < 2688) { base = 2944; j = n - 2304; kind = 0; } else { base = 3712; j = n - 2688; kind = 0; }
    if (kind == 1) { const int d = j & 63; if (d < 16) j = (j & ~63) + ((d & 1) ? 8 + (d >> 1) : (d >> 1)); }
    else if (kind == 2) { const int d = j & 31; if (d < 8) j = (j & ~31) + ((d & 1) ? 4 + (d >> 1) : (d >> 1)); }
    return base + j;
}
__device__ __forceinline__ int src_v(int n) { return n < 384 ? 768 + n : (n < 640 ? 2048 + (n - 384) : 3328 + (n - 640)); }
__device__ __forceinline__ void transpose_item(const float* W, int K, int Nsrc, bf16_t* WT, int Ndst, int mode, int coloff, LAS float* scr, int item, int lane, const float* gain) {
    const int nblk = Ndst / 32, kb = item / nblk, nb = item % nblk, k0 = 64 * kb, n0 = 32 * nb;
    const int nn = n0 + (lane & 31); const int sc = (mode == 1) ? src_main(nn) : ((mode == 2) ? src_v(nn) : coloff + nn);
#pragma unroll 16
    for (int i = 0; i < 32; ++i) { const int kk = 2 * i + (lane >> 5); const float gk = gain ? gain[k0 + kk] : 1.f; scr[kk * 33 + (lane & 31)] = W[(size_t)(k0 + kk) * Nsrc + sc] * gk; }
    asm volatile("s_waitcnt lgkmcnt(0)" ::: "memory");
    const int cc = lane & 7;
#pragma unroll
    for (int j = 0; j < 4; ++j) { const int n = (lane >> 3) + 8 * j; const LAS float* s = scr + (8 * cc) * 33 + n;
        u32x4 o; o.x = cvtpk(s[0 * 33], s[1 * 33]); o.y = cvtpk(s[2 * 33], s[3 * 33]); o.z = cvtpk(s[4 * 33], s[5 * 33]); o.w = cvtpk(s[6 * 33], s[7 * 33]);
        *(u32x4*)(WT + (size_t)(n0 + n) * K + k0 + 8 * cc) = o; }
    asm volatile("s_waitcnt lgkmcnt(0)" ::: "memory");
}
__device__ __forceinline__ void rope_cs(float pos, float chi, float clo, float& cs, float& sn) {
    const float h = pos * chi; float lo = fmaf(pos, chi, -h); lo = fmaf(pos, clo, lo);
    const float fr = (h - floorf(h)) + lo;
    cs = __builtin_amdgcn_cosf(fr); sn = __builtin_amdgcn_sinf(fr);
}

struct Args { const float* in[17]; float* out; unsigned char* ws; int ph_lo, ph_hi; };

__device__ __forceinline__ void prologue(const Args& a, LAS unsigned char* lds, int tid, int lane, int wid) {
    unsigned char* ws = a.ws;
    const int G = gridDim.x, gw = blockIdx.x * 8 + wid, NGW = G * 8;
    LAS float* scr = (LAS float*)(lds + wid * 16384);
    bf16_t* Wb = (bf16_t*)(ws + WS_W);
    constexpr int I_MAIN = 16 * 96, I_V = 16 * 32, I_OUT = 16 * 32, I_XQ = 16 * 16, I_XK = 16 * 16, I_XV = 16 * 16, I_XO = 8 * 32, I_L = I_MAIN + I_V + I_OUT + I_XQ + I_XK + I_XV + I_XO;
    for (int it = gw; it < 2 * I_L; it += NGW) {
        const int l = it / I_L; int r = it % I_L; bf16_t* W = Wb + (size_t)l * W_LAYER;
        const float* w_in = a.in[4] + (size_t)l * 1024 * 4096; const float* w_out = a.in[5] + (size_t)l * 1024 * 1024;
        const float* w_xq = a.in[13] + (size_t)l * 1024 * 512; const float* w_xkv = a.in[14] + (size_t)l * 1024 * 1024; const float* w_xo = a.in[15] + (size_t)l * 512 * 1024;
        if (r < I_MAIN) { transpose_item(w_in, 1024, 4096, W + W_MAIN, 3072, 1, 0, scr, r, lane, a.in[3] + l * DM); continue; } r -= I_MAIN;
        if (r < I_V) { transpose_item(w_in, 1024, 4096, W + W_V, 1024, 2, 0, scr, r, lane, a.in[3] + l * DM); continue; } r -= I_V;
        if (r < I_OUT) { transpose_item(w_out, 1024, 1024, W + W_OUT, 1024, 0, 0, scr, r, lane, nullptr); continue; } r -= I_OUT;
        if (r < I_XQ) { transpose_item(w_xq, 1024, 512, W + W_XQ, 512, 0, 0, scr, r, lane, a.in[11] + l * DM); continue; } r -= I_XQ;
        if (r < I_XK) { transpose_item(w_xkv, 1024, 1024, W + W_XK, 512, 0, 0, scr, r, lane, nullptr); continue; } r -= I_XK;
        if (r < I_XV) { transpose_item(w_xkv, 1024, 1024, W + W_XV, 512, 0, 512, scr, r, lane, nullptr); continue; } r -= I_XV;
        transpose_item(w_xo, 512, 1024, W + W_XO, 1024, 0, 0, scr, r, lane, nullptr);
    }
    {
        const float* x = a.in[0]; bf16_t* hb = (bf16_t*)(ws + WS_HB); float* ssq = (float*)(ws + WS_SSQ);
        for (int row = gw; row < TT; row += 2 * NGW) {
            const int row2 = row + NGW;
            const f32x4* xr = (const f32x4*)(x + (size_t)row * DM) + lane; const f32x4* xr2 = (const f32x4*)(x + (size_t)row2 * DM) + lane;
            f32x4 v[4], v2[4];
#pragma unroll
            for (int j = 0; j < 4; ++j) { v[j] = xr[64 * j]; v2[j] = xr2[64 * j]; }
            float s = 0.f, s2 = 0.f; u32x2* o8 = (u32x2*)(hb + (size_t)row * DM) + lane; u32x2* o82 = (u32x2*)(hb + (size_t)row2 * DM) + lane;
#pragma unroll
            for (int j = 0; j < 4; ++j) {
                u32x2 w; w.x = cvtpk(v[j].x, v[j].y); w.y = cvtpk(v[j].z, v[j].w); o8[64 * j] = w;
                { const float r0 = bflo(w.x), r1 = bfhi(w.x), r2 = bflo(w.y), r3 = bfhi(w.y); s += (r0 * r0 + r1 * r1) + (r2 * r2 + r3 * r3); }
                u32x2 w2; w2.x = cvtpk(v2[j].x, v2[j].y); w2.y = cvtpk(v2[j].z, v2[j].w); o82[64 * j] = w2;
                { const float r0 = bflo(w2.x), r1 = bfhi(w2.x), r2 = bflo(w2.y), r3 = bfhi(w2.y); s2 += (r0 * r0 + r1 * r1) + (r2 * r2 + r3 * r3); }
            }
            s = wave_sum(s); s2 = wave_sum(s2);
            if (lane < 4) { ssq[(size_t)row * 4 + lane] = (lane == 0) ? s : 0.f; ssq[(size_t)row2 * 4 + lane] = (lane == 0) ? s2 : 0.f; }
        }
    }
    for (int it = gw; it < 2 * 1024; it += NGW) {
        const int l = it >> 10, row = it & 1023; const float* g = a.in[12] + l * DM; bf16_t* mo = (bf16_t*)(ws + WS_MEMN) + (size_t)l * 1024 * 1024 + (size_t)row * DM;
        const f32x4* xr = (const f32x4*)(a.in[1] + (size_t)row * DM) + lane; f32x4 v[4]; float s = 0.f;
#pragma unroll
        for (int j = 0; j < 4; ++j) { v[j] = xr[64 * j]; s += (v[j].x * v[j].x + v[j].y * v[j].y) + (v[j].z * v[j].z + v[j].w * v[j].w); }
        const float ri = __builtin_amdgcn_rsqf(wave_sum(s) * (1.f / 1024.f) + RMS_EPS);
#pragma unroll
        for (int j = 0; j < 4; ++j) { const f32x4 gg = *((const f32x4*)g + lane + 64 * j); u32x2 w; w.x = cvtpk(v[j].x * ri * gg.x, v[j].y * ri * gg.y); w.y = cvtpk(v[j].z * ri * gg.z, v[j].w * ri * gg.w); *((u32x2*)mo + lane + 64 * j) = w; }
    }
    {
        const int gt = blockIdx.x * 512 + tid;
        constexpr float ROPE64_HI[8] = {1.591549367e-01f, 3.086376376e-02f, 5.985185504e-03f, 1.160663669e-03f, 2.250790858e-04f, 4.364795313e-05f, 8.464330676e-06f, 1.641426252e-06f};
        constexpr float ROPE64_LO[8] = {6.420638327e-09f, -3.597993882e-10f, 2.087540496e-10f, -2.775752479e-11f, -6.755000964e-12f, -3.416928741e-13f, 1.318804142e-13f, 1.098673667e-14f};
        for (int tk = gt; tk < TT; tk += G * 512) {
            const float pos = (float)((const int*)a.in[2])[tk]; float* c64 = (float*)(ws + WS_CS64) + (size_t)tk * 16; float* c32 = (float*)(ws + WS_CS32) + (size_t)tk * 8;
#pragma unroll
            for (int i = 0; i < 8; ++i) { float cs, sn; rope_cs(pos, ROPE64_HI[i], ROPE64_LO[i], cs, sn); c64[2 * i] = cs; c64[2 * i + 1] = sn; }
#pragma unroll
            for (int i = 0; i < 4; ++i) { float cs, sn; rope_cs(pos, ROPE64_HI[2 * i], ROPE64_LO[2 * i], cs, sn); c32[2 * i] = cs; c32[2 * i + 1] = sn; }
        }
    }
    if (blockIdx.x == 0 && wid == 0) {
        int* ctl = (int*)(ws + WS_CTL);
        if (lane < 16) ctl[lane] = 0;
#pragma unroll
        for (int l = 0; l < 2; ++l) {
            float p1 = 0.f, p2 = 0.f;
            if (lane < 32) { p1 = a.in[6][l * 32 + lane] * a.in[7][l * 32 + lane]; p2 = a.in[8][l * 32 + lane] * a.in[9][l * 32 + lane]; }
            p1 = wave_sum(p1); p2 = wave_sum(p2);
            const float li = 0.8f - 0.6f * expf(-0.3f * (float)l);
            if (lane == 0) { ((float*)ctl)[16 + 2 * l] = expf(p1) - expf(p2) + li; ((float*)ctl)[17 + 2 * l] = 1.f - li; }
        }
    }
}

__device__ __forceinline__ void final_norm(const Args& a, int lane, int wid) {
    const int gw = blockIdx.x * 8 + wid, NGW = gridDim.x * 8; const float* ssq = (const float*)(a.ws + WS_SSQ); const float* g = a.in[16]; const bf16_t* hb = (const bf16_t*)(a.ws + WS_HB);
    f32x4 gv[2][2];
#pragma unroll
    for (int j = 0; j < 2; ++j) { gv[j][0] = *(const f32x4*)(g + 512 * j + lane * 8); gv[j][1] = *(const f32x4*)(g + 512 * j + lane * 8 + 4); }
    for (int row0 = gw; row0 < TT; row0 += 2 * NGW) {
        u32x4 v[2][2]; float ri[2];
#pragma unroll
        for (int q = 0; q < 2; ++q) { const int row = row0 + q * NGW; ri[q] = rinv_row(ssq, row);
#pragma unroll
            for (int j = 0; j < 2; ++j) v[q][j] = *(const u32x4*)(hb + (size_t)row * DM + 512 * j + lane * 8); }
#pragma unroll
        for (int q = 0; q < 2; ++q)
#pragma unroll
            for (int j = 0; j < 2; ++j) {
                const u32x4 w = v[q][j];
                f32x4 o0, o1; o0.x = bflo(w.x); o0.y = bfhi(w.x); o0.z = bflo(w.y); o0.w = bfhi(w.y); o1.x = bflo(w.z); o1.y = bfhi(w.z); o1.z = bflo(w.w); o1.w = bfhi(w.w);
                float* op = a.out + (size_t)(row0 + q * NGW) * DM + 512 * j + lane * 8;
                *(f32x4*)op = o0 * ri[q] * gv[j][0]; *(f32x4*)(op + 4) = o1 * ri[q] * gv[j][1];
            }
    }
}

__device__ __forceinline__ int pi32(int r) { return (r & ~12) | ((r & 4) << 1) | ((r & 8) >> 1); }
constexpr int N_PHASES = 12;
#ifndef PROBE_MIX
#define PROBE_MIX 0
#endif
#ifndef PH_MASK
#define PH_MASK 0x1FF
#endif
__device__ __forceinline__ bf16_t* wlayer(const Args& a, int l) { return (bf16_t*)(a.ws + WS_W) + (size_t)l * W_LAYER; }
__device__ __forceinline__ void make_ctx(ACtx& c, LAS unsigned char* lds) {
    const int tid = tid_opaque(), lane = tid & 63;
    c.tid = tid; c.lane = lane; c.wid = __builtin_amdgcn_readfirstlane(tid >> 6); c.r32 = lane & 31; c.hi = lane >> 5; c.r32p = pi32(lane & 31); c.lds = lds;
}
__device__ __forceinline__ void phase_in(const Args& a, LAS unsigned char* lds, int l) {
    const int G = grid_opaque(), bid = bid_opaque(); unsigned char* ws = a.ws;
    { pg8::Gemm g{(const bf16_t*)(ws + WS_HB), wlayer(a, l) + W_MAIN, TT, 3072, 1024}; pg8::StaticOrder S; S.init(TT, 3072, G, bid);
      EpiIn E{(bf16_t*)(ws + WS_P), (const float*)(ws + WS_SSQ), (const float*)(ws + WS_CS64), (const float*)(ws + WS_CS32), (bf16_t*)(ws + WS_KIMG), (float*)(ws + WS_KMEAN), (bf16_t*)a.out, (bf16_t*)a.out + (size_t)16 * 1024 * 1024};
      pg8::gemm_phase<EpiIn, pg8::StaticOrder, true, true>(lds, g, S, E); }
    { pg8::Gemm g{wlayer(a, l) + W_V, (const bf16_t*)(ws + WS_HB), 1024, TT, 1024}; pg8::StaticOrder S; S.init(1024, TT, G, bid);
      EpiVt E{(bf16_t*)(ws + WS_VT), (const float*)(ws + WS_SSQ)};
      pg8::gemm_phase<EpiVt, pg8::StaticOrder, true, true>(lds, g, S, E); }
}
__device__ __forceinline__ void phase_kmean(const Args& a, LAS unsigned char* lds, int l) {
    const int G = grid_opaque(), bid = bid_opaque(), tid_ = tid_opaque(), lane = tid_ & 63, wid = __builtin_amdgcn_readfirstlane(tid_ >> 6); unsigned char* ws = a.ws;
    for (int it = bid * 8 + wid; it < 768; it += G * 8) kmean_item(it, (const bf16_t*)(ws + WS_KIMG), (bf16_t*)(ws + WS_KMEAN), lane);
    bf16_t* memn = (bf16_t*)(ws + WS_MEMN) + (size_t)l * 1024 * 1024; bf16_t* kx = (bf16_t*)(ws + WS_KX) + (size_t)l * 1024 * 512; bf16_t* vxt = (bf16_t*)(ws + WS_VXT) + (size_t)l * 512 * 1024;
#pragma unroll 1
    for (int j = 0; j < 2; ++j) {
        pg8::Gemm g; g.A = j ? (wlayer(a, l) + W_XV) : memn; g.Bt = j ? memn : (wlayer(a, l) + W_XK); g.M = j ? 512 : 1024; g.N = j ? 1024 : 512; g.K = 1024;
        pg8::StaticOrder S; S.init(g.M, g.N, G, (bid + G - 8 - 16 * j) % G); EpiB16 E{j ? vxt : kx, j ? 1024 : 512, nullptr, 1.f};
        pg8::gemm_phase<EpiB16, pg8::StaticOrder, true, true>(lds, g, S, E);
    }
}
struct OneUnit {
    Unit u;
    __device__ __forceinline__ bool next(int i, Unit& o) const { if (i) return false; o = u; return true; }
    __device__ __forceinline__ void a_ready(const Unit&) const {}
    __device__ __forceinline__ void done(const Unit&) const {}
};
#ifndef MIX_TYPES
#define MIX_TYPES 7
#endif
__device__ __forceinline__ void phase_mix(const Args& a, LAS unsigned char* lds, int l, int rep, int types) {
    volatile LAS int* wq = (volatile LAS int*)(lds + LDS_MISC);
    const int x0 = (int)((unsigned)__builtin_amdgcn_s_getreg((3 << 11) | 20) & 7u);
    int nq = 0;
    for (;;) {
        unsigned char* ws = a.ws; asm volatile("" : "+s"(ws));
        int* ctl = (int*)(ws + WS_CTL);
        const bf16_t* P = (const bf16_t*)(ws + WS_P); const bf16_t* Vt = (const bf16_t*)(ws + WS_VT); bf16_t* mrg = (bf16_t*)(ws + WS_MRG);
        ACtx c; make_ctx(c, lds);
        const int q = (x0 + nq) & 7;
        if (c.tid == 0) *wq = __hip_atomic_fetch_add(ctl + 32 + (l * 2 + rep) * 8 + q, 1, __ATOMIC_RELAXED, __HIP_MEMORY_SCOPE_AGENT);
        __syncthreads();
        const int i = __builtin_amdgcn_readfirstlane(*wq);
        __syncthreads();
        if (i >= 258) { if (++nq >= 8) break; continue; }
        if (i >= 256) {
            const int it = (i - 256) + 2 * q, j = it >> 3, uu = it & 7;
            bf16_t* memn = (bf16_t*)(ws + WS_MEMN) + (size_t)l * 1024 * 1024;
            pg8::Gemm g; g.A = j ? (wlayer(a, l) + W_XV) : memn; g.Bt = j ? memn : (wlayer(a, l) + W_XK); g.M = j ? 512 : 1024; g.N = j ? 1024 : 512; g.K = 1024;
            OneUnit S; S.u.pm = j ? (uu & 1) : (uu & 3); S.u.pn = j ? (uu >> 1) : (uu >> 2);
            EpiB16 E{j ? ((bf16_t*)(ws + WS_VXT) + (size_t)l * 512 * 1024) : ((bf16_t*)(ws + WS_KX) + (size_t)l * 1024 * 512), j ? 1024 : 512, nullptr, 1.f};
            pg8::gemm_phase<EpiB16, OneUnit, true, true>(lds, g, S, E);
            __syncthreads();
            continue;
        }
        int type, bh, qb;
        if (i < 56) { type = 0; qb = 31 - (i >> 1); bh = q + 8 * (i & 1); }
        else if (i < 152) { const int j = i - 56; type = 1; qb = 31 - j / 3; bh = q + 8 * (j % 3); }
        else if (i < 160) { const int j = i - 152; type = 0; qb = 3 - (j >> 1); bh = q + 8 * (j & 1); }
        else { const int j = i - 160; type = 2; qb = 31 - j / 3; bh = q + 8 * (j % 3); }
        if (type == 0) { if (types & 1) diff_unit(c, bh >> 2, bh & 3, qb, P, (const bf16_t*)a.out + (size_t)16 * 1024 * 1024, Vt + (size_t)384 * TT, mrg, ((const float*)ctl)[16 + 2 * l], ((const float*)ctl)[17 + 2 * l], a.in[10] + l * 64); }
        else if (type == 1) { if (types & 2) moba_unit(c, bh / 6, bh % 6, qb, P, (const bf16_t*)(ws + WS_KIMG), Vt, (const float*)(ws + WS_KMEAN), mrg); }
        else if (types & 4) sb_unit(c, bh / 6, bh % 6, qb, P, (const bf16_t*)a.out, Vt + (size_t)640 * TT, mrg);
    }
}
__device__ __forceinline__ void phase_res(const Args& a, LAS unsigned char* lds, int l, bool o) {
    unsigned char* ws = a.ws;
    pg8::Gemm g; g.A = (const bf16_t*)(ws + (o ? WS_MRG : WS_OX)); g.Bt = wlayer(a, l) + (o ? W_OUT : W_XO); g.M = TT; g.N = 1024; g.K = o ? 1024 : 512;
    pg8::StaticOrder S; S.init(TT, 1024, grid_opaque(), bid_opaque());
    EpiRes E; E.h = (bf16_t*)(ws + WS_HB); E.ssq = (float*)(ws + WS_SSQ);
    E.red = (LAS float*)(lds + LDS_RED); E.tid = tid_opaque();
    pg8::gemm_phase<EpiRes, pg8::StaticOrder, true, true>(lds, g, S, E);
}
__device__ __forceinline__ void phase_xq(const Args& a, LAS unsigned char* lds, int l) {
    unsigned char* ws = a.ws;
    pg8::Gemm g{(const bf16_t*)(ws + WS_HB), wlayer(a, l) + W_XQ, TT, 512, 1024}; pg8::StaticOrder S; S.init(TT, 512, grid_opaque(), bid_opaque());
    EpiB16 E{(bf16_t*)(ws + WS_QX), 512, (const float*)(ws + WS_SSQ), 0.08838834764831845f * LOG2E};
    pg8::gemm_phase<EpiB16, pg8::StaticOrder, true, true>(lds, g, S, E);
    asm volatile("s_waitcnt vmcnt(0)" ::: "memory");
    __syncthreads();
    Unit u;
    if (S.next(0, u)) {
        ACtx c; make_ctx(c, lds);
        const bf16_t* kx = (const bf16_t*)(ws + WS_KX) + (size_t)l * 1024 * 512; const bf16_t* vxt = (const bf16_t*)(ws + WS_VXT) + (size_t)l * 512 * 1024;
#pragma unroll 1
        for (int hh = 0; hh < 2; ++hh) xattn_unit(c, u.pm >> 5, 2 * u.pn + hh, u.pm & 31, (const bf16_t*)(ws + WS_QX), kx, vxt, (bf16_t*)(ws + WS_OX));
    }
}
__device__ __forceinline__ void phase_xattn(const Args& a, LAS unsigned char* lds, int l) {
    unsigned char* ws = a.ws; ACtx c; make_ctx(c, lds);
    const bf16_t* kx = (const bf16_t*)(ws + WS_KX) + (size_t)l * 1024 * 512; const bf16_t* vxt = (const bf16_t*)(ws + WS_VXT) + (size_t)l * 512 * 1024;
    for (int i = bid_opaque(); i < 512; i += grid_opaque()) { const int qb = i & 31, bh = i >> 5; xattn_unit(c, bh >> 2, bh & 3, qb, (const bf16_t*)(ws + WS_QX), kx, vxt, (bf16_t*)(ws + WS_OX)); }
}
#define XB_TMO      128
#define XB_XCNT(j)  (256  + 64 * (j))
#define XB_XSUB(j)  (1280 + 64 * (j))
#define XB_XGEN(j)  (2304 + 64 * (j))
#define XB_TOP      3328
#define XB_TOPGEN   3392
#define XCD_BAR_WORDS 3456
#define XB_SPIN_CAP (1u << 18)

__device__ __forceinline__ unsigned xb_ld(unsigned* p)              { return __hip_atomic_load(p, __ATOMIC_RELAXED, __HIP_MEMORY_SCOPE_AGENT); }
__device__ __forceinline__ unsigned xb_add(unsigned* p, unsigned v) { return __hip_atomic_fetch_add(p, v, __ATOMIC_RELAXED, __HIP_MEMORY_SCOPE_AGENT); }
__device__ __forceinline__ unsigned xb_xcc_id() { return (unsigned)__builtin_amdgcn_s_getreg((3 << 11) | 20) & 0xFu; }
#define XB_SPIN(cond, bar) do { unsigned _sp = 0; while (cond) { __builtin_amdgcn_s_sleep(1); \
    if ((++_sp & 255u) == 0u) { if (xb_ld(&(bar)[XB_TMO])) break; if (_sp > XB_SPIN_CAP) { atomicAdd(&(bar)[XB_TMO], 1u); break; } } } } while (0)

struct XcdBarrier {
    unsigned* bar; unsigned x;
    volatile LAS unsigned* st;
};

__device__ __forceinline__ XcdBarrier xcd_barrier_post(unsigned* bar, volatile LAS unsigned* st) {
    XcdBarrier b; b.bar = bar; b.x = xb_xcc_id(); b.st = st;
    if (threadIdx.x == 0) (void)xb_add(&bar[XB_XCNT(b.x)], 1u);
    return b;
}
__device__ __forceinline__ void xcd_barrier_complete(unsigned* bar, unsigned x, unsigned& nloc, unsigned& nx) {
    const unsigned G = gridDim.x * gridDim.y * gridDim.z;
    unsigned sum, cnt, mine, sp = 0u;
    for (;;) {
        sum = 0u; cnt = 0u; mine = 0u;
#pragma unroll
        for (unsigned j = 0; j < 16; ++j) { const unsigned c = xb_ld(&bar[XB_XCNT(j)]); sum += c; cnt += (c > 0u) ? 1u : 0u; mine = (j == x) ? c : mine; }
        if (sum == G) break;
        __builtin_amdgcn_s_sleep(1);
        if ((++sp & 255u) == 0u) { if (xb_ld(&bar[XB_TMO])) break; if (sp > XB_SPIN_CAP) { atomicAdd(&bar[XB_TMO], 1u); break; } }
    }
    nloc = mine > 0u ? mine : 1u; nx = cnt > 0u ? cnt : 1u;
}

__device__ __forceinline__ void xcd_barrier(const XcdBarrier& b) {
    asm volatile("s_waitcnt vmcnt(0)" ::: "memory");
    __syncthreads();
    if (threadIdx.x == 0) {
        unsigned* bar = b.bar;
        __builtin_amdgcn_s_waitcnt(0);
        unsigned nloc = b.st[0], nx = b.st[1];
        if (nloc == 0u) { xcd_barrier_complete(bar, b.x, nloc, nx); b.st[0] = nloc; b.st[1] = nx; }
        const unsigned old = xb_add(&bar[XB_XSUB(b.x)], 1u);
        const unsigned gen = old / nloc;
        if (old + 1u == (gen + 1u) * nloc) {
            __builtin_amdgcn_fence(__ATOMIC_RELEASE, "agent");
            asm volatile("s_waitcnt vmcnt(0)" ::: "memory");
            const unsigned og = xb_add(&bar[XB_TOP], 1u);
            const unsigned tg = og / nx;
            if (og + 1u == (tg + 1u) * nx) xb_add(&bar[XB_TOPGEN], 1u);
            else XB_SPIN(xb_ld(&bar[XB_TOPGEN]) == tg, bar);
            __builtin_amdgcn_fence(__ATOMIC_ACQUIRE, "agent");
            xb_add(&bar[XB_XGEN(b.x)], 1u);
            asm volatile("s_waitcnt vmcnt(0)" ::: "memory");
        } else {
            XB_SPIN(xb_ld(&bar[XB_XGEN(b.x)]) == gen, bar);
            __builtin_amdgcn_fence(__ATOMIC_ACQUIRE, "agent");
            asm volatile("s_waitcnt vmcnt(0)" ::: "memory");
        }
    }
    __syncthreads();
}


__device__ __forceinline__ void grid_bar(unsigned* bar, unsigned k) {
    asm volatile("s_waitcnt vmcnt(0)" ::: "memory");
    __syncthreads();
    if (threadIdx.x == 0) {
        __builtin_amdgcn_fence(__ATOMIC_RELEASE, "agent");
        asm volatile("s_waitcnt vmcnt(0)" ::: "memory");
        const unsigned G = gridDim.x, g = blockIdx.x & 7u, ng = (G - g + 7u) >> 3;
        unsigned* sub = bar + 64 * (1 + g); unsigned* gen = bar + 64 * (9 + g); unsigned* top = bar + 64 * 17;
        const unsigned old = __hip_atomic_fetch_add(sub, 1u, __ATOMIC_RELAXED, __HIP_MEMORY_SCOPE_AGENT);
        if (old + 1u == k * ng) {
            const unsigned oldt = __hip_atomic_fetch_add(top, 1u, __ATOMIC_RELAXED, __HIP_MEMORY_SCOPE_AGENT);
            if (oldt + 1u == k * 8u) {
#pragma unroll
                for (int gg = 0; gg < 8; ++gg) __hip_atomic_store(bar + 64 * (9 + gg), k, __ATOMIC_RELAXED, __HIP_MEMORY_SCOPE_AGENT);
            }
        }
        while (__hip_atomic_load(gen, __ATOMIC_RELAXED, __HIP_MEMORY_SCOPE_AGENT) < k) __builtin_amdgcn_s_sleep(2);
        __builtin_amdgcn_fence(__ATOMIC_ACQUIRE, "agent");
        asm volatile("s_waitcnt vmcnt(0)" ::: "memory");
    }
    __syncthreads();
}
__global__ void __launch_bounds__(512, 2) fwd_kernel(Args a) {
    extern __shared__ __attribute__((aligned(16))) unsigned char lds_raw[];
    LAS unsigned char* lds = (LAS unsigned char*)lds_raw;
    volatile LAS unsigned* xst = (volatile LAS unsigned*)(lds + LDS_MISC + 256);
    if (threadIdx.x == 0) { xst[0] = 0u; xst[1] = 0u; }
    __syncthreads();
    XcdBarrier xbar = xcd_barrier_post((unsigned*)(a.ws + WS_CTL) + 1024, xst);
#pragma unroll 1
    for (int ph = a.ph_lo; ph < a.ph_hi; ++ph) {
        if (ph == 0) { const int t_ = tid_opaque(); prologue(a, lds, t_, t_ & 63, __builtin_amdgcn_readfirstlane(t_ >> 6)); }
        else if (ph == N_PHASES - 1) { const int t_ = tid_opaque(); final_norm(a, t_ & 63, __builtin_amdgcn_readfirstlane(t_ >> 6)); }
        else {
            const int l = (ph - 1) / 5, r = (ph - 1) % 5;
            if (r == 0) { if (PH_MASK & 1) phase_in(a, lds, l); }
            else if (r == 1) { phase_mix(a, lds, l, 0, MIX_TYPES);
#if PROBE_MIX
                __syncthreads(); phase_mix(a, lds, l, 1, PROBE_MIX);
#endif
            }
            else if (r == 2 || r == 4) { if (PH_MASK & 8) phase_res(a, lds, l, r == 2); }
            else { if (PH_MASK & 16) phase_xq(a, lds, l); }
        }
        if (ph + 1 < a.ph_hi) {
            if (a.ph_hi > 4096) cg::this_grid().sync();
            xcd_barrier(xbar);
        }
    }
}

#ifndef MK_PER_PHASE
#define MK_PER_PHASE 0
#endif
extern "C" void kernel_launch(void* const* d_in, const int* in_sizes, int n_in, void* d_out, int out_size, void* d_ws, size_t ws_size, hipStream_t stream) {
    static int grid = 0;
    if (grid == 0) {
        if (n_in != 17 || out_size != TT * DM || ws_size < WS_END) { fprintf(stderr, "kernel_launch: unexpected shapes (n_in %d out %d ws %zu)\n", n_in, out_size, ws_size); grid = -1; return; }
        int dev = 0, cus = 0, per_cu = 0;
        if (hipGetDevice(&dev) != hipSuccess || hipDeviceGetAttribute(&cus, hipDeviceAttributeMultiprocessorCount, dev) != hipSuccess) { grid = -1; return; }
        if (hipFuncSetAttribute((const void*)fwd_kernel, hipFuncAttributeMaxDynamicSharedMemorySize, LDS_BYTES) != hipSuccess) { fprintf(stderr, "kernel_launch: hipFuncSetAttribute failed\n"); grid = -1; return; }
        if (hipOccupancyMaxActiveBlocksPerMultiprocessor(&per_cu, (const void*)fwd_kernel, 512, LDS_BYTES) != hipSuccess || per_cu < 1) { fprintf(stderr, "kernel_launch: occupancy query says %d\n", per_cu); (void)hipGetLastError(); }
        grid = cus;
    }
    if (grid < 0) return;
    Args a{};
    for (int i = 0; i < 17; ++i) a.in[i] = (const float*)d_in[i];
    a.out = (float*)d_out; a.ws = (unsigned char*)d_ws;
#if MK_PER_PHASE
    for (int ph = 0; ph < N_PHASES; ++ph) { a.ph_lo = ph; a.ph_hi = ph + 1; hipLaunchKernelGGL(fwd_kernel, dim3(grid), dim3(512), LDS_BYTES, stream, a); }
#else
    a.ph_lo = 0; a.ph_hi = N_PHASES;
    (void)hipMemsetAsync(d_ws, 0, 32768, stream);
    void* args[] = {&a};
    hipError_t e = hipLaunchCooperativeKernel((const void*)fwd_kernel, dim3(grid), dim3(512), args, LDS_BYTES, stream);
    if (e != hipSuccess) fprintf(stderr, "kernel_launch: cooperative launch failed: %s (grid %d)\n", hipGetErrorString(e), grid);
#endif
}
```

```cpp
#include <hip/hip_runtime.h>
#include <hip/hip_cooperative_groups.h>
#include <cstdio>
#include <cstdint>
namespace cg = cooperative_groups;
__device__ __forceinline__ int tid_opaque() { int t = threadIdx.x; asm volatile("" : "+v"(t)); return t; }
__device__ __forceinline__ int bid_opaque() { int b = blockIdx.x; asm volatile("" : "+s"(b)); return b; }
__device__ __forceinline__ int grid_opaque() { int b = gridDim.x; asm volatile("" : "+s"(b)); return b; }
namespace pg8 {
#define PG8_LAS __attribute__((address_space(3)))
typedef unsigned short bf16_t;
typedef short bf16x8 __attribute__((ext_vector_type(8)));
typedef float f32x4 __attribute__((ext_vector_type(4)));
typedef unsigned u32x4 __attribute__((ext_vector_type(4)));
constexpr int BM = 256, BK = 64, HALF = 128, HTB = HALF * BK * 2  , STAGE_BYTES = 8 * HTB, NXCD = 8, WGM = 8;

__host__ __device__ __forceinline__ int lds_byte(int r, int c) { const int st = (r >> 4) * 2 + (c >> 5), rr = r & 15, cc = c & 31, ob = rr * 64 + cc * 2; return st * 1024 + (ob ^ (((ob >> 9) & 1) << 5)); }
__host__ __device__ __forceinline__ void stage_rc(int b, int& R, int& C) { const int st = b / 1024, sb = b % 1024, swz = sb ^ (((sb >> 9) & 1) << 5); R = (st >> 1) * 16 + swz / 64; C = (st & 1) * 32 + (swz % 64) / 2; }
__host__ __device__ __forceinline__ int perm32(int rho) { const int n = rho >> 4, i = rho & 15; return 8 * (i >> 2) + 4 * n + (i & 3); }

struct Unit { int pm, pn; };
struct Gemm { const bf16_t* A; const bf16_t* Bt; int M, N, K; };

struct StaticOrder {
    int nM, nN, nwg, G, c;
    __host__ __device__ void init(int M, int N, int G_, int c_) { nM = M / BM; nN = N / BM; nwg = nM * nN; G = G_; c = c_; }
    __host__ __device__ bool next(int i, Unit& u) const {
        const long L = (long)i * G + c; if (L >= nwg) return false;
        int wgid = (int)L; { const int q = nwg / NXCD, r = nwg % NXCD, xcd = wgid % NXCD, off = wgid / NXCD; wgid = (xcd < r ? xcd * (q + 1) : r * (q + 1) + (xcd - r) * q) + off; }
        const int nig = WGM * nN, gid = wgid / nig, fm = gid * WGM, gsz = (nM - fm) < WGM ? (nM - fm) : WGM;
        u.pm = fm + ((wgid % nig) % gsz); u.pn = (wgid % nig) / gsz; return true;
    }
    __device__ __forceinline__ void a_ready(const Unit&) const {}
    __device__ __forceinline__ void done(const Unit&) const {}
};

__device__ __forceinline__ unsigned cvt_pk_bf16(float lo, float hi) { unsigned r; asm volatile("v_cvt_pk_bf16_f32 %0, %1, %2" : "=v"(r) : "v"(lo), "v"(hi)); return r; }
typedef float f32x2 __attribute__((ext_vector_type(2)));
template <class Epi, class Sched, bool ALIGN_EPI = false, bool SP2 = false>
__device__ __forceinline__ void gemm_phase(PG8_LAS unsigned char* lds, const Gemm g, const Sched& S, const Epi& E) {
    const int tid = tid_opaque(), wid = __builtin_amdgcn_readfirstlane(tid >> 6), lane = tid & 63, wr = wid >> 2, wc = wid & 3, fr = lane & 15, fq = lane >> 4;
    const int K = g.K, nt = K / BK;
    unsigned voffA[2], voffB[2];
#pragma unroll
    for (int i = 0; i < 2; ++i) { int R, C; stage_rc(tid * 16 + i * 8192, R, C); const int Rb = Epi::PERM ? ((R & ~31) + perm32(R & 31)) : R;
        voffA[i] = (unsigned)(R * K + C) * 2u; voffB[i] = (unsigned)(Rb * K + C) * 2u; }
    const size_t kstep = (size_t)(BK * 2);
    const size_t hstep = (size_t)HALF * K * 2;
    const size_t tstep = 2 * hstep;
    const unsigned ldsw = (unsigned)wid * 1024u;
    const int aoff = lds_byte(wr * 64 + fr, fq * 8), boff = lds_byte(wc * 32 + fr, fq * 8);
#define PG8_SA(b, h) (((b) * 2 + (h)) * HTB)
#define PG8_SB(b, h) ((4 + (b) * 2 + (h)) * HTB)
#define PG8_STAGE(bufoff, gbase, voff) do { _Pragma("unroll") for (int _i = 0; _i < 2; ++_i) \
        __builtin_amdgcn_global_load_lds((const unsigned*)((const char*)(gbase) + (voff)[_i]), (PG8_LAS unsigned*)(lds + (bufoff) + ldsw + _i * 8192), 16, 0, 0); } while (0)
#define PG8_LDA(dst, b, h) do { _Pragma("unroll") for (int m = 0; m < 4; ++m) _Pragma("unroll") for (int k = 0; k < 2; ++k) dst[m][k] = *(const PG8_LAS bf16x8*)(lds + PG8_SA(b, h) + aoff + m * 2048 + k * 1024); } while (0)
#define PG8_LDB(dst, b, h) do { _Pragma("unroll") for (int n = 0; n < 2; ++n) _Pragma("unroll") for (int k = 0; k < 2; ++k) dst[n][k] = *(const PG8_LAS bf16x8*)(lds + PG8_SB(b, h) + boff + n * 2048 + k * 1024); } while (0)
#define PG8_MMA(ai, bj, At, Bt) do { __builtin_amdgcn_s_setprio(1); _Pragma("unroll") for (int m = 0; m < 4; ++m) _Pragma("unroll") for (int n = 0; n < 2; ++n) _Pragma("unroll") for (int k = 0; k < 2; ++k) \
        acc[ai][bj][m][n] = __builtin_amdgcn_mfma_f32_16x16x32_bf16(Bt[n][k], At[m][k], acc[ai][bj][m][n], 0, 0, 0); __builtin_amdgcn_s_setprio(0); } while (0)
#define PG8_WAIT_V(n) asm volatile("s_waitcnt vmcnt(" #n ")" ::: "memory")
#define PG8_WAIT_L(n) asm volatile("s_waitcnt lgkmcnt(" #n ")" ::: "memory")
#define PG8_BAR __builtin_amdgcn_s_barrier()
#define PG8_SCHED __builtin_amdgcn_sched_barrier(0)
    Unit cur, nxt; int ui = 0;
    if (!S.next(0, cur)) return;
    f32x4 acc[2][2][4][2];
#pragma unroll
    for (int a = 0; a < 2; ++a)
#pragma unroll
        for (int b = 0; b < 2; ++b)
#pragma unroll
            for (int m = 0; m < 4; ++m)
#pragma unroll
                for (int n = 0; n < 2; ++n) acc[a][b][m][n] = (f32x4){0.f, 0.f, 0.f, 0.f};
    bf16x8 At[4][2], B0[2][2], B1[2][2];
    const char* cA = (const char*)g.A + (size_t)cur.pm * tstep; const char* cB = (const char*)g.Bt + (size_t)cur.pn * tstep;
    S.a_ready(cur);
    if constexpr (SP2) {
        PG8_STAGE(PG8_SB(0, 0), cB, voffB); PG8_STAGE(PG8_SB(0, 1), cB + hstep, voffB); PG8_STAGE(PG8_SA(0, 0), cA, voffA); PG8_STAGE(PG8_SA(0, 1), cA + hstep, voffA);
        if (wr == 1) PG8_BAR;
        PG8_WAIT_V(2); PG8_BAR;
        PG8_STAGE(PG8_SB(1, 0), cB + kstep, voffB); PG8_STAGE(PG8_SA(1, 0), cA + kstep, voffA); PG8_STAGE(PG8_SB(1, 1), cB + hstep + kstep, voffB);
        PG8_WAIT_V(6); PG8_BAR;
    } else {
        PG8_STAGE(PG8_SB(0, 0), cB, voffB); PG8_STAGE(PG8_SA(0, 0), cA, voffA); PG8_STAGE(PG8_SB(0, 1), cB + hstep, voffB); PG8_STAGE(PG8_SA(0, 1), cA + hstep, voffA);
        if (wr == 1) PG8_BAR;
        PG8_WAIT_V(4); PG8_BAR;
        PG8_STAGE(PG8_SB(1, 0), cB + kstep, voffB); PG8_STAGE(PG8_SA(1, 0), cA + kstep, voffA); PG8_STAGE(PG8_SB(1, 1), cB + hstep + kstep, voffB);
        PG8_WAIT_V(6); PG8_BAR;
    }
    for (;;) {
        const bool has_next = S.next(ui + 1, nxt);
        const char* nA = has_next ? (const char*)g.A + (size_t)nxt.pm * tstep : cA; const char* nB = has_next ? (const char*)g.Bt + (size_t)nxt.pn * tstep : cB;
        for (int t = 0; t < nt; t += 2) {
            const bool last = (t == nt - 2);
            const char* a1 = cA + (size_t)(t + 1) * kstep;
            const char* a2 = last ? nA : cA + (size_t)(t + 2) * kstep; const char* b2 = last ? nB : cB + (size_t)(t + 2) * kstep;
            const char* a3 = a2 + kstep; const char* b3 = b2 + kstep;
            if (last && has_next) S.a_ready(nxt);
            if constexpr (SP2) {
            PG8_LDB(B0, 0, 0); PG8_LDB(B1, 0, 1); PG8_SCHED; PG8_LDA(At, 0, 0); PG8_STAGE(PG8_SA(1, 1), a1 + hstep, voffA);
            PG8_WAIT_V(8); PG8_WAIT_L(0); PG8_BAR; PG8_MMA(0, 0, At, B0); PG8_MMA(0, 1, At, B1); PG8_BAR; PG8_SCHED;
            PG8_LDA(At, 0, 1); PG8_STAGE(PG8_SB(0, 0), b2, voffB); PG8_STAGE(PG8_SB(0, 1), b2 + hstep, voffB); PG8_STAGE(PG8_SA(0, 0), a2, voffA);
            PG8_WAIT_V(8); PG8_WAIT_L(0); PG8_BAR; PG8_MMA(1, 0, At, B0); PG8_MMA(1, 1, At, B1); PG8_BAR; PG8_SCHED;
            PG8_LDB(B0, 1, 0); PG8_LDB(B1, 1, 1); PG8_SCHED; PG8_LDA(At, 1, 0); PG8_STAGE(PG8_SA(0, 1), a2 + hstep, voffA);
            PG8_WAIT_V(8); PG8_WAIT_L(0); PG8_BAR; PG8_MMA(0, 0, At, B0); PG8_MMA(0, 1, At, B1); PG8_BAR; PG8_SCHED;
            PG8_LDA(At, 1, 1); PG8_STAGE(PG8_SB(1, 0), b3, voffB); PG8_STAGE(PG8_SB(1, 1), b3 + hstep, voffB); PG8_STAGE(PG8_SA(1, 0), a3, voffA);
            PG8_WAIT_V(8); PG8_WAIT_L(0); PG8_BAR; PG8_MMA(1, 0, At, B0); PG8_MMA(1, 1, At, B1); PG8_BAR; PG8_SCHED;
            } else {
            PG8_LDB(B0, 0, 0); PG8_SCHED; PG8_LDA(At, 0, 0); PG8_STAGE(PG8_SA(1, 1), a1 + hstep, voffA);
            PG8_WAIT_L(8); PG8_BAR; PG8_WAIT_L(0); PG8_MMA(0, 0, At, B0); PG8_BAR; PG8_SCHED;
            PG8_LDB(B1, 0, 1); PG8_STAGE(PG8_SB(0, 0), b2, voffB);
            PG8_BAR; PG8_WAIT_L(0); PG8_MMA(0, 1, At, B1); PG8_BAR;
            PG8_LDA(At, 0, 1); PG8_STAGE(PG8_SA(0, 0), a2, voffA);
            PG8_BAR; PG8_WAIT_L(0); PG8_MMA(1, 0, At, B0); PG8_BAR; PG8_SCHED;
            PG8_STAGE(PG8_SB(0, 1), b2 + hstep, voffB);
            PG8_WAIT_V(6); PG8_BAR; PG8_MMA(1, 1, At, B1); PG8_BAR;
            PG8_LDB(B0, 1, 0); PG8_SCHED; PG8_LDA(At, 1, 0); PG8_STAGE(PG8_SA(0, 1), a2 + hstep, voffA);
            PG8_WAIT_L(8); PG8_BAR; PG8_WAIT_L(0); PG8_MMA(0, 0, At, B0); PG8_BAR; PG8_SCHED;
            PG8_LDB(B1, 1, 1); PG8_STAGE(PG8_SB(1, 0), b3, voffB);
            PG8_BAR; PG8_WAIT_L(0); PG8_MMA(0, 1, At, B1); PG8_BAR;
            PG8_LDA(At, 1, 1); PG8_STAGE(PG8_SA(1, 0), a3, voffA);
            PG8_BAR; PG8_WAIT_L(0); PG8_MMA(1, 0, At, B0); PG8_BAR; PG8_SCHED;
            PG8_STAGE(PG8_SB(1, 1), b3 + hstep, voffB);
            PG8_WAIT_V(6); PG8_BAR; PG8_MMA(1, 1, At, B1); PG8_BAR;
            }
        }
        if constexpr (ALIGN_EPI) { if (wr == 0) PG8_BAR; }
        if constexpr (!Epi::AFTER_DRAIN) { E(acc, cur, wr, wc, fr, fq); S.done(cur); }
        if (!has_next) break;
#pragma unroll
        for (int a = 0; a < 2; ++a)
#pragma unroll
            for (int b = 0; b < 2; ++b)
#pragma unroll
                for (int m = 0; m < 4; ++m)
#pragma unroll
                    for (int n = 0; n < 2; ++n) acc[a][b][m][n] = (f32x4){0.f, 0.f, 0.f, 0.f};
        cur = nxt; cA = nA; cB = nB; ++ui;
        if constexpr (ALIGN_EPI) { if (wr == 1) PG8_BAR; }
    }
    PG8_WAIT_V(0);
    if constexpr (!ALIGN_EPI) { if (wr == 0) PG8_BAR; }
    PG8_BAR;
    if constexpr (Epi::AFTER_DRAIN) { E.fused(acc, cur, wr, wc, fr, fq, lds, wid, lane); S.done(cur); }
#undef PG8_SA
#undef PG8_SB
#undef PG8_STAGE
#undef PG8_LDA
#undef PG8_LDB
#undef PG8_MMA
#undef PG8_WAIT_V
#undef PG8_WAIT_L
#undef PG8_BAR
#undef PG8_SCHED
}
}

using pg8::bf16_t; using pg8::bf16x8; using pg8::f32x4; using pg8::u32x4; using pg8::Unit;
typedef float f32x16 __attribute__((ext_vector_type(16)));
typedef unsigned u32x2 __attribute__((ext_vector_type(2)));
typedef float f32x2_t __attribute__((ext_vector_type(2)));
typedef __bf16 bf16x2_t __attribute__((ext_vector_type(2)));
#define LAS __attribute__((address_space(3)))
constexpr int TT = 32768, DM = 1024, SEQ = 8192, NBATCH = 4, MEML = 256;
constexpr int PW = 3072;
constexpr float RMS_EPS = 1e-6f;
constexpr float LOG2E = 1.4426950408889634f;
constexpr float NEGF = -1.0e30f;
constexpr size_t MiB = (size_t)1 << 20;
constexpr size_t WS_CTL = 0, WS_SSQ = 1 * MiB, WS_CS64 = 3 * MiB, WS_CS32 = 5 * MiB, WS_KMEAN = 6 * MiB, WS_MEMN = 8 * MiB, WS_KX = 12 * MiB, WS_VXT = 14 * MiB,
                 WS_W = 16 * MiB, WS_HB = 48 * MiB, WS_P = 112 * MiB, WS_VT = 304 * MiB, WS_MRG = 368 * MiB, WS_QX = 432 * MiB, WS_OX = 432 * MiB  , WS_KIMG = 464 * MiB, WS_END = 496 * MiB;
constexpr size_t W_MAIN = 0, W_V = (size_t)3072 * 1024, W_OUT = W_V + (size_t)1024 * 1024, W_XQ = W_OUT + (size_t)1024 * 1024, W_XK = W_XQ + (size_t)512 * 1024,
                 W_XV = W_XK + (size_t)512 * 1024, W_XO = W_XV + (size_t)512 * 1024, W_LAYER = W_XO + (size_t)1024 * 512;
static_assert(W_LAYER * 2 * 2 <= 32 * MiB, "weights fit");
constexpr int LDS_BYTES = 155648;
constexpr int LDS_MISC = 143360, LDS_RED = 143360 + 1024;

__device__ __forceinline__ unsigned cvtpk(float lo, float hi) { f32x2_t v = {lo, hi}; bf16x2_t b = __builtin_convertvector(v, bf16x2_t); return __builtin_bit_cast(unsigned, b); }
__device__ __forceinline__ float bflo(unsigned w) { return __uint_as_float(w << 16); }
__device__ __forceinline__ float bfhi(unsigned w) { return __uint_as_float(w & 0xffff0000u); }
__device__ __forceinline__ float ex2(float x) { return __builtin_amdgcn_exp2f(x); }
__device__ __forceinline__ float lg2(float x) { return __builtin_amdgcn_logf(x); }
__device__ __forceinline__ float rinv_row(const float* ssq, int row) {
    const f32x4 s = *(const f32x4*)(ssq + (size_t)row * 4);
    return __builtin_amdgcn_rsqf(((s.x + s.y) + (s.z + s.w)) * (1.f / 1024.f) + RMS_EPS);
}
__device__ __forceinline__ float silu_f(float y) { return y * __builtin_amdgcn_rcpf(1.f + ex2(-y * LOG2E)); }
#define ROT2(x1, x2, c, s) do { const float a_ = (x1) * (c) - (x2) * (s), b_ = (x2) * (c) + (x1) * (s); (x1) = a_; (x2) = b_; } while (0)

struct EpiIn {
    static constexpr bool PERM = true, AFTER_DRAIN = false;
    bf16_t* P; const float* ssq; const float* cs64; const float* cs32; bf16_t* Kimg; float* kpart; bf16_t* Ksb; bf16_t* Kdf;
    __device__ __forceinline__ void operator()(const f32x4 (&acc)[2][2][4][2], const Unit& u, int wr, int wc, int fr, int fq) const {
        const int row0 = u.pm * 256 + wr * 64 + fr;
        float rinv[2][4];
#pragma unroll
        for (int ai = 0; ai < 2; ++ai)
#pragma unroll
            for (int m = 0; m < 4; ++m) rinv[ai][m] = rinv_row(ssq, row0 + ai * 128 + m * 16);
#pragma unroll
        for (int bj = 0; bj < 2; ++bj) {
            const int seg = u.pn * 2 + bj;
            const int c0 = seg * 128 + wc * 32 + fq * 8;
            int kind; float sc = 1.f;
            if (seg < 3) { kind = 1; sc = 0.125f * LOG2E; } else if (seg < 6) { kind = 1; } else if (seg < 9) { kind = 3; }
            else if (seg < 11) { kind = 2; sc = 0.17677669529663687f * LOG2E; } else if (seg < 13) { kind = 2; } else if (seg < 15) { kind = 3; }
            else if (seg < 18) { kind = 0; sc = 0.125f * LOG2E; } else if (seg < 21) { kind = 0; } else { kind = 3; }
            const bool rope = (kind == 1 && (c0 & 63) < 16) || (kind == 2 && (c0 & 31) == 0);
            f32x4 cs0 = {0.f, 0.f, 0.f, 0.f}, cs1 = {0.f, 0.f, 0.f, 0.f};
#pragma unroll
            for (int ai = 0; ai < 2; ++ai)
#pragma unroll
                for (int m = 0; m < 4; ++m) {
                    const int row = row0 + ai * 128 + m * 16; const float s = rinv[ai][m];
                    f32x4 v0 = acc[ai][bj][m][0] * s, v1 = acc[ai][bj][m][1] * s;
                    if (kind == 3) {
                        v0.x = silu_f(v0.x); v0.y = silu_f(v0.y); v0.z = silu_f(v0.z); v0.w = silu_f(v0.w);
                        v1.x = silu_f(v1.x); v1.y = silu_f(v1.y); v1.z = silu_f(v1.z); v1.w = silu_f(v1.w);
                    } else {
                        if (rope) {
                            const float* t = (kind == 1) ? (cs64 + (size_t)row * 16 + (c0 & 63)) : (cs32 + (size_t)row * 8);
                            const f32x4 t0 = *(const f32x4*)t, t1 = *(const f32x4*)(t + 4);
                            ROT2(v0.x, v0.y, t0.x, t0.y); ROT2(v0.z, v0.w, t0.z, t0.w); ROT2(v1.x, v1.y, t1.x, t1.y); ROT2(v1.z, v1.w, t1.z, t1.w);
                        }
                        v0 = v0 * sc; v1 = v1 * sc;
                        cs0 = cs0 + v0; cs1 = cs1 + v1;
                    }
                    u32x4 w; w.x = cvtpk(v0.x, v0.y); w.y = cvtpk(v0.z, v0.w); w.z = cvtpk(v1.x, v1.y); w.w = cvtpk(v1.z, v1.w);
                    bf16_t* dst = P + (size_t)row * PW + c0;
                    if (seg >= 3 && seg < 6) {
                        const int cc = c0 - 384, hh = cc >> 6, ch = (cc & 63) >> 3, bb = row >> 13, s = row & 8191;
                        dst = Kimg + ((((size_t)(bb * 6 + hh) * 128 + (s >> 6)) * 8 + ch) * 64 + (s & 63)) * 8;
                    }
                    if (seg >= 11 && seg < 13) {
                        const int cc = c0 - 1408, hh = cc >> 6, ch = (cc & 63) >> 3, bb = row >> 13, s = row & 8191;
                        dst = Kdf + ((((size_t)(bb * 4 + hh) * 128 + (s >> 6)) * 8 + ch) * 64 + (s & 63)) * 8;
                    }
                    if (seg >= 18 && seg < 21) {
                        const int cc = c0 - 2304, hh = cc >> 6, ch = (cc & 63) >> 3, bb = row >> 13, s = row & 8191;
                        dst = Ksb + ((((size_t)(bb * 6 + hh) * 128 + (s >> 6)) * 8 + ch) * 64 + (s & 63)) * 8;
                    }
                    *(u32x4*)dst = w;
                }
            if (seg >= 3 && seg < 6) {
#pragma unroll
                for (int o = 1; o < 16; o <<= 1) {
                    cs0.x += __shfl_xor(cs0.x, o); cs0.y += __shfl_xor(cs0.y, o); cs0.z += __shfl_xor(cs0.z, o); cs0.w += __shfl_xor(cs0.w, o);
                    cs1.x += __shfl_xor(cs1.x, o); cs1.y += __shfl_xor(cs1.y, o); cs1.z += __shfl_xor(cs1.z, o); cs1.w += __shfl_xor(cs1.w, o);
                }
                if (fr == 0) {
                    const int cc = c0 - 384, hh = cc >> 6, bb = u.pm >> 5, blk = u.pm & 31;
                    float* kp = kpart + ((((size_t)(bb * 6 + hh) * 32 + blk) * 2 + wr) * 64 + (cc & 63));
                    *(f32x4*)kp = cs0; *(f32x4*)(kp + 4) = cs1;
                }
            }
        }
    }
};
struct EpiVt {
    static constexpr bool PERM = true, AFTER_DRAIN = false;
    bf16_t* Vt; const float* ssq;
    __device__ __forceinline__ void operator()(const f32x4 (&acc)[2][2][4][2], const Unit& u, int wr, int wc, int fr, int fq) const {
        const int row0 = u.pm * 256 + wr * 64 + fr;
#pragma unroll
        for (int bj = 0; bj < 2; ++bj) {
            const int c0 = u.pn * 256 + bj * 128 + wc * 32 + fq * 8;
            float ri[8];
#pragma unroll
            for (int j = 0; j < 8; ++j) ri[j] = rinv_row(ssq, c0 + j);
#pragma unroll
            for (int ai = 0; ai < 2; ++ai)
#pragma unroll
                for (int m = 0; m < 4; ++m) {
                    const int row = row0 + ai * 128 + m * 16;
                    const f32x4 v0 = acc[ai][bj][m][0], v1 = acc[ai][bj][m][1];
                    u32x4 w; w.x = cvtpk(v0.x * ri[0], v0.y * ri[1]); w.y = cvtpk(v0.z * ri[2], v0.w * ri[3]); w.z = cvtpk(v1.x * ri[4], v1.y * ri[5]); w.w = cvtpk(v1.z * ri[6], v1.w * ri[7]);
                    bf16_t* dst = Vt + (size_t)row * TT + c0;
                    if (2 * u.pm + ai < 3) {
                        const int hh = row >> 6, d = row & 63, bb = c0 >> 13, s = c0 & 8191;
                        dst = Vt + ((((size_t)(bb * 6 + hh) * 128 + (s >> 6)) * 8 + ((s & 63) >> 3)) * 64 + d) * 8;
                    }
                    if (2 * u.pm + ai == 3 || 2 * u.pm + ai == 4) {
                        const int rr = row - 384, hh = rr >> 6, d = rr & 63, bb = c0 >> 13, s = c0 & 8191;
                        dst = Vt + (size_t)384 * TT + ((((size_t)(bb * 4 + hh) * 128 + (s >> 6)) * 8 + ((s & 63) >> 3)) * 64 + d) * 8;
                    }
                    if (2 * u.pm + ai >= 5) {
                        const int rr = row - 640, hh = rr >> 6, d = rr & 63, bb = c0 >> 13, s = c0 & 8191;
                        dst = Vt + (size_t)640 * TT + ((((size_t)(bb * 6 + hh) * 128 + (s >> 6)) * 8 + ((s & 63) >> 3)) * 64 + d) * 8;
                    }
                    *(u32x4*)dst = w;
                }
        }
    }
};
struct EpiRes {
    static constexpr bool PERM = true, AFTER_DRAIN = false;
    bf16_t* h; float* ssq; LAS float* red; int tid;
    __device__ __forceinline__ void operator()(const f32x4 (&acc)[2][2][4][2], const Unit& u, int wr, int wc, int fr, int fq) const {
        const int row0 = u.pm * 256 + wr * 64 + fr, col0 = u.pn * 256 + wc * 32 + 8 * fq;
#pragma unroll
        for (int ai = 0; ai < 2; ++ai)
#pragma unroll
            for (int m = 0; m < 4; ++m) {
                const int row = row0 + ai * 128 + m * 16; float ss = 0.f;
#pragma unroll
                for (int bj = 0; bj < 2; ++bj) {
                    bf16_t* p = h + (size_t)row * DM + col0 + bj * 128;
                    const u32x4 v = *(const u32x4*)p; const f32x4 a0 = acc[ai][bj][m][0], a1 = acc[ai][bj][m][1];
                    const float h0 = bflo(v.x) + a0.x, h1 = bfhi(v.x) + a0.y, h2 = bflo(v.y) + a0.z, h3 = bfhi(v.y) + a0.w, h4 = bflo(v.z) + a1.x, h5 = bfhi(v.z) + a1.y, h6 = bflo(v.w) + a1.z, h7 = bfhi(v.w) + a1.w;
                    u32x4 w; w.x = cvtpk(h0, h1); w.y = cvtpk(h2, h3); w.z = cvtpk(h4, h5); w.w = cvtpk(h6, h7);
                    *(u32x4*)p = w;
                    const float r0 = bflo(w.x), r1 = bfhi(w.x), r2 = bflo(w.y), r3 = bfhi(w.y), r4 = bflo(w.z), r5 = bfhi(w.z), r6 = bflo(w.w), r7 = bfhi(w.w);
                    ss += ((r0 * r0 + r1 * r1) + (r2 * r2 + r3 * r3)) + ((r4 * r4 + r5 * r5) + (r6 * r6 + r7 * r7));
                }
                ss += __shfl_xor(ss, 16); ss += __shfl_xor(ss, 32);
                if (fq == 0) red[(ai * 128 + wr * 64 + m * 16 + fr) * 4 + wc] = ss;
            }
        asm volatile("s_waitcnt lgkmcnt(0)" ::: "memory"); __builtin_amdgcn_s_barrier(); asm volatile("" ::: "memory");
        if (tid < 256) { const f32x4 v = *(const LAS f32x4*)(red + tid * 4); ssq[(size_t)(u.pm * 256 + tid) * 4 + u.pn] = (v.x + v.y) + (v.z + v.w); }
    }
};
struct EpiB16 {
    static constexpr bool PERM = true, AFTER_DRAIN = false;
    bf16_t* O; int ldc; const float* ssq; float scale;
    __device__ __forceinline__ void operator()(const f32x4 (&acc)[2][2][4][2], const Unit& u, int wr, int wc, int fr, int fq) const {
        const int row0 = u.pm * 256 + wr * 64 + fr;
#pragma unroll
        for (int ai = 0; ai < 2; ++ai)
#pragma unroll
            for (int m = 0; m < 4; ++m) {
                const int row = row0 + ai * 128 + m * 16; const float s = ssq ? scale * rinv_row(ssq, row) : scale;
#pragma unroll
                for (int bj = 0; bj < 2; ++bj) {
                    const int c0 = u.pn * 256 + bj * 128 + wc * 32 + fq * 8;
                    const f32x4 v0 = acc[ai][bj][m][0] * s, v1 = acc[ai][bj][m][1] * s;
                    u32x4 w; w.x = cvtpk(v0.x, v0.y); w.y = cvtpk(v0.z, v0.w); w.z = cvtpk(v1.x, v1.y); w.w = cvtpk(v1.z, v1.w);
                    *(u32x4*)(O + (size_t)row * ldc + c0) = w;
                }
            }
    }
};

struct ACtx { int tid, lane, wid, r32, hi, r32p; LAS unsigned char* lds; };
#define MFMA32(a, b, c) __builtin_amdgcn_mfma_f32_32x32x16_bf16((a), (b), (c), 0, 0, 0)

template <int ROWS, int CH> struct Stage {
    static constexpr int N = ROWS * CH / 512;
    u32x4 r[N];
    __device__ __forceinline__ void load(const bf16_t* g, size_t pitch, int tid) {
#pragma unroll
        for (int i = 0; i < N; ++i) { const int idx = tid + i * 512, rl = idx & 7, c = (idx >> 3) & (CH - 1), rh = idx / (8 * CH); r[i] = *(const u32x4*)(g + (size_t)(rh * 8 + rl) * pitch + c * 8); }
    }
    __device__ __forceinline__ void store(LAS unsigned char* dst, int tid) const {
#pragma unroll
        for (int i = 0; i < N; ++i) { const int idx = tid + i * 512, rl = idx & 7, c = (idx >> 3) & (CH - 1), rh = idx / (8 * CH); *(LAS u32x4*)(dst + c * (ROWS * 16) + (rh * 8 + rl) * 16) = r[i]; }
    }
};
template <int ROWS, int CH> __device__ __forceinline__ void stage_glds(const bf16_t* g, size_t pitch, LAS unsigned char* dst, const ACtx& c) {
    constexpr int RB = ROWS / 64, NP = RB * CH / 8;
#pragma unroll
    for (int i = 0; i < NP; ++i) {
        const int p = c.wid + 8 * i, chunk = p / RB, rb = p % RB;
        __builtin_amdgcn_global_load_lds((const unsigned*)(g + (size_t)(rb * 64 + c.lane) * pitch + chunk * 8), (LAS unsigned*)(dst + chunk * (ROWS * 16) + rb * 1024), 16, 0, 0);
    }
}
__device__ __forceinline__ bf16x8 pack8(float a0, float a1, float a2, float a3, float a4, float a5, float a6, float a7) {
    u32x4 w; w.x = cvtpk(a0, a1); w.y = cvtpk(a2, a3); w.z = cvtpk(a4, a5); w.w = cvtpk(a6, a7); return __builtin_bit_cast(bf16x8, w);
}
template <int NK, int KSTR = 1024> __device__ __forceinline__ void qk_tile(f32x16& p0, f32x16& p1, const LAS unsigned char* Ks, int cb, const bf16x8* qr, const ACtx& c) {
    f32x16 z;
#pragma unroll
    for (int r = 0; r < 16; ++r) z[r] = 0.f;
    p0 = z; p1 = z;
    __builtin_amdgcn_s_setprio(1);
#pragma unroll
    for (int d0 = 0; d0 < NK; ++d0) {
        const LAS unsigned char* a = Ks + (cb + 2 * d0 + c.hi) * KSTR + c.r32p * 16;
        const bf16x8 k0 = *(const LAS bf16x8*)a, k1 = *(const LAS bf16x8*)(a + 512);
        p0 = MFMA32(k0, qr[d0], p0); p1 = MFMA32(k1, qr[d0], p1);
    }
    __builtin_amdgcn_s_setprio(0);
}
template <int DVB, int VSTR = 512 * DVB> __device__ __forceinline__ void pv_tile(f32x16* o, const LAS unsigned char* Vs, const f32x16& p0, const f32x16& p1, const ACtx& c) {
    bf16x8 pf[4];
    pf[0] = pack8(p0[0], p0[1], p0[2], p0[3], p0[4], p0[5], p0[6], p0[7]); pf[1] = pack8(p0[8], p0[9], p0[10], p0[11], p0[12], p0[13], p0[14], p0[15]);
    pf[2] = pack8(p1[0], p1[1], p1[2], p1[3], p1[4], p1[5], p1[6], p1[7]); pf[3] = pack8(p1[8], p1[9], p1[10], p1[11], p1[12], p1[13], p1[14], p1[15]);
#pragma unroll
    for (int s = 0; s < 4; ++s)
#pragma unroll
        for (int d0 = 0; d0 < DVB; ++d0) {
            const bf16x8 v = *(const LAS bf16x8*)(Vs + (2 * s + c.hi) * VSTR + (32 * d0 + c.r32) * 16);
            o[d0] = MFMA32(v, pf[s], o[d0]);
        }
}
__device__ __forceinline__ float softmax_step(f32x16& p0, f32x16& p1, float& m, float& l) {
    float mx = fmaxf(p0[0], p1[0]);
#pragma unroll
    for (int r = 1; r < 16; ++r) mx = fmaxf(mx, fmaxf(p0[r], p1[r]));
    mx = fmaxf(mx, __shfl_xor(mx, 32));
    const float mn = fmaxf(m, mx), alpha = ex2(m - mn); m = mn;
    float rs = 0.f;
#pragma unroll
    for (int r = 0; r < 16; ++r) { p0[r] = ex2(p0[r] - mn); p1[r] = ex2(p1[r] - mn); rs += p0[r] + p1[r]; }
    l = l * alpha + rs;
    return alpha;
}
__device__ __forceinline__ void scale_o(f32x16& o, float a) {
#pragma unroll
    for (int r = 0; r < 16; ++r) o[r] *= a;
}
__device__ __forceinline__ void zero16(f32x16& o) {
#pragma unroll
    for (int r = 0; r < 16; ++r) o[r] = 0.f;
}
__device__ __forceinline__ void xhalf(float v, float& lo, float& hi) { auto r = __builtin_amdgcn_permlane32_swap(__float_as_uint(v), __float_as_uint(v), false, false); lo = __uint_as_float(r[0]); hi = __uint_as_float(r[1]); }
__device__ __forceinline__ float xhalf_partner(float v, int hi_lane) { float lo, hi; xhalf(v, lo, hi); return hi_lane ? lo : hi; }
__device__ __forceinline__ unsigned xhalf_or(unsigned v) { auto r = __builtin_amdgcn_permlane32_swap(v, v, false, false); return r[0] | r[1]; }
struct Soft { float m; int zm; float l; };
__device__ __forceinline__ void soft_init(Soft& s) { s.m = 0.f; s.zm = 1; s.l = 0.f; }
__device__ __forceinline__ float max3f(float a, float b, float c) { float r; asm("v_max3_f32 %0, %1, %2, %3" : "=v"(r) : "v"(a), "v"(b), "v"(c)); return r; }
template <int NO> __device__ __forceinline__ void soft_step(Soft& s, f32x16& p0, f32x16& p1, f32x16* o, bool first) {
    float a = max3f(p0[0], p0[1], p1[0]), b = max3f(p0[2], p0[3], p1[1]); a = max3f(a, p1[2], p1[3]);
#pragma unroll
    for (int r = 4; r < 16; r += 4) { a = max3f(a, p0[r], p0[r + 1]); b = max3f(b, p0[r + 2], p0[r + 3]); a = max3f(a, p1[r], p1[r + 1]); b = max3f(b, p1[r + 2], p1[r + 3]); }
    float mx = max3f(a, b, b);
    { float lo_, hi_; xhalf(mx, lo_, hi_); mx = max3f(lo_, hi_, hi_); }
    const float d = mx - s.m;
    const bool up = d > 32.f, dn = first && (d < -32.f) && (mx > -1.0e29f);
    if (__any(up || dn)) {
        const float mn = (up || dn) ? mx : s.m; const float alpha = ex2(s.m - mn); s.m = mn;
        s.l *= alpha;
#pragma unroll
        for (int i = 0; i < NO; ++i) scale_o(o[i], alpha);
        s.zm = __all(s.m == 0.f);
    }
    if (s.zm) {
#pragma unroll
        for (int r = 0; r < 16; ++r) { p0[r] = ex2(p0[r]); p1[r] = ex2(p1[r]); }
    } else {
        const float m = s.m;
#pragma unroll
        for (int r = 0; r < 16; ++r) { p0[r] = ex2(p0[r] - m); p1[r] = ex2(p1[r] - m); }
    }
}
__device__ __forceinline__ bf16x8 ones8() { u32x4 w; w.x = 0x3F803F80u; w.y = 0x3F803F80u; w.z = 0x3F803F80u; w.w = 0x3F803F80u; return __builtin_bit_cast(bf16x8, w); }
template <int DVB, int VSTR> __device__ __forceinline__ void pv_tile_l(f32x16* o, float& l, const LAS unsigned char* Vs, const f32x16& p0, const f32x16& p1, const ACtx& c) {
    bf16x8 pf[4];
    pf[0] = pack8(p0[0], p0[1], p0[2], p0[3], p0[4], p0[5], p0[6], p0[7]); pf[1] = pack8(p0[8], p0[9], p0[10], p0[11], p0[12], p0[13], p0[14], p0[15]);
    pf[2] = pack8(p1[0], p1[1], p1[2], p1[3], p1[4], p1[5], p1[6], p1[7]); pf[3] = pack8(p1[8], p1[9], p1[10], p1[11], p1[12], p1[13], p1[14], p1[15]);
    const bf16x8 one = ones8();
    f32x16 la; zero16(la);
    __builtin_amdgcn_s_setprio(1);
#pragma unroll
    for (int s = 0; s < 4; ++s) {
        la = MFMA32(one, pf[s], la);
#pragma unroll
        for (int d0 = 0; d0 < DVB; ++d0) {
            const bf16x8 v = *(const LAS bf16x8*)(Vs + (2 * s + c.hi) * VSTR + (32 * d0 + c.r32) * 16);
            o[d0] = MFMA32(v, pf[s], o[d0]);
        }
    }
    __builtin_amdgcn_s_setprio(0);
    l += la[0];
}
template <bool STRICT> __device__ __forceinline__ void mask_causal(f32x16& p0, f32x16& p1, int kbase, int q, int hi) {
#pragma unroll
    for (int r = 0; r < 16; ++r) {
        const int key = kbase + 16 * (r >> 3) + 8 * hi + (r & 7);
        const bool v0 = STRICT ? (key < q) : (key <= q), v1 = STRICT ? (key + 32 < q) : (key + 32 <= q);
        p0[r] = v0 ? p0[r] : NEGF; p1[r] = v1 ? p1[r] : NEGF;
    }
}
__device__ __forceinline__ void top3_insert(float& t1, float& t2, float& t3, float v) {
    const float a = fmaxf(t1, v), b = fminf(t1, v); t1 = a; const float c = fmaxf(t2, b), d = fminf(t2, b); t2 = c; t3 = fmaxf(t3, d);
}

__device__ __forceinline__ void store_gated_rows(const ACtx& c, LAS unsigned char* stg, const f32x16* o, const bf16_t* Gp0, bf16_t* Op0, size_t gpitch) {
#pragma unroll
    for (int d0 = 0; d0 < 2; ++d0)
#pragma unroll
        for (int r4 = 0; r4 < 4; ++r4) {
            u32x2 w; w.x = cvtpk(o[d0][4 * r4], o[d0][4 * r4 + 1]); w.y = cvtpk(o[d0][4 * r4 + 2], o[d0][4 * r4 + 3]);
            *(LAS u32x2*)(stg + c.r32 * 128 + (((4 * d0 + r4) ^ (c.r32 & 7)) * 16) + c.hi * 8) = w;
        }
    asm volatile("s_waitcnt lgkmcnt(0)" ::: "memory");
#pragma unroll
    for (int i = 0; i < 4; ++i) {
        const int row = i * 8 + (c.lane >> 3), ch = c.lane & 7;
        const u32x4 v = *(const LAS u32x4*)(stg + row * 128 + ((ch ^ (row & 7)) * 16));
        const u32x4 g = *(const u32x4*)(Gp0 + (size_t)row * gpitch + ch * 8);
        u32x4 w; w.x = cvtpk(bflo(v.x) * bflo(g.x), bfhi(v.x) * bfhi(g.x)); w.y = cvtpk(bflo(v.y) * bflo(g.y), bfhi(v.y) * bfhi(g.y));
        w.z = cvtpk(bflo(v.z) * bflo(g.z), bfhi(v.z) * bfhi(g.z)); w.w = cvtpk(bflo(v.w) * bflo(g.w), bfhi(v.w) * bfhi(g.w));
        *(u32x4*)(Op0 + (size_t)row * DM + ch * 8) = w;
    }
    asm volatile("s_waitcnt lgkmcnt(0)" ::: "memory");
}
constexpr int MOBA_PART = 32768, MOBA_REC = 136;
template <int NP> __device__ __forceinline__ void stage_linear(const bf16_t* g, LAS unsigned char* dst, const ACtx& c) {
#pragma unroll
    for (int i = 0; i < NP; ++i) { const int p = c.wid + 8 * i; __builtin_amdgcn_global_load_lds((const unsigned*)(g + (size_t)p * 512 + c.lane * 8), (LAS unsigned*)(dst + p * 1024), 16, 0, 0); }
}
__device__ __forceinline__ void moba_unit(const ACtx& c, int b, int h, int qb, const bf16_t* P, const bf16_t* Kimg, const bf16_t* Vimg, const float* kpart, bf16_t* merged) {
    const size_t tok0 = (size_t)b * SEQ;
    const int qrel = c.wid * 32 + c.r32;
    const size_t qtok = tok0 + qb * 256 + qrel;
    const bf16_t* Kg = Kimg + (size_t)(b * 6 + h) * 128 * 4096;
    const bf16_t* Vg = Vimg + (size_t)(b * 6 + h) * 128 * 4096;
    const bf16_t* Qp = P + qtok * PW + h * 64;
    unsigned sel = 0u;
    if (qb > 0) {
        {
            bf16x8 qr[4];
#pragma unroll
            for (int d0 = 0; d0 < 4; ++d0) qr[d0] = *(const bf16x8*)(Qp + d0 * 16 + c.hi * 8);
            f32x16 g; zero16(g);
            const float* km = kpart + ((size_t)(b * 6 + h) * 32 + c.r32) * 128;
#pragma unroll
            for (int d0 = 0; d0 < 4; ++d0) {
                const float* kq = km + d0 * 16 + c.hi * 8;
                const f32x4 a0 = *(const f32x4*)kq + *(const f32x4*)(kq + 64), a1 = *(const f32x4*)(kq + 4) + *(const f32x4*)(kq + 68);
                const float sc = 1.f / 256.f;
                const bf16x8 kf = pack8(a0.x * sc, a0.y * sc, a0.z * sc, a0.w * sc, a1.x * sc, a1.y * sc, a1.z * sc, a1.w * sc); g = MFMA32(kf, qr[d0], g);
            }
            float t1 = NEGF, t2 = NEGF, t3 = NEGF;
#pragma unroll
            for (int r = 0; r < 16; ++r) { const int blk = (r & 3) + 8 * (r >> 2) + 4 * c.hi; const float v = (blk < qb) ? g[r] : NEGF; g[r] = v; top3_insert(t1, t2, t3, v); }
            const float u1 = xhalf_partner(t1, c.hi), u2 = xhalf_partner(t2, c.hi), u3 = xhalf_partner(t3, c.hi);
            top3_insert(t1, t2, t3, u1); top3_insert(t1, t2, t3, u2); top3_insert(t1, t2, t3, u3);
            unsigned seq = 0u;
#pragma unroll
            for (int r = 0; r < 16; ++r) { const int blk = (r & 3) + 8 * (r >> 2) + 4 * c.hi; if (blk < qb) { if (g[r] > t3) sel |= 1u << blk; else if (g[r] == t3) seq |= 1u << blk; } }
            sel = xhalf_or(sel); seq = xhalf_or(seq);
            { const int need = 3 - __popc(sel); while (__popc(seq) > need) seq &= ~(0x80000000u >> __clz((int)seq)); }
            sel |= seq;
        }
        LAS int* cnt = (LAS int*)c.lds; LAS unsigned short* list = (LAS unsigned short*)(c.lds + 1024);
        if (c.tid < 32) cnt[c.tid] = 0;
        __syncthreads();
        if (c.hi == 0) {
            unsigned s = sel; int slot = 0;
            while (s) { const int blk = __ffs((int)s) - 1; s &= s - 1u; const int pos = __hip_atomic_fetch_add(cnt + blk, 1, __ATOMIC_RELAXED, __HIP_MEMORY_SCOPE_WORKGROUP); list[blk * 256 + pos] = (unsigned short)(qrel | (slot << 8)); ++slot; }
        }
        __syncthreads();
        int item = 0;
#pragma unroll 1
        for (int j = 0; j < qb; ++j) {
            const int n = __builtin_amdgcn_readfirstlane(cnt[j]); const int ntile = (n + 31) >> 5;
#pragma unroll 1
            for (int tl = 0; tl < ntile; ++tl, ++item) {
                if ((item & 7) != c.wid) continue;
                const int idx = 32 * tl + c.r32; const bool valid = idx < n;
                const unsigned e = list[j * 256 + (valid ? idx : 0)]; const int ql = e & 255, slot = e >> 8;
                const bf16_t* Qg = P + (tok0 + qb * 256 + ql) * PW + h * 64;
                bf16x8 qg[4];
#pragma unroll
                for (int d0 = 0; d0 < 4; ++d0) qg[d0] = *(const bf16x8*)(Qg + d0 * 16 + c.hi * 8);
                Soft s2; soft_init(s2); f32x16 o2[2]; zero16(o2[0]); zero16(o2[1]);
                const bf16_t* kp = Kg + (size_t)(j * 4) * 4096 + (c.hi * 64 + c.r32p) * 8;
                const bf16_t* vp = Vg + (size_t)(j * 4) * 4096 + (c.hi * 64 + c.r32) * 8;
                bf16x8 kc[8];
#pragma unroll
                for (int i = 0; i < 4; ++i) { kc[2 * i] = *(const bf16x8*)(kp + i * 1024); kc[2 * i + 1] = *(const bf16x8*)(kp + i * 1024 + 256); }
#pragma unroll 1
                for (int kt = 0; kt < 4; ++kt) {
                    bf16x8 vc[8];
                    { const bf16_t* vq = vp + (size_t)kt * 4096;
#pragma unroll
                      for (int i = 0; i < 4; ++i) { vc[2 * i] = *(const bf16x8*)(vq + i * 1024); vc[2 * i + 1] = *(const bf16x8*)(vq + i * 1024 + 256); } }
                    f32x16 p0, p1; zero16(p0); zero16(p1);
#pragma unroll
                    for (int d0 = 0; d0 < 4; ++d0) { p0 = MFMA32(kc[2 * d0], qg[d0], p0); p1 = MFMA32(kc[2 * d0 + 1], qg[d0], p1); }
                    if (kt < 3) {
                        const bf16_t* kq = kp + (size_t)(kt + 1) * 4096;
#pragma unroll
                        for (int i = 0; i < 4; ++i) { kc[2 * i] = *(const bf16x8*)(kq + i * 1024); kc[2 * i + 1] = *(const bf16x8*)(kq + i * 1024 + 256); }
                    }
                    soft_step<2>(s2, p0, p1, o2, kt == 0);
                    bf16x8 pf[4]; const bf16x8 one = ones8(); f32x16 la; zero16(la);
                    pf[0] = pack8(p0[0], p0[1], p0[2], p0[3], p0[4], p0[5], p0[6], p0[7]); pf[1] = pack8(p0[8], p0[9], p0[10], p0[11], p0[12], p0[13], p0[14], p0[15]);
                    pf[2] = pack8(p1[0], p1[1], p1[2], p1[3], p1[4], p1[5], p1[6], p1[7]); pf[3] = pack8(p1[8], p1[9], p1[10], p1[11], p1[12], p1[13], p1[14], p1[15]);
#pragma unroll
                    for (int s = 0; s < 4; ++s) {
                        la = MFMA32(one, pf[s], la);
                        o2[0] = MFMA32(vc[2 * s], pf[s], o2[0]); o2[1] = MFMA32(vc[2 * s + 1], pf[s], o2[1]);
                    }
                    s2.l += la[0];
                }
                const float m2 = s2.m, l2 = s2.l;
                if (valid) {
                    LAS unsigned char* rec = c.lds + MOBA_PART + (ql * 3 + slot) * MOBA_REC;
#pragma unroll
                    for (int d0 = 0; d0 < 2; ++d0)
#pragma unroll
                        for (int r4 = 0; r4 < 4; ++r4) { u32x2 w; w.x = cvtpk(o2[d0][4 * r4], o2[d0][4 * r4 + 1]); w.y = cvtpk(o2[d0][4 * r4 + 2], o2[d0][4 * r4 + 3]); *(LAS u32x2*)(rec + (32 * d0 + 8 * r4 + 4 * c.hi) * 2) = w; }
                    if (c.hi == 0) { *(LAS float*)(rec + 128) = m2; *(LAS float*)(rec + 132) = l2; }
                }
            }
        }
        __syncthreads();
    }
    Soft sm; soft_init(sm); f32x16 o[2]; zero16(o[0]); zero16(o[1]);
    {
        bf16x8 qr[4];
#pragma unroll
        for (int d0 = 0; d0 < 4; ++d0) qr[d0] = *(const bf16x8*)(Qp + d0 * 16 + c.hi * 8);
        const bf16_t* kp = Kg + (size_t)(qb * 4) * 4096 + (c.hi * 64 + c.r32p) * 8;
        const bf16_t* vp = Vg + (size_t)(qb * 4) * 4096 + (c.hi * 64 + c.r32) * 8;
        const int ntl = ((32 * c.wid + 31) >> 6) + 1;
        bf16x8 kc[8];
#pragma unroll
        for (int i = 0; i < 4; ++i) { kc[2 * i] = *(const bf16x8*)(kp + i * 1024); kc[2 * i + 1] = *(const bf16x8*)(kp + i * 1024 + 256); }
#pragma unroll 1
        for (int kt = 0; kt < ntl; ++kt) {
            bf16x8 vc[8];
            { const bf16_t* vq = vp + (size_t)kt * 4096;
#pragma unroll
              for (int i = 0; i < 4; ++i) { vc[2 * i] = *(const bf16x8*)(vq + i * 1024); vc[2 * i + 1] = *(const bf16x8*)(vq + i * 1024 + 256); } }
            f32x16 p0, p1; zero16(p0); zero16(p1);
#pragma unroll
            for (int d0 = 0; d0 < 4; ++d0) { p0 = MFMA32(kc[2 * d0], qr[d0], p0); p1 = MFMA32(kc[2 * d0 + 1], qr[d0], p1); }
            if (kt + 1 < ntl) {
                const bf16_t* kq = kp + (size_t)(kt + 1) * 4096;
#pragma unroll
                for (int i = 0; i < 4; ++i) { kc[2 * i] = *(const bf16x8*)(kq + i * 1024); kc[2 * i + 1] = *(const bf16x8*)(kq + i * 1024 + 256); }
            }
            if (64 * kt + 63 > 32 * c.wid) mask_causal<false>(p0, p1, 64 * kt, qrel, c.hi);
            soft_step<2>(sm, p0, p1, o, kt == 0);
            bf16x8 pf[4]; const bf16x8 one = ones8(); f32x16 la; zero16(la);
            pf[0] = pack8(p0[0], p0[1], p0[2], p0[3], p0[4], p0[5], p0[6], p0[7]); pf[1] = pack8(p0[8], p0[9], p0[10], p0[11], p0[12], p0[13], p0[14], p0[15]);
            pf[2] = pack8(p1[0], p1[1], p1[2], p1[3], p1[4], p1[5], p1[6], p1[7]); pf[3] = pack8(p1[8], p1[9], p1[10], p1[11], p1[12], p1[13], p1[14], p1[15]);
#pragma unroll
            for (int s = 0; s < 4; ++s) { la = MFMA32(one, pf[s], la); o[0] = MFMA32(vc[2 * s], pf[s], o[0]); o[1] = MFMA32(vc[2 * s + 1], pf[s], o[1]); }
            sm.l += la[0];
        }
    }
    float l = sm.l;
    if (qb > 0) {
        const float m = sm.m;
        const int nsel = __popc(sel);
        const LAS unsigned char* rec0 = c.lds + MOBA_PART + (qrel * 3) * MOBA_REC;
        float ms0 = NEGF, ms1 = NEGF, ms2 = NEGF;
        if (nsel > 0) ms0 = *(const LAS float*)(rec0 + 128);
        if (nsel > 1) ms1 = *(const LAS float*)(rec0 + MOBA_REC + 128);
        if (nsel > 2) ms2 = *(const LAS float*)(rec0 + 2 * MOBA_REC + 128);
        const float M = fmaxf(fmaxf(m, ms0), fmaxf(ms1, ms2));
        const float w0 = ex2(m - M); l *= w0; scale_o(o[0], w0); scale_o(o[1], w0);
#pragma unroll
        for (int s = 0; s < 3; ++s) {
            if (s < nsel) {
                const LAS unsigned char* rec = rec0 + s * MOBA_REC;
                const float ws = ex2((s == 0 ? ms0 : (s == 1 ? ms1 : ms2)) - M);
                l += ws * *(const LAS float*)(rec + 132);
#pragma unroll
                for (int d0 = 0; d0 < 2; ++d0)
#pragma unroll
                    for (int r4 = 0; r4 < 4; ++r4) { const u32x2 v = *(const LAS u32x2*)(rec + (32 * d0 + 8 * r4 + 4 * c.hi) * 2);
                        o[d0][4 * r4] += ws * bflo(v.x); o[d0][4 * r4 + 1] += ws * bfhi(v.x); o[d0][4 * r4 + 2] += ws * bflo(v.y); o[d0][4 * r4 + 3] += ws * bfhi(v.y); }
            }
        }
    }
    const float inv = 1.f / l;
    scale_o(o[0], inv); scale_o(o[1], inv);
    { const size_t qt0 = tok0 + qb * 256 + c.wid * 32;
      store_gated_rows(c, c.lds + c.wid * 4096, o, P + qt0 * PW + 768 + h * 64, merged + qt0 * DM + h * 64, PW); }
    __syncthreads();
}

__device__ __forceinline__ void diff_sub(const bool MASK, const ACtx& c, const LAS unsigned char* Ks, const LAS unsigned char* Vs, const bf16x8 (&qr)[2][2], int kbase, int qabs,
                                                             Soft& s0, Soft& s1, f32x16* oa, f32x16* ob, bool first) {
    f32x16 p0, p1, r0, r1;
    qk_tile<2, 1024>(p0, p1, Ks, 0, qr[0], c);
    qk_tile<2, 1024>(r0, r1, Ks, 4, qr[1], c);
    if (MASK) { mask_causal<false>(p0, p1, kbase, qabs, c.hi); mask_causal<false>(r0, r1, kbase, qabs, c.hi); }
    soft_step<2>(s0, p0, p1, oa, first);
    { float sa = 0.f;
#pragma unroll
      for (int r = 0; r < 16; ++r) sa += p0[r] + p1[r];
      s0.l += sa; }
    pv_tile<2, 1024>(oa, Vs, p0, p1, c);
    soft_step<2>(s1, r0, r1, ob, first);
    { float sb = 0.f;
#pragma unroll
      for (int r = 0; r < 16; ++r) sb += r0[r] + r1[r];
      s1.l += sb; }
    pv_tile<2, 1024>(ob, Vs, r0, r1, c);
}
__device__ __forceinline__ void diff_pair(const ACtx& c, const LAS unsigned char* Kb, const LAS unsigned char* Vb, const bf16x8 (&qr)[2][2], int kbase0, int qabs, int q0w,
                                          Soft& s0, Soft& s1, f32x16* oa, f32x16* ob, bool first) {
    const bool do0 = kbase0 <= q0w + 31, do1 = kbase0 + 64 <= q0w + 31, mk0 = kbase0 + 63 > q0w, mk1 = kbase0 + 127 > q0w;
    f32x16 p0, p1, r0, r1, p2, p3, r2, r3;
    if (do0) {
        qk_tile<2, 1024>(p0, p1, Kb, 0, qr[0], c);
        qk_tile<2, 1024>(r0, r1, Kb, 4, qr[1], c);
        if (mk0) { mask_causal<false>(p0, p1, kbase0, qabs, c.hi); mask_causal<false>(r0, r1, kbase0, qabs, c.hi); }
        soft_step<2>(s0, p0, p1, oa, first);
        { float sa = 0.f;
#pragma unroll
          for (int r = 0; r < 16; ++r) sa += p0[r] + p1[r];
          s0.l += sa; }
        pv_tile<2, 1024>(oa, Vb, p0, p1, c);
    }
    if (do1) {
        qk_tile<2, 1024>(p2, p3, Kb + 8192, 0, qr[0], c);
        qk_tile<2, 1024>(r2, r3, Kb + 8192, 4, qr[1], c);
        if (mk1) { mask_causal<false>(p2, p3, kbase0 + 64, qabs, c.hi); mask_causal<false>(r2, r3, kbase0 + 64, qabs, c.hi); }
    }
    if (do0) {
        soft_step<2>(s1, r0, r1, ob, first);
        { float sb = 0.f;
#pragma unroll
          for (int r = 0; r < 16; ++r) sb += r0[r] + r1[r];
          s1.l += sb; }
        pv_tile<2, 1024>(ob, Vb, r0, r1, c);
    }
    if (do1) {
        soft_step<2>(s0, p2, p3, oa, false);
        { float sa = 0.f;
#pragma unroll
          for (int r = 0; r < 16; ++r) sa += p2[r] + p3[r];
          s0.l += sa; }
        pv_tile<2, 1024>(oa, Vb + 8192, p2, p3, c);
        soft_step<2>(s1, r2, r3, ob, false);
        { float sb = 0.f;
#pragma unroll
          for (int r = 0; r < 16; ++r) sb += r2[r] + r3[r];
          s1.l += sb; }
        pv_tile<2, 1024>(ob, Vb + 8192, r2, r3, c);
    }
}
__device__ __forceinline__ void diff_unit(const ACtx& c, int b, int h, int qb, const bf16_t* P, const bf16_t* Kdf, const bf16_t* Vdf, bf16_t* merged, float lam, float one_m_li, const float* hng) {
    const size_t tok0 = (size_t)b * SEQ;
    const int q0w = qb * 256 + c.wid * 32, qabs = q0w + c.r32;
    const size_t qtok = tok0 + qabs;
    const bf16_t* Qp = P + qtok * PW + 1152 + h * 64;
    bf16x8 qr[2][2];
#pragma unroll
    for (int sh = 0; sh < 2; ++sh)
#pragma unroll
        for (int d0 = 0; d0 < 2; ++d0) qr[sh][d0] = *(const bf16x8*)(Qp + sh * 32 + d0 * 16 + c.hi * 8);
    const int NT = 2 * qb + 2;
    const bf16_t* Kg = Kdf + (size_t)(b * 4 + h) * 128 * 4096;
    const bf16_t* Vg = Vdf + (size_t)(b * 4 + h) * 128 * 4096;
    stage_linear<2>(Kg, c.lds, c); stage_linear<2>(Vg, c.lds + 32768, c);
    __syncthreads();
    Soft s0, s1; soft_init(s0); soft_init(s1); f32x16 oa[2], ob[2]; zero16(oa[0]); zero16(oa[1]); zero16(ob[0]); zero16(ob[1]);
#pragma unroll 1
    for (int t = 0; t < NT; ++t) {
        const int cur = t & 1;
        if (t + 1 < NT) { stage_linear<2>(Kg + (size_t)(2 * t + 2) * 4096, c.lds + (cur ^ 1) * 16384, c); stage_linear<2>(Vg + (size_t)(2 * t + 2) * 4096, c.lds + 32768 + (cur ^ 1) * 16384, c); }
        diff_pair(c, c.lds + cur * 16384, c.lds + 32768 + cur * 16384, qr, 128 * t, qabs, q0w, s0, s1, oa, ob, t == 0);
        __syncthreads();
    }
    { float lo_, hi_; xhalf(s0.l, lo_, hi_); s0.l = lo_ + hi_; xhalf(s1.l, lo_, hi_); s1.l = lo_ + hi_; }
    const float a0 = 1.f / s0.l, a1 = lam / s1.l;
    float ss = 0.f;
#pragma unroll
    for (int d0 = 0; d0 < 2; ++d0)
#pragma unroll
        for (int r = 0; r < 16; ++r) { const float f = oa[d0][r] * a0 - ob[d0][r] * a1; oa[d0][r] = f; ss += f * f; }
    { float lo_, hi_; xhalf(ss, lo_, hi_); ss = lo_ + hi_; }
    const float rn = __builtin_amdgcn_rsqf(ss * (1.f / 64.f) + RMS_EPS) * one_m_li;
#pragma unroll
    for (int d0 = 0; d0 < 2; ++d0)
#pragma unroll
        for (int r4 = 0; r4 < 4; ++r4) {
            const int d = 32 * d0 + 8 * r4 + 4 * c.hi; const f32x4 hg = *(const f32x4*)(hng + d);
            oa[d0][4 * r4] *= rn * hg.x; oa[d0][4 * r4 + 1] *= rn * hg.y; oa[d0][4 * r4 + 2] *= rn * hg.z; oa[d0][4 * r4 + 3] *= rn * hg.w;
        }
    { const size_t qt0 = tok0 + q0w;
      store_gated_rows(c, c.lds + c.wid * 4096, oa, P + qt0 * PW + 1664 + h * 64, merged + qt0 * DM + 384 + h * 64, PW); }
    __syncthreads();
}

__device__ __forceinline__ void sb_elem(float z, bool valid, float& a, float& lb) {
    const float e = ex2(-fabsf(z)); const float sp = fmaxf(z, 0.f) + lg2(1.f + e);
    a = valid ? -sp : 0.f; lb = valid ? (z - sp) : NEGF;
}
__device__ __forceinline__ void sb_unit(const ACtx& c, int b, int h, int qb, const bf16_t* P, const bf16_t* Ksb, const bf16_t* Vsb, bf16_t* merged) {
    const size_t tok0 = (size_t)b * SEQ;
    const int q0w = qb * 256 + c.wid * 32, qabs = q0w + c.r32;
    const size_t qtok = tok0 + qabs;
    const bf16_t* Qp = P + qtok * PW + 1920 + h * 64;
    bf16x8 qr[4];
#pragma unroll
    for (int d0 = 0; d0 < 4; ++d0) qr[d0] = *(const bf16x8*)(Qp + d0 * 16 + c.hi * 8);
    const bf16_t* kp = Ksb + (size_t)(b * 6 + h) * 128 * 4096 + (c.hi * 64 + c.r32p) * 8;
    const bf16_t* vp = Vsb + (size_t)(b * 6 + h) * 128 * 4096 + (c.hi * 64 + c.r32) * 8;
    float R = 0.f; f32x16 o[2]; zero16(o[0]); zero16(o[1]);
    int t = (q0w + 30) >> 6;
    {
        bf16x8 kc[8];
#pragma unroll
        for (int i = 0; i < 4; ++i) { kc[2 * i] = *(const bf16x8*)(kp + (size_t)t * 4096 + i * 1024); kc[2 * i + 1] = *(const bf16x8*)(kp + (size_t)t * 4096 + i * 1024 + 256); }
#pragma unroll 1
        for (;;) {
            bf16x8 vc[8];
#pragma unroll
            for (int i = 0; i < 4; ++i) { vc[2 * i] = *(const bf16x8*)(vp + (size_t)t * 4096 + i * 1024); vc[2 * i + 1] = *(const bf16x8*)(vp + (size_t)t * 4096 + i * 1024 + 256); }
            f32x16 p0, p1; zero16(p0); zero16(p1);
#pragma unroll
            for (int d0 = 0; d0 < 4; ++d0) { p0 = MFMA32(kc[2 * d0], qr[d0], p0); p1 = MFMA32(kc[2 * d0 + 1], qr[d0], p1); }
            if (t > 0) {
#pragma unroll
                for (int i = 0; i < 4; ++i) { kc[2 * i] = *(const bf16x8*)(kp + (size_t)(t - 1) * 4096 + i * 1024); kc[2 * i + 1] = *(const bf16x8*)(kp + (size_t)(t - 1) * 4096 + i * 1024 + 256); }
            }
            const bool needmask = (64 * t + 63 >= q0w);
            f32x16 a0, a1;
#pragma unroll
            for (int r = 0; r < 16; ++r) {
                const int key = 64 * t + 16 * (r >> 3) + 8 * c.hi + (r & 7);
                float a, lb;
                sb_elem(p0[r], !needmask || (key < qabs), a, lb); a0[r] = a; p0[r] = lb;
                sb_elem(p1[r], !needmask || (key + 32 < qabs), a, lb); a1[r] = a; p1[r] = lb;
            }
            float gs0 = 0.f, gs1 = 0.f, gs2 = 0.f, gs3 = 0.f;
#pragma unroll
            for (int i = 0; i < 8; ++i) { gs0 += a0[i]; gs1 += a0[8 + i]; gs2 += a1[i]; gs3 += a1[8 + i]; }
            const float pg0 = xhalf_partner(gs0, c.hi), pg1 = xhalf_partner(gs1, c.hi), pg2 = xhalf_partner(gs2, c.hi), pg3 = xhalf_partner(gs3, c.hi);
            const float so2 = gs3, so1 = so2 + gs2, so0 = so1 + gs1;
            const float pe2 = pg3, pe1 = pe2 + pg2, pe0 = pe1 + pg1;
            const float totO = so0 + gs0, totP = pe0 + pg0;
            float base0 = R + so0 + (c.hi ? pe0 : totP);
            float base1 = R + so1 + (c.hi ? pe1 : pe0);
            float base2 = R + so2 + (c.hi ? pe2 : pe1);
            float base3 = R + (c.hi ? 0.f : pe2);
#pragma unroll
            for (int i = 7; i >= 0; --i) {
                p0[i] = ex2(p0[i] + base0); base0 += a0[i];
                p0[8 + i] = ex2(p0[8 + i] + base1); base1 += a0[8 + i];
                p1[i] = ex2(p1[i] + base2); base2 += a1[i];
                p1[8 + i] = ex2(p1[8 + i] + base3); base3 += a1[8 + i];
            }
            R += c.hi ? (totP + totO) : (totO + totP);
            bf16x8 pf[4];
            pf[0] = pack8(p0[0], p0[1], p0[2], p0[3], p0[4], p0[5], p0[6], p0[7]); pf[1] = pack8(p0[8], p0[9], p0[10], p0[11], p0[12], p0[13], p0[14], p0[15]);
            pf[2] = pack8(p1[0], p1[1], p1[2], p1[3], p1[4], p1[5], p1[6], p1[7]); pf[3] = pack8(p1[8], p1[9], p1[10], p1[11], p1[12], p1[13], p1[14], p1[15]);
#pragma unroll
            for (int s = 0; s < 4; ++s) { o[0] = MFMA32(vc[2 * s], pf[s], o[0]); o[1] = MFMA32(vc[2 * s + 1], pf[s], o[1]); }
            if (t == 0 || __all(R < -150.f)) break;
            --t;
        }
    }
    { const size_t qt0 = tok0 + q0w;
      store_gated_rows(c, c.lds + c.wid * 4096, o, P + qt0 * PW + 2688 + h * 64, merged + qt0 * DM + 640 + h * 64, PW); }
}

__device__ __forceinline__ void xattn_unit(const ACtx& c, int b, int hx, int qb, const bf16_t* QX, const bf16_t* KX, const bf16_t* VXT, bf16_t* OX) {
    const size_t qtok = (size_t)b * SEQ + qb * 256 + c.wid * 32 + c.r32;
    const bf16_t* Qp = QX + qtok * 512 + hx * 128;
    bf16x8 qr[8];
#pragma unroll
    for (int d0 = 0; d0 < 8; ++d0) qr[d0] = *(const bf16x8*)(Qp + d0 * 16 + c.hi * 8);
    const bf16_t* Kg = KX + (size_t)(b * MEML) * 512 + hx * 128;
    const bf16_t* Vg = VXT + (size_t)(hx * 128) * 1024 + b * MEML;
    stage_glds<256, 16>(Kg, 512, c.lds, c); stage_glds<128, 32>(Vg, 1024, c.lds + 65536, c);
    __syncthreads();
    Soft sm; soft_init(sm); f32x16 o[4]; zero16(o[0]); zero16(o[1]); zero16(o[2]); zero16(o[3]);
#pragma unroll 1
    for (int t = 0; t < 4; ++t) {
        f32x16 p0, p1; qk_tile<8, 4096>(p0, p1, c.lds + t * 1024, 0, qr, c);
        soft_step<4>(sm, p0, p1, o, t == 0);
        pv_tile_l<4, 2048>(o, sm.l, c.lds + 65536 + t * 16384, p0, p1, c);
    }
    __syncthreads();
    const float inv = 1.f / sm.l;
    bf16_t* Op = OX + qtok * 512 + hx * 128;
#pragma unroll
    for (int d0 = 0; d0 < 4; ++d0)
#pragma unroll
        for (int r4 = 0; r4 < 4; ++r4) {
            const int d = 32 * d0 + 8 * r4 + 4 * c.hi;
            u32x2 w; w.x = cvtpk(o[d0][4 * r4] * inv, o[d0][4 * r4 + 1] * inv); w.y = cvtpk(o[d0][4 * r4 + 2] * inv, o[d0][4 * r4 + 3] * inv);
            *(u32x2*)(Op + d) = w;
        }
}

__device__ __forceinline__ float wave_sum(float v) {
#pragma unroll
    for (int o = 1; o < 64; o <<= 1) v += __shfl_xor(v, o);
    return v;
}
__device__ __forceinline__ void kmean_item(int item, const bf16_t* Kimg, bf16_t* kmean, int lane) {
    const int blk = item & 31, bh = item >> 5;
    const bf16_t* img = Kimg + ((size_t)bh * 128 + blk * 4) * 4096;
    const int kl = lane >> 3, cc = lane & 7;
    float s0 = 0.f, s1 = 0.f, s2 = 0.f, s3 = 0.f, s4 = 0.f, s5 = 0.f, s6 = 0.f, s7 = 0.f;
#pragma unroll 8
    for (int it = 0; it < 32; ++it) {
        const int key = it * 8 + kl;
        const u32x4 v = *(const u32x4*)(img + ((size_t)((key >> 6) * 8 + cc) * 64 + (key & 63)) * 8);
        s0 += bflo(v.x); s1 += bfhi(v.x); s2 += bflo(v.y); s3 += bfhi(v.y); s4 += bflo(v.z); s5 += bfhi(v.z); s6 += bflo(v.w); s7 += bfhi(v.w);
    }
#pragma unroll
    for (int o = 8; o < 64; o <<= 1) { s0 += __shfl_xor(s0, o); s1 += __shfl_xor(s1, o); s2 += __shfl_xor(s2, o); s3 += __shfl_xor(s3, o); s4 += __shfl_xor(s4, o); s5 += __shfl_xor(s5, o); s6 += __shfl_xor(s6, o); s7 += __shfl_xor(s7, o); }
    if (lane < 8) { const float k = 1.f / 256.f; u32x4 w; w.x = cvtpk(s0 * k, s1 * k); w.y = cvtpk(s2 * k, s3 * k); w.z = cvtpk(s4 * k, s5 * k); w.w = cvtpk(s6 * k, s7 * k); *(u32x4*)(kmean + (size_t)item * 64 + cc * 8) = w; }
}
__device__ __forceinline__ int src_main(int n) {
    int base, j, kind;
    if (n < 384) { base = 0; j = n; kind = 1; } else if (n < 768) { base = 384; j = n - 384; kind = 1; } else if (n < 1152) { base = 1152; j = n - 768; kind = 0; }
    else if (n < 1408) { base = 1536; j = n - 1152; kind = 2; } else if (n < 1664) { base = 1792; j = n - 1408; kind = 2; } else if (n < 1920) { base = 2304; j = n - 1664; kind = 0; }
    else if (n < 2304) { base = 2560; j = n - 1920; kind = 0; } else if (n < 2688) { base = 2944; j = n - 2304; kind = 0; } else { base = 3712; j = n - 2688; kind = 0; }
    if (kind == 1) { const int d = j & 63; if (d < 16) j = (j & ~63) + ((d & 1) ? 8 + (d >> 1) : (d >> 1)); }
    else if (kind == 2) { const int d = j & 31; if (d < 8) j = (j & ~31) + ((d & 1) ? 4 + (d >> 1) : (d >> 1)); }
    return base + j;
}
__device__ __forceinline__ int src_v(int n) { return n < 384 ? 768 + n : (n < 640 ? 2048 + (n - 384) : 3328 + (n - 640)); }
__device__ __forceinline__ void transpose_item(const float* W, int K, int Nsrc, bf16_t* WT, int Ndst, int mode, int coloff, LAS float* scr, int item, int lane, const float* gain) {
    const int nblk = Ndst / 32, kb = item / nblk, nb = item % nblk, k0 = 64 * kb, n0 = 32 * nb;
    const int nn = n0 + (lane & 31); const int sc = (mode == 1) ? src_main(nn) : ((mode == 2) ? src_v(nn) : coloff + nn);
#pragma unroll 16
    for (int i = 0; i < 32; ++i) { const int kk = 2 * i + (lane >> 5); const float gk = gain ? gain[k0 + kk] : 1.f; scr[kk * 33 + (lane & 31)] = W[(size_t)(k0 + kk) * Nsrc + sc] * gk; }
    asm volatile("s_waitcnt lgkmcnt(0)" ::: "memory");
    const int cc = lane & 7;
#pragma unroll
    for (int j = 0; j < 4; ++j) { const int n = (lane >> 3) + 8 * j; const LAS float* s = scr + (8 * cc) * 33 + n;
        u32x4 o; o.x = cvtpk(s[0 * 33], s[1 * 33]); o.y = cvtpk(s[2 * 33], s[3 * 33]); o.z = cvtpk(s[4 * 33], s[5 * 33]); o.w = cvtpk(s[6 * 33], s[7 * 33]);
        *(u32x4*)(WT + (size_t)(n0 + n) * K + k0 + 8 * cc) = o; }
    asm volatile("s_waitcnt lgkmcnt(0)" ::: "memory");
}
__device__ __forceinline__ void rope_cs(float pos, float chi, float clo, float& cs, float& sn) {
    const float h = pos * chi; float lo = fmaf(pos, chi, -h); lo = fmaf(pos, clo, lo);
    const float fr = (h - floorf(h)) + lo;
    cs = __builtin_amdgcn_cosf(fr); sn = __builtin_amdgcn_sinf(fr);
}

struct Args { const float* in[17]; float* out; unsigned char* ws; int ph_lo, ph_hi; };

__device__ __forceinline__ void prologue(const Args& a, LAS unsigned char* lds, int tid, int lane, int wid) {
    unsigned char* ws = a.ws;
    const int G = gridDim.x, gw = blockIdx.x * 8 + wid, NGW = G * 8;
    LAS float* scr = (LAS float*)(lds + wid * 16384);
    bf16_t* Wb = (bf16_t*)(ws + WS_W);
    constexpr int I_MAIN = 16 * 96, I_V = 16 * 32, I_OUT = 16 * 32, I_XQ = 16 * 16, I_XK = 16 * 16, I_XV = 16 * 16, I_XO = 8 * 32, I_L = I_MAIN + I_V + I_OUT + I_XQ + I_XK + I_XV + I_XO;
    for (int it = gw; it < 2 * I_L; it += NGW) {
        const int l = it / I_L; int r = it % I_L; bf16_t* W = Wb + (size_t)l * W_LAYER;
        const float* w_in = a.in[4] + (size_t)l * 1024 * 4096; const float* w_out = a.in[5] + (size_t)l * 1024 * 1024;
        const float* w_xq = a.in[13] + (size_t)l * 1024 * 512; const float* w_xkv = a.in[14] + (size_t)l * 1024 * 1024; const float* w_xo = a.in[15] + (size_t)l * 512 * 1024;
        if (r < I_MAIN) { transpose_item(w_in, 1024, 4096, W + W_MAIN, 3072, 1, 0, scr, r, lane, a.in[3] + l * DM); continue; } r -= I_MAIN;
        if (r < I_V) { transpose_item(w_in, 1024, 4096, W + W_V, 1024, 2, 0, scr, r, lane, a.in[3] + l * DM); continue; } r -= I_V;
        if (r < I_OUT) { transpose_item(w_out, 1024, 1024, W + W_OUT, 1024, 0, 0, scr, r, lane, nullptr); continue; } r -= I_OUT;
        if (r < I_XQ) { transpose_item(w_xq, 1024, 512, W + W_XQ, 512, 0, 0, scr, r, lane, a.in[11] + l * DM); continue; } r -= I_XQ;
        if (r < I_XK) { transpose_item(w_xkv, 1024, 1024, W + W_XK, 512, 0, 0, scr, r, lane, nullptr); continue; } r -= I_XK;
        if (r < I_XV) { transpose_item(w_xkv, 1024, 1024, W + W_XV, 512, 0, 512, scr, r, lane, nullptr); continue; } r -= I_XV;
        transpose_item(w_xo, 512, 1024, W + W_XO, 1024, 0, 0, scr, r, lane, nullptr);
    }
    {
        const float* x = a.in[0]; bf16_t* hb = (bf16_t*)(ws + WS_HB); float* ssq = (float*)(ws + WS_SSQ);
        for (int row = gw; row < TT; row += 2 * NGW) {
            const int row2 = row + NGW;
            const f32x4* xr = (const f32x4*)(x + (size_t)row * DM) + lane; const f32x4* xr2 = (const f32x4*)(x + (size_t)row2 * DM) + lane;
            f32x4 v[4], v2[4];
#pragma unroll
            for (int j = 0; j < 4; ++j) { v[j] = xr[64 * j]; v2[j] = xr2[64 * j]; }
            float s = 0.f, s2 = 0.f; u32x2* o8 = (u32x2*)(hb + (size_t)row * DM) + lane; u32x2* o82 = (u32x2*)(hb + (size_t)row2 * DM) + lane;
#pragma unroll
            for (int j = 0; j < 4; ++j) {
                u32x2 w; w.x = cvtpk(v[j].x, v[j].y); w.y = cvtpk(v[j].z, v[j].w); o8[64 * j] = w;
                { const float r0 = bflo(w.x), r1 = bfhi(w.x), r2 = bflo(w.y), r3 = bfhi(w.y); s += (r0 * r0 + r1 * r1) + (r2 * r2 + r3 * r3); }
                u32x2 w2; w2.x = cvtpk(v2[j].x, v2[j].y); w2.y = cvtpk(v2[j].z, v2[j].w); o82[64 * j] = w2;
                { const float r0 = bflo(w2.x), r1 = bfhi(w2.x), r2 = bflo(w2.y), r3 = bfhi(w2.y); s2 += (r0 * r0 + r1 * r1) + (r2 * r2 + r3 * r3); }
            }
            s = wave_sum(s); s2 = wave_sum(s2);
            if (lane < 4) { ssq[(size_t)row * 4 + lane] = (lane == 0) ? s : 0.f; ssq[(size_t)row2 * 4 + lane] = (lane == 0) ? s2 : 0.f; }
        }
    }
    for (int it = gw; it < 2 * 1024; it += NGW) {
        const int l = it >> 10, row = it & 1023; const float* g = a.in[12] + l * DM; bf16_t* mo = (bf16_t*)(ws + WS_MEMN) + (size_t)l * 1024 * 1024 + (size_t)row * DM;
        const f32x4* xr = (const f32x4*)(a.in[1] + (size_t)row * DM) + lane; f32x4 v[4]; float s = 0.f;
#pragma unroll
        for (int j = 0; j < 4; ++j) { v[j] = xr[64 * j]; s += (v[j].x * v[j].x + v[j].y * v[j].y) + (v[j].z * v[j].z + v[j].w * v[j].w); }
        const float ri = __builtin_amdgcn_rsqf(wave_sum(s) * (1.f / 1024.f) + RMS_EPS);
#pragma unroll
        for (int j = 0; j < 4; ++j) { const f32x4 gg = *((const f32x4*)g + lane + 64 * j); u32x2 w; w.x = cvtpk(v[j].x * ri * gg.x, v[j].y * ri * gg.y); w.y = cvtpk(v[j].z * ri * gg.z, v[j].w * ri * gg.w); *((u32x2*)mo + lane + 64 * j) = w; }
    }
    {
        const int gt = blockIdx.x * 512 + tid;
        constexpr float ROPE64_HI[8] = {1.591549367e-01f, 3.086376376e-02f, 5.985185504e-03f, 1.160663669e-03f, 2.250790858e-04f, 4.364795313e-05f, 8.464330676e-06f, 1.641426252e-06f};
        constexpr float ROPE64_LO[8] = {6.420638327e-09f, -3.597993882e-10f, 2.087540496e-10f, -2.775752479e-11f, -6.755000964e-12f, -3.416928741e-13f, 1.318804142e-13f, 1.098673667e-14f};
        for (int tk = gt; tk < TT; tk += G * 512) {
            const float pos = (float)((const int*)a.in[2])[tk]; float* c64 = (float*)(ws + WS_CS64) + (size_t)tk * 16; float* c32 = (float*)(ws + WS_CS32) + (size_t)tk * 8;
#pragma unroll
            for (int i = 0; i < 8; ++i) { float cs, sn; rope_cs(pos, ROPE64_HI[i], ROPE64_LO[i], cs, sn); c64[2 * i] = cs; c64[2 * i + 1] = sn; }
#pragma unroll
            for (int i = 0; i < 4; ++i) { float cs, sn; rope_cs(pos, ROPE64_HI[2 * i], ROPE64_LO[2 * i], cs, sn); c32[2 * i] = cs; c32[2 * i + 1] = sn; }
        }
    }
    if (blockIdx.x == 0 && wid == 0) {
        int* ctl = (int*)(ws + WS_CTL);
        if (lane < 16) ctl[lane] = 0;
#pragma unroll
        for (int l = 0; l < 2; ++l) {
            float p1 = 0.f, p2 = 0.f;
            if (lane < 32) { p1 = a.in[6][l * 32 + lane] * a.in[7][l * 32 + lane]; p2 = a.in[8][l * 32 + lane] * a.in[9][l * 32 + lane]; }
            p1 = wave_sum(p1); p2 = wave_sum(p2);
            const float li = 0.8f - 0.6f * expf(-0.3f * (float)l);
            if (lane == 0) { ((float*)ctl)[16 + 2 * l] = expf(p1) - expf(p2) + li; ((float*)ctl)[17 + 2 * l] = 1.f - li; }
        }
    }
}

__device__ __forceinline__ void final_norm(const Args& a, int lane, int wid) {
    const int gw = blockIdx.x * 8 + wid, NGW = gridDim.x * 8; const float* ssq = (const float*)(a.ws + WS_SSQ); const float* g = a.in[16]; const bf16_t* hb = (const bf16_t*)(a.ws + WS_HB);
    f32x4 gv[2][2];
#pragma unroll
    for (int j = 0; j < 2; ++j) { gv[j][0] = *(const f32x4*)(g + 512 * j + lane * 8); gv[j][1] = *(const f32x4*)(g + 512 * j + lane * 8 + 4); }
    for (int row0 = gw; row0 < TT; row0 += 2 * NGW) {
        u32x4 v[2][2]; float ri[2];
#pragma unroll
        for (int q = 0; q < 2; ++q) { const int row = row0 + q * NGW; ri[q] = rinv_row(ssq, row);
#pragma unroll
            for (int j = 0; j < 2; ++j) v[q][j] = *(const u32x4*)(hb + (size_t)row * DM + 512 * j + lane * 8); }
#pragma unroll
        for (int q = 0; q < 2; ++q)
#pragma unroll
            for (int j = 0; j < 2; ++j) {
                const u32x4 w = v[q][j];
                f32x4 o0, o1; o0.x = bflo(w.x); o0.y = bfhi(w.x); o0.z = bflo(w.y); o0.w = bfhi(w.y); o1.x = bflo(w.z); o1.y = bfhi(w.z); o1.z = bflo(w.w); o1.w = bfhi(w.w);
                float* op = a.out + (size_t)(row0 + q * NGW) * DM + 512 * j + lane * 8;
                *(f32x4*)op = o0 * ri[q] * gv[j][0]; *(f32x4*)(op + 4) = o1 * ri[q] * gv[j][1];
            }
    }
}

__device__ __forceinline__ int pi32(int r) { return (r & ~12) | ((r & 4) << 1) | ((r & 8) >> 1); }
constexpr int N_PHASES = 12;
#ifndef PROBE_MIX
#define PROBE_MIX 0
#endif
#ifndef PH_MASK
#define PH_MASK 0x1FF
#endif
__device__ __forceinline__ bf16_t* wlayer(const Args& a, int l) { return (bf16_t*)(a.ws + WS_W) + (size_t)l * W_LAYER; }
__device__ __forceinline__ void make_ctx(ACtx& c, LAS unsigned char* lds) {
    const int tid = tid_opaque(), lane = tid & 63;
    c.tid = tid; c.lane = lane; c.wid = __builtin_amdgcn_readfirstlane(tid >> 6); c.r32 = lane & 31; c.hi = lane >> 5; c.r32p = pi32(lane & 31); c.lds = lds;
}
__device__ __forceinline__ void phase_in(const Args& a, LAS unsigned char* lds, int l) {
    const int G = grid_opaque(), bid = bid_opaque(); unsigned char* ws = a.ws;
    { pg8::Gemm g{(const bf16_t*)(ws + WS_HB), wlayer(a, l) + W_MAIN, TT, 3072, 1024}; pg8::StaticOrder S; S.init(TT, 3072, G, bid);
      EpiIn E{(bf16_t*)(ws + WS_P), (const float*)(ws + WS_SSQ), (const float*)(ws + WS_CS64), (const float*)(ws + WS_CS32), (bf16_t*)(ws + WS_KIMG), (float*)(ws + WS_KMEAN), (bf16_t*)a.out, (bf16_t*)a.out + (size_t)16 * 1024 * 1024};
      pg8::gemm_phase<EpiIn, pg8::StaticOrder, true, true>(lds, g, S, E); }
    { pg8::Gemm g{wlayer(a, l) + W_V, (const bf16_t*)(ws + WS_HB), 1024, TT, 1024}; pg8::StaticOrder S; S.init(1024, TT, G, bid);
      EpiVt E{(bf16_t*)(ws + WS_VT), (const float*)(ws + WS_SSQ)};
      pg8::gemm_phase<EpiVt, pg8::StaticOrder, true, true>(lds, g, S, E); }
}
__device__ __forceinline__ void phase_kmean(const Args& a, LAS unsigned char* lds, int l) {
    const int G = grid_opaque(), bid = bid_opaque(), tid_ = tid_opaque(), lane = tid_ & 63, wid = __builtin_amdgcn_readfirstlane(tid_ >> 6); unsigned char* ws = a.ws;
    for (int it = bid * 8 + wid; it < 768; it += G * 8) kmean_item(it, (const bf16_t*)(ws + WS_KIMG), (bf16_t*)(ws + WS_KMEAN), lane);
    bf16_t* memn = (bf16_t*)(ws + WS_MEMN) + (size_t)l * 1024 * 1024; bf16_t* kx = (bf16_t*)(ws + WS_KX) + (size_t)l * 1024 * 512; bf16_t* vxt = (bf16_t*)(ws + WS_VXT) + (size_t)l * 512 * 1024;
#pragma unroll 1
    for (int j = 0; j < 2; ++j) {
        pg8::Gemm g; g.A = j ? (wlayer(a, l) + W_XV) : memn; g.Bt = j ? memn : (wlayer(a, l) + W_XK); g.M = j ? 512 : 1024; g.N = j ? 1024 : 512; g.K = 1024;
        pg8::StaticOrder S; S.init(g.M, g.N, G, (bid + G - 8 - 16 * j) % G); EpiB16 E{j ? vxt : kx, j ? 1024 : 512, nullptr, 1.f};
        pg8::gemm_phase<EpiB16, pg8::StaticOrder, true, true>(lds, g, S, E);
    }
}
struct OneUnit {
    Unit u;
    __device__ __forceinline__ bool next(int i, Unit& o) const { if (i) return false; o = u; return true; }
    __device__ __forceinline__ void a_ready(const Unit&) const {}
    __device__ __forceinline__ void done(const Unit&) const {}
};
#ifndef MIX_TYPES
#define MIX_TYPES 7
#endif
__device__ __forceinline__ void phase_mix(const Args& a, LAS unsigned char* lds, int l, int rep, int types) {
    volatile LAS int* wq = (volatile LAS int*)(lds + LDS_MISC);
    const int x0 = (int)((unsigned)__builtin_amdgcn_s_getreg((3 << 11) | 20) & 7u);
    int nq = 0;
    for (;;) {
        unsigned char* ws = a.ws; asm volatile("" : "+s"(ws));
        int* ctl = (int*)(ws + WS_CTL);
        const bf16_t* P = (const bf16_t*)(ws + WS_P); const bf16_t* Vt = (const bf16_t*)(ws + WS_VT); bf16_t* mrg = (bf16_t*)(ws + WS_MRG);
        ACtx c; make_ctx(c, lds);
        const int q = (x0 + nq) & 7;
        if (c.tid == 0) *wq = __hip_atomic_fetch_add(ctl + 32 + (l * 2 + rep) * 8 + q, 1, __ATOMIC_RELAXED, __HIP_MEMORY_SCOPE_AGENT);
        __syncthreads();
        const int i = __builtin_amdgcn_readfirstlane(*wq);
        __syncthreads();
        if (i >= 258) { if (++nq >= 8) break; continue; }
        if (i >= 256) {
            const int it = (i - 256) + 2 * q, j = it >> 3, uu = it & 7;
            bf16_t* memn = (bf16_t*)(ws + WS_MEMN) + (size_t)l * 1024 * 1024;
            pg8::Gemm g; g.A = j ? (wlayer(a, l) + W_XV) : memn; g.Bt = j ? memn : (wlayer(a, l) + W_XK); g.M = j ? 512 : 1024; g.N = j ? 1024 : 512; g.K = 1024;
            OneUnit S; S.u.pm = j ? (uu & 1) : (uu & 3); S.u.pn = j ? (uu >> 1) : (uu >> 2);
            EpiB16 E{j ? ((bf16_t*)(ws + WS_VXT) + (size_t)l * 512 * 1024) : ((bf16_t*)(ws + WS_KX) + (size_t)l * 1024 * 512), j ? 1024 : 512, nullptr, 1.f};
            pg8::gemm_phase<EpiB16, OneUnit, true, true>(lds, g, S, E);
            __syncthreads();
            continue;
        }
        int type, bh, qb;
        if (i < 56) { type = 0; qb = 31 - (i >> 1); bh = q + 8 * (i & 1); }
        else if (i < 152) { const int j = i - 56; type = 1; qb = 31 - j / 3; bh = q + 8 * (j % 3); }
        else if (i < 160) { const int j = i - 152; type = 0; qb = 3 - (j >> 1); bh = q + 8 * (j & 1); }
        else { const int j = i - 160; type = 2; qb = 31 - j / 3; bh = q + 8 * (j % 3); }
        if (type == 0) { if (types & 1) diff_unit(c, bh >> 2, bh & 3, qb, P, (const bf16_t*)a.out + (size_t)16 * 1024 * 1024, Vt + (size_t)384 * TT, mrg, ((const float*)ctl)[16 + 2 * l], ((const float*)ctl)[17 + 2 * l], a.in[10] + l * 64); }
        else if (type == 1) { if (types & 2) moba_unit(c, bh / 6, bh % 6, qb, P, (const bf16_t*)(ws + WS_KIMG), Vt, (const float*)(ws + WS_KMEAN), mrg); }
        else if (types & 4) sb_unit(c, bh / 6, bh % 6, qb, P, (const bf16_t*)a.out, Vt + (size_t)640 * TT, mrg);
    }
}
__device__ __forceinline__ void phase_res(const Args& a, LAS unsigned char* lds, int l, bool o) {
    unsigned char* ws = a.ws;
    pg8::Gemm g; g.A = (const bf16_t*)(ws + (o ? WS_MRG : WS_OX)); g.Bt = wlayer(a, l) + (o ? W_OUT : W_XO); g.M = TT; g.N = 1024; g.K = o ? 1024 : 512;
    pg8::StaticOrder S; S.init(TT, 1024, grid_opaque(), bid_opaque());
    EpiRes E; E.h = (bf16_t*)(ws + WS_HB); E.ssq = (float*)(ws + WS_SSQ);
    E.red = (LAS float*)(lds + LDS_RED); E.tid = tid_opaque();
    pg8::gemm_phase<EpiRes, pg8::StaticOrder, true, true>(lds, g, S, E);
}
__device__ __forceinline__ void phase_xq(const Args& a, LAS unsigned char* lds, int l) {
    unsigned char* ws = a.ws;
    pg8::Gemm g{(const bf16_t*)(ws + WS_HB), wlayer(a, l) + W_XQ, TT, 512, 1024}; pg8::StaticOrder S; S.init(TT, 512, grid_opaque(), bid_opaque());
    EpiB16 E{(bf16_t*)(ws + WS_QX), 512, (const float*)(ws + WS_SSQ), 0.08838834764831845f * LOG2E};
    pg8::gemm_phase<EpiB16, pg8::StaticOrder, true, true>(lds, g, S, E);
    asm volatile("s_waitcnt vmcnt(0)" ::: "memory");
    __syncthreads();
    Unit u;
    if (S.next(0, u)) {
        ACtx c; make_ctx(c, lds);
        const bf16_t* kx = (const bf16_t*)(ws + WS_KX) + (size_t)l * 1024 * 512; const bf16_t* vxt = (const bf16_t*)(ws + WS_VXT) + (size_t)l * 512 * 1024;
#pragma unroll 1
        for (int hh = 0; hh < 2; ++hh) xattn_unit(c, u.pm >> 5, 2 * u.pn + hh, u.pm & 31, (const bf16_t*)(ws + WS_QX), kx, vxt, (bf16_t*)(ws + WS_OX));
    }
}
__device__ __forceinline__ void phase_xattn(const Args& a, LAS unsigned char* lds, int l) {
    unsigned char* ws = a.ws; ACtx c; make_ctx(c, lds);
    const bf16_t* kx = (const bf16_t*)(ws + WS_KX) + (size_t)l * 1024 * 512; const bf16_t* vxt = (const bf16_t*)(ws + WS_VXT) + (size_t)l * 512 * 1024;
    for (int i = bid_opaque(); i < 512; i += grid_opaque()) { const int qb = i & 31, bh = i >> 5; xattn_unit(c, bh >> 2, bh & 3, qb, (const bf16_t*)(ws + WS_QX), kx, vxt, (bf16_t*)(ws + WS_OX)); }
}
#define XB_TMO      128
#define XB_XCNT(j)  (256  + 64 * (j))
#define XB_XSUB(j)  (1280 + 64 * (j))
#define XB_XGEN(j)  (2304 + 64 * (j))
#define XB_TOP      3328
#define XB_TOPGEN   3392
#define XCD_BAR_WORDS 3456
#define XB_SPIN_CAP (1u << 18)

__device__ __forceinline__ unsigned xb_ld(unsigned* p)              { return __hip_atomic_load(p, __ATOMIC_RELAXED, __HIP_MEMORY_SCOPE_AGENT); }
__device__ __forceinline__ unsigned xb_add(unsigned* p, unsigned v) { return __hip_atomic_fetch_add(p, v, __ATOMIC_RELAXED, __HIP_MEMORY_SCOPE_AGENT); }
__device__ __forceinline__ unsigned xb_xcc_id() { return (unsigned)__builtin_amdgcn_s_getreg((3 << 11) | 20) & 0xFu; }
#define XB_SPIN(cond, bar) do { unsigned _sp = 0; while (cond) { __builtin_amdgcn_s_sleep(1); \
    if ((++_sp & 255u) == 0u) { if (xb_ld(&(bar)[XB_TMO])) break; if (_sp > XB_SPIN_CAP) { atomicAdd(&(bar)[XB_TMO], 1u); break; } } } } while (0)

struct XcdBarrier {
    unsigned* bar; unsigned x;
    volatile LAS unsigned* st;
};

__device__ __forceinline__ XcdBarrier xcd_barrier_post(unsigned* bar, volatile LAS unsigned* st) {
    XcdBarrier b; b.bar = bar; b.x = xb_xcc_id(); b.st = st;
    if (threadIdx.x == 0) (void)xb_add(&bar[XB_XCNT(b.x)], 1u);
    return b;
}
__device__ __forceinline__ void xcd_barrier_complete(unsigned* bar, unsigned x, unsigned& nloc, unsigned& nx) {
    const unsigned G = gridDim.x * gridDim.y * gridDim.z;
    unsigned sum, cnt, mine, sp = 0u;
    for (;;) {
        sum = 0u; cnt = 0u; mine = 0u;
#pragma unroll
        for (unsigned j = 0; j < 16; ++j) { const unsigned c = xb_ld(&bar[XB_XCNT(j)]); sum += c; cnt += (c > 0u) ? 1u : 0u; mine = (j == x) ? c : mine; }
        if (sum == G) break;
        __builtin_amdgcn_s_sleep(1);
        if ((++sp & 255u) == 0u) { if (xb_ld(&bar[XB_TMO])) break; if (sp > XB_SPIN_CAP) { atomicAdd(&bar[XB_TMO], 1u); break; } }
    }
    nloc = mine > 0u ? mine : 1u; nx = cnt > 0u ? cnt : 1u;
}

__device__ __forceinline__ void xcd_barrier(const XcdBarrier& b) {
    asm volatile("s_waitcnt vmcnt(0)" ::: "memory");
    __syncthreads();
    if (threadIdx.x == 0) {
        unsigned* bar = b.bar;
        __builtin_amdgcn_s_waitcnt(0);
        unsigned nloc = b.st[0], nx = b.st[1];
        if (nloc == 0u) { xcd_barrier_complete(bar, b.x, nloc, nx); b.st[0] = nloc; b.st[1] = nx; }
        const unsigned old = xb_add(&bar[XB_XSUB(b.x)], 1u);
        const unsigned gen = old / nloc;
        if (old + 1u == (gen + 1u) * nloc) {
            __builtin_amdgcn_fence(__ATOMIC_RELEASE, "agent");
            asm volatile("s_waitcnt vmcnt(0)" ::: "memory");
            const unsigned og = xb_add(&bar[XB_TOP], 1u);
            const unsigned tg = og / nx;
            if (og + 1u == (tg + 1u) * nx) xb_add(&bar[XB_TOPGEN], 1u);
            else XB_SPIN(xb_ld(&bar[XB_TOPGEN]) == tg, bar);
            __builtin_amdgcn_fence(__ATOMIC_ACQUIRE, "agent");
            xb_add(&bar[XB_XGEN(b.x)], 1u);
            asm volatile("s_waitcnt vmcnt(0)" ::: "memory");
        } else {
            XB_SPIN(xb_ld(&bar[XB_XGEN(b.x)]) == gen, bar);
            __builtin_amdgcn_fence(__ATOMIC_ACQUIRE, "agent");
            asm volatile("s_waitcnt vmcnt(0)" ::: "memory");
        }
    }
    __syncthreads();
}


__device__ __forceinline__ void grid_bar(unsigned* bar, unsigned k) {
    asm volatile("s_waitcnt vmcnt(0)" ::: "memory");
    __syncthreads();
    if (threadIdx.x == 0) {
        __builtin_amdgcn_fence(__ATOMIC_RELEASE, "agent");
        asm volatile("s_waitcnt vmcnt(0)" ::: "memory");
        const unsigned G = gridDim.x, g = blockIdx.x & 7u, ng = (G - g + 7u) >> 3;
        unsigned* sub = bar + 64 * (1 + g); unsigned* gen = bar + 64 * (9 + g); unsigned* top = bar + 64 * 17;
        const unsigned old = __hip_atomic_fetch_add(sub, 1u, __ATOMIC_RELAXED, __HIP_MEMORY_SCOPE_AGENT);
        if (old + 1u == k * ng) {
            const unsigned oldt = __hip_atomic_fetch_add(top, 1u, __ATOMIC_RELAXED, __HIP_MEMORY_SCOPE_AGENT);
            if (oldt + 1u == k * 8u) {
#pragma unroll
                for (int gg = 0; gg < 8; ++gg) __hip_atomic_store(bar + 64 * (9 + gg), k, __ATOMIC_RELAXED, __HIP_MEMORY_SCOPE_AGENT);
            }
        }
        while (__hip_atomic_load(gen, __ATOMIC_RELAXED, __HIP_MEMORY_SCOPE_AGENT) < k) __builtin_amdgcn_s_sleep(2);
        __builtin_amdgcn_fence(__ATOMIC_ACQUIRE, "agent");
        asm volatile("s_waitcnt vmcnt(0)" ::: "memory");
    }
    __syncthreads();
}
__global__ void __launch_bounds__(512, 2) fwd_kernel(Args a) {
    extern __shared__ __attribute__((aligned(16))) unsigned char lds_raw[];
    LAS unsigned char* lds = (LAS unsigned char*)lds_raw;
    volatile LAS unsigned* xst = (volatile LAS unsigned*)(lds + LDS_MISC + 256);
    if (threadIdx.x == 0) { xst[0] = 0u; xst[1] = 0u; }
    __syncthreads();
    XcdBarrier xbar = xcd_barrier_post((unsigned*)(a.ws + WS_CTL) + 1024, xst);
#pragma unroll 1
    for (int ph = a.ph_lo; ph < a.ph_hi; ++ph) {
        if (ph == 0) { const int t_ = tid_opaque(); prologue(a, lds, t_, t_ & 63, __builtin_amdgcn_readfirstlane(t_ >> 6)); }
        else if (ph == N_PHASES - 1) { const int t_ = tid_opaque(); final_norm(a, t_ & 63, __builtin_amdgcn_readfirstlane(t_ >> 6)); }
        else {
            const int l = (ph - 1) / 5, r = (ph - 1) % 5;
            if (r == 0) { if (PH_MASK & 1) phase_in(a, lds, l); }
            else if (r == 1) { phase_mix(a, lds, l, 0, MIX_TYPES);
#if PROBE_MIX
                __syncthreads(); phase_mix(a, lds, l, 1, PROBE_MIX);
#endif
            }
            else if (r == 2 || r == 4) { if (PH_MASK & 8) phase_res(a, lds, l, r == 2); }
            else { if (PH_MASK & 16) phase_xq(a, lds, l); }
        }
        if (ph + 1 < a.ph_hi) {
            if (a.ph_hi > 4096) cg::this_grid().sync();
            xcd_barrier(xbar);
        }
    }
}

#ifndef MK_PER_PHASE
#define MK_PER_PHASE 0
#endif
extern "C" void kernel_launch(void* const* d_in, const int* in_sizes, int n_in, void* d_out, int out_size, void* d_ws, size_t ws_size, hipStream_t stream) {
    static int grid = 0;
    if (grid == 0) {
        if (n_in != 17 || out_size != TT * DM || ws_size < WS_END) { fprintf(stderr, "kernel_launch: unexpected shapes (n_in %d out %d ws %zu)\n", n_in, out_size, ws_size); grid = -1; return; }
        int dev = 0, cus = 0, per_cu = 0;
        if (hipGetDevice(&dev) != hipSuccess || hipDeviceGetAttribute(&cus, hipDeviceAttributeMultiprocessorCount, dev) != hipSuccess) { grid = -1; return; }
        if (hipFuncSetAttribute((const void*)fwd_kernel, hipFuncAttributeMaxDynamicSharedMemorySize, LDS_BYTES) != hipSuccess) { fprintf(stderr, "kernel_launch: hipFuncSetAttribute failed\n"); grid = -1; return; }
        if (hipOccupancyMaxActiveBlocksPerMultiprocessor(&per_cu, (const void*)fwd_kernel, 512, LDS_BYTES) != hipSuccess || per_cu < 1) { fprintf(stderr, "kernel_launch: occupancy query says %d\n", per_cu); (void)hipGetLastError(); }
        grid = cus;
    }
    if (grid < 0) return;
    Args a{};
    for (int i = 0; i < 17; ++i) a.in[i] = (const float*)d_in[i];
    a.out = (float*)d_out; a.ws = (unsigned char*)d_ws;
#if MK_PER_PHASE
    for (int ph = 0; ph < N_PHASES; ++ph) { a.ph_lo = ph; a.ph_hi = ph + 1; hipLaunchKernelGGL(fwd_kernel, dim3(grid), dim3(512), LDS_BYTES, stream, a); }
#else
    a.ph_lo = 0; a.ph_hi = N_PHASES;
    (void)hipMemsetAsync(d_ws, 0, 32768, stream);
    void* args[] = {&a};
    hipError_t e = hipLaunchCooperativeKernel((const void*)fwd_kernel, dim3(grid), dim3(512), args, LDS_BYTES, stream);
    if (e != hipSuccess) fprintf(stderr, "kernel_launch: cooperative launch failed: %s (grid %d)\n", hipGetErrorString(e), grid);
#endif
}
```

```cpp
#include <hip/hip_runtime.h>
#include <hip/hip_cooperative_groups.h>
#include <cstdio>
#include <cstdint>
namespace cg = cooperative_groups;
__device__ __forceinline__ int tid_opaque() { int t = threadIdx.x; asm volatile("" : "+v"(t)); return t; }
__device__ __forceinline__ int bid_opaque() { int b = blockIdx.x; asm volatile("" : "+s"(b)); return b; }
__device__ __forceinline__ int grid_opaque() { int b = gridDim.x; asm volatile("" : "+s"(b)); return b; }
namespace pg8 {
#define PG8_LAS __attribute__((address_space(3)))
typedef unsigned short bf16_t;
typedef short bf16x8 __attribute__((ext_vector_type(8)));
typedef float f32x4 __attribute__((ext_vector_type(4)));
typedef unsigned u32x4 __attribute__((ext_vector_type(4)));
constexpr int BM = 256, BK = 64, HALF = 128, HTB = HALF * BK * 2  , STAGE_BYTES = 8 * HTB, NXCD = 8, WGM = 8;

__host__ __device__ __forceinline__ int lds_byte(int r, int c) { const int st = (r >> 4) * 2 + (c >> 5), rr = r & 15, cc = c & 31, ob = rr * 64 + cc * 2; return st * 1024 + (ob ^ (((ob >> 9) & 1) << 5)); }
__host__ __device__ __forceinline__ void stage_rc(int b, int& R, int& C) { const int st = b / 1024, sb = b % 1024, swz = sb ^ (((sb >> 9) & 1) << 5); R = (st >> 1) * 16 + swz / 64; C = (st & 1) * 32 + (swz % 64) / 2; }
__host__ __device__ __forceinline__ int perm32(int rho) { const int n = rho >> 4, i = rho & 15; return 8 * (i >> 2) + 4 * n + (i & 3); }

struct Unit { int pm, pn; };
struct Gemm { const bf16_t* A; const bf16_t* Bt; int M, N, K; };

struct StaticOrder {
    int nM, nN, nwg, G, c;
    __host__ __device__ void init(int M, int N, int G_, int c_) { nM = M / BM; nN = N / BM; nwg = nM * nN; G = G_; c = c_; }
    __host__ __device__ bool next(int i, Unit& u) const {
        const long L = (long)i * G + c; if (L >= nwg) return false;
        int wgid = (int)L; { const int q = nwg / NXCD, r = nwg % NXCD, xcd = wgid % NXCD, off = wgid / NXCD; wgid = (xcd < r ? xcd * (q + 1) : r * (q + 1) + (xcd - r) * q) + off; }
        const int nig = WGM * nN, gid = wgid / nig, fm = gid * WGM, gsz = (nM - fm) < WGM ? (nM - fm) : WGM;
        u.pm = fm + ((wgid % nig) % gsz); u.pn = (wgid % nig) / gsz; return true;
    }
    __device__ __forceinline__ void a_ready(const Unit&) const {}
    __device__ __forceinline__ void done(const Unit&) const {}
};

__device__ __forceinline__ unsigned cvt_pk_bf16(float lo, float hi) { unsigned r; asm volatile("v_cvt_pk_bf16_f32 %0, %1, %2" : "=v"(r) : "v"(lo), "v"(hi)); return r; }
typedef float f32x2 __attribute__((ext_vector_type(2)));
template <class Epi, class Sched, bool ALIGN_EPI = false, bool SP2 = false>
__device__ __forceinline__ void gemm_phase(PG8_LAS unsigned char* lds, const Gemm g, const Sched& S, const Epi& E) {
    const int tid = tid_opaque(), wid = __builtin_amdgcn_readfirstlane(tid >> 6), lane = tid & 63, wr = wid >> 2, wc = wid & 3, fr = lane & 15, fq = lane >> 4;
    const int K = g.K, nt = K / BK;
    unsigned voffA[2], voffB[2];
#pragma unroll
    for (int i = 0; i < 2; ++i) { int R, C; stage_rc(tid * 16 + i * 8192, R, C); const int Rb = Epi::PERM ? ((R & ~31) + perm32(R & 31)) : R;
        voffA[i] = (unsigned)(R * K + C) * 2u; voffB[i] = (unsigned)(Rb * K + C) * 2u; }
    const size_t kstep = (size_t)(BK * 2);
    const size_t hstep = (size_t)HALF * K * 2;
    const size_t tstep = 2 * hstep;
    const unsigned ldsw = (unsigned)wid * 1024u;
    const int aoff = lds_byte(wr * 64 + fr, fq * 8), boff = lds_byte(wc * 32 + fr, fq * 8);
#define PG8_SA(b, h) (((b) * 2 + (h)) * HTB)
#define PG8_SB(b, h) ((4 + (b) * 2 + (h)) * HTB)
#define PG8_STAGE(bufoff, gbase, voff) do { _Pragma("unroll") for (int _i = 0; _i < 2; ++_i) \
        __builtin_amdgcn_global_load_lds((const unsigned*)((const char*)(gbase) + (voff)[_i]), (PG8_LAS unsigned*)(lds + (bufoff) + ldsw + _i * 8192), 16, 0, 0); } while (0)
#define PG8_LDA(dst, b, h) do { _Pragma("unroll") for (int m = 0; m < 4; ++m) _Pragma("unroll") for (int k = 0; k < 2; ++k) dst[m][k] = *(const PG8_LAS bf16x8*)(lds + PG8_SA(b, h) + aoff + m * 2048 + k * 1024); } while (0)
#define PG8_LDB(dst, b, h) do { _Pragma("unroll") for (int n = 0; n < 2; ++n) _Pragma("unroll") for (int k = 0; k < 2; ++k) dst[n][k] = *(const PG8_LAS bf16x8*)(lds + PG8_SB(b, h) + boff + n * 2048 + k * 1024); } while (0)
#define PG8_MMA(ai, bj, At, Bt) do { __builtin_amdgcn_s_setprio(1); _Pragma("unroll") for (int m = 0; m < 4; ++m) _Pragma("unroll") for (int n = 0; n < 2; ++n) _Pragma("unroll") for (int k = 0; k < 2; ++k) \
        acc[ai][bj][m][n] = __builtin_amdgcn_mfma_f32_16x16x32_bf16(Bt[n][k], At[m][k], acc[ai][bj][m][n], 0, 0, 0); __builtin_amdgcn_s_setprio(0); } while (0)
#define PG8_WAIT_V(n) asm volatile("s_waitcnt vmcnt(" #n ")" ::: "memory")
#define PG8_WAIT_L(n) asm volatile("s_waitcnt lgkmcnt(" #n ")" ::: "memory")
#define PG8_BAR __builtin_amdgcn_s_barrier()
#define PG8_SCHED __builtin_amdgcn_sched_barrier(0)
    Unit cur, nxt; int ui = 0;
    if (!S.next(0, cur)) return;
    f32x4 acc[2][2][4][2];
#pragma unroll
    for (int a = 0; a < 2; ++a)
#pragma unroll
        for (int b = 0; b < 2; ++b)
#pragma unroll
            for (int m = 0; m < 4; ++m)
#pragma unroll
                for (int n = 0; n < 2; ++n) acc[a][b][m][n] = (f32x4){0.f, 0.f, 0.f, 0.f};
    bf16x8 At[4][2], B0[2][2], B1[2][2];
    const char* cA = (const char*)g.A + (size_t)cur.pm * tstep; const char* cB = (const char*)g.Bt + (size_t)cur.pn * tstep;
    S.a_ready(cur);
    if constexpr (SP2) {
        PG8_STAGE(PG8_SB(0, 0), cB, voffB); PG8_STAGE(PG8_SB(0, 1), cB + hstep, voffB); PG8_STAGE(PG8_SA(0, 0), cA, voffA); PG8_STAGE(PG8_SA(0, 1), cA + hstep, voffA);
        if (wr == 1) PG8_BAR;
        PG8_WAIT_V(2); PG8_BAR;
        PG8_STAGE(PG8_SB(1, 0), cB + kstep, voffB); PG8_STAGE(PG8_SA(1, 0), cA + kstep, voffA); PG8_STAGE(PG8_SB(1, 1), cB + hstep + kstep, voffB);
        PG8_WAIT_V(6); PG8_BAR;
    } else {
        PG8_STAGE(PG8_SB(0, 0), cB, voffB); PG8_STAGE(PG8_SA(0, 0), cA, voffA); PG8_STAGE(PG8_SB(0, 1), cB + hstep, voffB); PG8_STAGE(PG8_SA(0, 1), cA + hstep, voffA);
        if (wr == 1) PG8_BAR;
        PG8_WAIT_V(4); PG8_BAR;
        PG8_STAGE(PG8_SB(1, 0), cB + kstep, voffB); PG8_STAGE(PG8_SA(1, 0), cA + kstep, voffA); PG8_STAGE(PG8_SB(1, 1), cB + hstep + kstep, voffB);
        PG8_WAIT_V(6); PG8_BAR;
    }
    for (;;) {
        const bool has_next = S.next(ui + 1, nxt);
        const char* nA = has_next ? (const char*)g.A + (size_t)nxt.pm * tstep : cA; const char* nB = has_next ? (const char*)g.Bt + (size_t)nxt.pn * tstep : cB;
        for (int t = 0; t < nt; t += 2) {
            const bool last = (t == nt - 2);
            const char* a1 = cA + (size_t)(t + 1) * kstep;
            const char* a2 = last ? nA : cA + (size_t)(t + 2) * kstep; const char* b2 = last ? nB : cB + (size_t)(t + 2) * kstep;
            const char* a3 = a2 + kstep; const char* b3 = b2 + kstep;
            if (last && has_next) S.a_ready(nxt);
            if constexpr (SP2) {
            PG8_LDB(B0, 0, 0); PG8_LDB(B1, 0, 1); PG8_SCHED; PG8_LDA(At, 0, 0); PG8_STAGE(PG8_SA(1, 1), a1 + hstep, voffA);
            PG8_WAIT_V(8); PG8_WAIT_L(0); PG8_BAR; PG8_MMA(0, 0, At, B0); PG8_MMA(0, 1, At, B1); PG8_BAR; PG8_SCHED;
            PG8_LDA(At, 0, 1); PG8_STAGE(PG8_SB(0, 0), b2, voffB); PG8_STAGE(PG8_SB(0, 1), b2 + hstep, voffB); PG8_STAGE(PG8_SA(0, 0), a2, voffA);
            PG8_WAIT_V(8); PG8_WAIT_L(0); PG8_BAR; PG8_MMA(1, 0, At, B0); PG8_MMA(1, 1, At, B1); PG8_BAR; PG8_SCHED;
            PG8_LDB(B0, 1, 0); PG8_LDB(B1, 1, 1); PG8_SCHED; PG8_LDA(At, 1, 0); PG8_STAGE(PG8_SA(0, 1), a2 + hstep, voffA);
            PG8_WAIT_V(8); PG8_WAIT_L(0); PG8_BAR; PG8_MMA(0, 0, At, B0); PG8_MMA(0, 1, At, B1); PG8_BAR; PG8_SCHED;
            PG8_LDA(At, 1, 1); PG8_STAGE(PG8_SB(1, 0), b3, voffB); PG8_STAGE(PG8_SB(1, 1), b3 + hstep, voffB); PG8_STAGE(PG8_SA(1, 0), a3, voffA);
            PG8_WAIT_V(8); PG8_WAIT_L(0); PG8_BAR; PG8_MMA(1, 0, At, B0); PG8_MMA(1, 1, At, B1); PG8_BAR; PG8_SCHED;
            } else {
            PG8_LDB(B0, 0, 0); PG8_SCHED; PG8_LDA(At, 0, 0); PG8_STAGE(PG8_SA(1, 1), a1 + hstep, voffA);
            PG8_WAIT_L(8); PG8_BAR; PG8_WAIT_L(0); PG8_MMA(0, 0, At, B0); PG8_BAR; PG8_SCHED;
            PG8_LDB(B1, 0, 1); PG8_STAGE(PG8_SB(0, 0), b2, voffB);
            PG8_BAR; PG8_WAIT_L(0); PG8_MMA(0, 1, At, B1); PG8_BAR;
            PG8_LDA(At, 0, 1); PG8_STAGE(PG8_SA(0, 0), a2, voffA);
            PG8_BAR; PG8_WAIT_L(0); PG8_MMA(1, 0, At, B0); PG8_BAR; PG8_SCHED;
            PG8_STAGE(PG8_SB(0, 1), b2 + hstep, voffB);
            PG8_WAIT_V(6); PG8_BAR; PG8_MMA(1, 1, At, B1); PG8_BAR;
            PG8_LDB(B0, 1, 0); PG8_SCHED; PG8_LDA(At, 1, 0); PG8_STAGE(PG8_SA(0, 1), a2 + hstep, voffA);
            PG8_WAIT_L(8); PG8_BAR; PG8_WAIT_L(0); PG8_MMA(0, 0, At, B0); PG8_BAR; PG8_SCHED;
            PG8_LDB(B1, 1, 1); PG8_STAGE(PG8_SB(1, 0), b3, voffB);
            PG8_BAR; PG8_WAIT_L(0); PG8_MMA(0, 1, At, B1); PG8_BAR;
            PG8_LDA(At, 1, 1); PG8_STAGE(PG8_SA(1, 0), a3, voffA);
            PG8_BAR; PG8_WAIT_L(0); PG8_MMA(1, 0, At, B0); PG8_BAR; PG8_SCHED;
            PG8_STAGE(PG8_SB(1, 1), b3 + hstep, voffB);
            PG8_WAIT_V(6); PG8_BAR; PG8_MMA(1, 1, At, B1); PG8_BAR;
            }
        }
        if constexpr (ALIGN_EPI) { if (wr == 0) PG8_BAR; }
        if constexpr (!Epi::AFTER_DRAIN) { E(acc, cur, wr, wc, fr, fq); S.done(cur); }
        if (!has_next) break;
#pragma unroll
        for (int a = 0; a < 2; ++a)
#pragma unroll
            for (int b = 0; b < 2; ++b)
#pragma unroll
                for (int m = 0; m < 4; ++m)
#pragma unroll
                    for (int n = 0; n < 2; ++n) acc[a][b][m][n] = (f32x4){0.f, 0.f, 0.f, 0.f};
        cur = nxt; cA = nA; cB = nB; ++ui;
        if constexpr (ALIGN_EPI) { if (wr == 1) PG8_BAR; }
    }
    PG8_WAIT_V(0);
    if constexpr (!ALIGN_EPI) { if (wr == 0) PG8_BAR; }
    PG8_BAR;
    if constexpr (Epi::AFTER_DRAIN) { E.fused(acc, cur, wr, wc, fr, fq, lds, wid, lane); S.done(cur); }
#undef PG8_SA
#undef PG8_SB
#undef PG8_STAGE
#undef PG8_LDA
#undef PG8_LDB
#undef PG8_MMA
#undef PG8_WAIT_V
#undef PG8_WAIT_L
#undef PG8_BAR
#undef PG8_SCHED
}
}

using pg8::bf16_t; using pg8::bf16x8; using pg8::f32x4; using pg8::u32x4; using pg8::Unit;
typedef float f32x16 __attribute__((ext_vector_type(16)));
typedef unsigned u32x2 __attribute__((ext_vector_type(2)));
typedef float f32x2_t __attribute__((ext_vector_type(2)));
typedef __bf16 bf16x2_t __attribute__((ext_vector_type(2)));
#define LAS __attribute__((address_space(3)))
constexpr int TT = 32768, DM = 1024, SEQ = 8192, NBATCH = 4, MEML = 256;
constexpr int PW = 3072;
constexpr float RMS_EPS = 1e-6f;
constexpr float LOG2E = 1.4426950408889634f;
constexpr float NEGF = -1.0e30f;
constexpr size_t MiB = (size_t)1 << 20;
constexpr size_t WS_CTL = 0, WS_SSQ = 1 * MiB, WS_CS64 = 3 * MiB, WS_CS32 = 5 * MiB, WS_KMEAN = 6 * MiB, WS_MEMN = 8 * MiB, WS_KX = 12 * MiB, WS_VXT = 14 * MiB,
                 WS_W = 16 * MiB, WS_HB = 48 * MiB, WS_P = 112 * MiB, WS_VT = 304 * MiB, WS_MRG = 368 * MiB, WS_QX = 432 * MiB, WS_OX = 432 * MiB  , WS_KIMG = 464 * MiB, WS_END = 496 * MiB;
constexpr size_t W_MAIN = 0, W_V = (size_t)3072 * 1024, W_OUT = W_V + (size_t)1024 * 1024, W_XQ = W_OUT + (size_t)1024 * 1024, W_XK = W_XQ + (size_t)512 * 1024,
                 W_XV = W_XK + (size_t)512 * 1024, W_XO = W_XV + (size_t)512 * 1024, W_LAYER = W_XO + (size_t)1024 * 512;
static_assert(W_LAYER * 2 * 2 <= 32 * MiB, "weights fit");
constexpr int LDS_BYTES = 155648;
constexpr int LDS_MISC = 143360, LDS_RED = 143360 + 1024;

__device__ __forceinline__ unsigned cvtpk(float lo, float hi) { f32x2_t v = {lo, hi}; bf16x2_t b = __builtin_convertvector(v, bf16x2_t); return __builtin_bit_cast(unsigned, b); }
__device__ __forceinline__ float bflo(unsigned w) { return __uint_as_float(w << 16); }
__device__ __forceinline__ float bfhi(unsigned w) { return __uint_as_float(w & 0xffff0000u); }
__device__ __forceinline__ float ex2(float x) { return __builtin_amdgcn_exp2f(x); }
__device__ __forceinline__ float lg2(float x) { return __builtin_amdgcn_logf(x); }
__device__ __forceinline__ float rinv_row(const float* ssq, int row) {
    const f32x4 s = *(const f32x4*)(ssq + (size_t)row * 4);
    return __builtin_amdgcn_rsqf(((s.x + s.y) + (s.z + s.w)) * (1.f / 1024.f) + RMS_EPS);
}
__device__ __forceinline__ float silu_f(float y) { return y * __builtin_amdgcn_rcpf(1.f + ex2(-y * LOG2E)); }
#define ROT2(x1, x2, c, s) do { const float a_ = (x1) * (c) - (x2) * (s), b_ = (x2) * (c) + (x1) * (s); (x1) = a_; (x2) = b_; } while (0)

struct EpiIn {
    static constexpr bool PERM = true, AFTER_DRAIN = false;
    bf16_t* P; const float* ssq; const float* cs64; const float* cs32; bf16_t* Kimg; float* kpart; bf16_t* Ksb; bf16_t* Kdf;
    __device__ __forceinline__ void operator()(const f32x4 (&acc)[2][2][4][2], const Unit& u, int wr, int wc, int fr, int fq) const {
        const int row0 = u.pm * 256 + wr * 64 + fr;
        float rinv[2][4];
#pragma unroll
        for (int ai = 0; ai < 2; ++ai)
#pragma unroll
            for (int m = 0; m < 4; ++m) rinv[ai][m] = rinv_row(ssq, row0 + ai * 128 + m * 16);
#pragma unroll
        for (int bj = 0; bj < 2; ++bj) {
            const int seg = u.pn * 2 + bj;
            const int c0 = seg * 128 + wc * 32 + fq * 8;
            int kind; float sc = 1.f;
            if (seg < 3) { kind = 1; sc = 0.125f * LOG2E; } else if (seg < 6) { kind = 1; } else if (seg < 9) { kind = 3; }
            else if (seg < 11) { kind = 2; sc = 0.17677669529663687f * LOG2E; } else if (seg < 13) { kind = 2; } else if (seg < 15) { kind = 3; }
            else if (seg < 18) { kind = 0; sc = 0.125f * LOG2E; } else if (seg < 21) { kind = 0; } else { kind = 3; }
            const bool rope = (kind == 1 && (c0 & 63) < 16) || (kind == 2 && (c0 & 31) == 0);
            f32x4 cs0 = {0.f, 0.f, 0.f, 0.f}, cs1 = {0.f, 0.f, 0.f, 0.f};
#pragma unroll
            for (int ai = 0; ai < 2; ++ai)
#pragma unroll
                for (int m = 0; m < 4; ++m) {
                    const int row = row0 + ai * 128 + m * 16; const float s = rinv[ai][m];
                    f32x4 v0 = acc[ai][bj][m][0] * s, v1 = acc[ai][bj][m][1] * s;
                    if (kind == 3) {
                        v0.x = silu_f(v0.x); v0.y = silu_f(v0.y); v0.z = silu_f(v0.z); v0.w = silu_f(v0.w);
                        v1.x = silu_f(v1.x); v1.y = silu_f(v1.y); v1.z = silu_f(v1.z); v1.w = silu_f(v1.w);
                    } else {
                        if (rope) {
                            const float* t = (kind == 1) ? (cs64 + (size_t)row * 16 + (c0 & 63)) : (cs32 + (size_t)row * 8);
                            const f32x4 t0 = *(const f32x4*)t, t1 = *(const f32x4*)(t + 4);
                            ROT2(v0.x, v0.y, t0.x, t0.y); ROT2(v0.z, v0.w, t0.z, t0.w); ROT2(v1.x, v1.y, t1.x, t1.y); ROT2(v1.z, v1.w, t1.z, t1.w);
                        }
                        v0 = v0 * sc; v1 = v1 * sc;
                        cs0 = cs0 + v0; cs1 = cs1 + v1;
                    }
                    u32x4 w; w.x = cvtpk(v0.x, v0.y); w.y = cvtpk(v0.z, v0.w); w.z = cvtpk(v1.x, v1.y); w.w = cvtpk(v1.z, v1.w);
                    bf16_t* dst = P + (size_t)row * PW + c0;
                    if (seg >= 3 && seg < 6) {
                        const int cc = c0 - 384, hh = cc >> 6, ch = (cc & 63) >> 3, bb = row >> 13, s = row & 8191;
                        dst = Kimg + ((((size_t)(bb * 6 + hh) * 128 + (s >> 6)) * 8 + ch) * 64 + (s & 63)) * 8;
                    }
                    if (seg >= 11 && seg < 13) {
                        const int cc = c0 - 1408, hh = cc >> 6, ch = (cc & 63) >> 3, bb = row >> 13, s = row & 8191;
                        dst = Kdf + ((((size_t)(bb * 4 + hh) * 128 + (s >> 6)) * 8 + ch) * 64 + (s & 63)) * 8;
                    }
                    if (seg >= 18 && seg < 21) {
                        const int cc = c0 - 2304, hh = cc >> 6, ch = (cc & 63) >> 3, bb = row >> 13, s = row & 8191;
                        dst = Ksb + ((((size_t)(bb * 6 + hh) * 128 + (s >> 6)) * 8 + ch) * 64 + (s & 63)) * 8;
                    }
                    *(u32x4*)dst = w;
                }
            if (seg >= 3 && seg < 6) {
#pragma unroll
                for (int o = 1; o < 16; o <<= 1) {
                    cs0.x += __shfl_xor(cs0.x, o); cs0.y += __shfl_xor(cs0.y, o); cs0.z += __shfl_xor(cs0.z, o); cs0.w += __shfl_xor(cs0.w, o);
                    cs1.x += __shfl_xor(cs1.x, o); cs1.y += __shfl_xor(cs1.y, o); cs1.z += __shfl_xor(cs1.z, o); cs1.w += __shfl_xor(cs1.w, o);
                }
                if (fr == 0) {
                    const int cc = c0 - 384, hh = cc >> 6, bb = u.pm >> 5, blk = u.pm & 31;
                    float* kp = kpart + ((((size_t)(bb * 6 + hh) * 32 + blk) * 2 + wr) * 64 + (cc & 63));
                    *(f32x4*)kp = cs0; *(f32x4*)(kp + 4) = cs1;
                }
            }
        }
    }
};
struct EpiVt {
    static constexpr bool PERM = true, AFTER_DRAIN = false;
    bf16_t* Vt; const float* ssq;
    __device__ __forceinline__ void operator()(const f32x4 (&acc)[2][2][4][2], const Unit& u, int wr, int wc, int fr, int fq) const {
        const int row0 = u.pm * 256 + wr * 64 + fr;
#pragma unroll
        for (int bj = 0; bj < 2; ++bj) {
            const int c0 = u.pn * 256 + bj * 128 + wc * 32 + fq * 8;
            float ri[8];
#pragma unroll
            for (int j = 0; j < 8; ++j) ri[j] = rinv_row(ssq, c0 + j);
#pragma unroll
            for (int ai = 0; ai < 2; ++ai)
#pragma unroll
                for (int m = 0; m < 4; ++m) {
                    const int row = row0 + ai * 128 + m * 16;
                    const f32x4 v0 = acc[ai][bj][m][0], v1 = acc[ai][bj][m][1];
                    u32x4 w; w.x = cvtpk(v0.x * ri[0], v0.y * ri[1]); w.y = cvtpk(v0.z * ri[2], v0.w * ri[3]); w.z = cvtpk(v1.x * ri[4], v1.y * ri[5]); w.w = cvtpk(v1.z * ri[6], v1.w * ri[7]);
                    bf16_t* dst = Vt + (size_t)row * TT + c0;
                    if (2 * u.pm + ai < 3) {
                        const int hh = row >> 6, d = row & 63, bb = c0 >> 13, s = c0 & 8191;
                        dst = Vt + ((((size_t)(bb * 6 + hh) * 128 + (s >> 6)) * 8 + ((s & 63) >> 3)) * 64 + d) * 8;
                    }
                    if (2 * u.pm + ai == 3 || 2 * u.pm + ai == 4) {
                        const int rr = row - 384, hh = rr >> 6, d = rr & 63, bb = c0 >> 13, s = c0 & 8191;
                        dst = Vt + (size_t)384 * TT + ((((size_t)(bb * 4 + hh) * 128 + (s >> 6)) * 8 + ((s & 63) >> 3)) * 64 + d) * 8;
                    }
                    if (2 * u.pm + ai >= 5) {
                        const int rr = row - 640, hh = rr >> 6, d = rr & 63, bb = c0 >> 13, s = c0 & 8191;
                        dst = Vt + (size_t)640 * TT + ((((size_t)(bb * 6 + hh) * 128 + (s >> 6)) * 8 + ((s & 63) >> 3)) * 64 + d) * 8;
                    }
                    *(u32x4*)dst = w;
                }
        }
    }
};
struct EpiRes {
    static constexpr bool PERM = true, AFTER_DRAIN = false;
    bf16_t* h; float* ssq; LAS float* red; int tid;
    __device__ __forceinline__ void operator()(const f32x4 (&acc)[2][2][4][2], const Unit& u, int wr, int wc, int fr, int fq) const {
        const int row0 = u.pm * 256 + wr * 64 + fr, col0 = u.pn * 256 + wc * 32 + 8 * fq;
#pragma unroll
        for (int ai = 0; ai < 2; ++ai)
#pragma unroll
            for (int m = 0; m < 4; ++m) {
                const int row = row0 + ai * 128 + m * 16; float ss = 0.f;
#pragma unroll
                for (int bj = 0; bj < 2; ++bj) {
                    bf16_t* p = h + (size_t)row * DM + col0 + bj * 128;
                    const u32x4 v = *(const u32x4*)p; const f32x4 a0 = acc[ai][bj][m][0], a1 = acc[ai][bj][m][1];
                    const float h0 = bflo(v.x) + a0.x, h1 = bfhi(v.x) + a0.y, h2 = bflo(v.y) + a0.z, h3 = bfhi(v.y) + a0.w, h4 = bflo(v.z) + a1.x, h5 = bfhi(v.z) + a1.y, h6 = bflo(v.w) + a1.z, h7 = bfhi(v.w) + a1.w;
                    u32x4 w; w.x = cvtpk(h0, h1); w.y = cvtpk(h2, h3); w.z = cvtpk(h4, h5); w.w = cvtpk(h6, h7);
                    *(u32x4*)p = w;
                    const float r0 = bflo(w.x), r1 = bfhi(w.x), r2 = bflo(w.y), r3 = bfhi(w.y), r4 = bflo(w.z), r5 = bfhi(w.z), r6 = bflo(w.w), r7 = bfhi(w.w);
                    ss += ((r0 * r0 + r1 * r1) + (r2 * r2 + r3 * r3)) + ((r4 * r4 + r5 * r5) + (r6 * r6 + r7 * r7));
                }
                ss += __shfl_xor(ss, 16); ss += __shfl_xor(ss, 32);
                if (fq == 0) red[(ai * 128 + wr * 64 + m * 16 + fr) * 4 + wc] = ss;
            }
        asm volatile("s_waitcnt lgkmcnt(0)" ::: "memory"); __builtin_amdgcn_s_barrier(); asm volatile("" ::: "memory");
        if (tid < 256) { const f32x4 v = *(const LAS f32x4*)(red + tid * 4); ssq[(size_t)(u.pm * 256 + tid) * 4 + u.pn] = (v.x + v.y) + (v.z + v.w); }
    }
};
struct EpiB16 {
    static constexpr bool PERM = true, AFTER_DRAIN = false;
    bf16_t* O; int ldc; const float* ssq; float scale;
    __device__ __forceinline__ void operator()(const f32x4 (&acc)[2][2][4][2], const Unit& u, int wr, int wc, int fr, int fq) const {
        const int row0 = u.pm * 256 + wr * 64 + fr;
#pragma unroll
        for (int ai = 0; ai < 2; ++ai)
#pragma unroll
            for (int m = 0; m < 4; ++m) {
                const int row = row0 + ai * 128 + m * 16; const float s = ssq ? scale * rinv_row(ssq, row) : scale;
#pragma unroll
                for (int bj = 0; bj < 2; ++bj) {
                    const int c0 = u.pn * 256 + bj * 128 + wc * 32 + fq * 8;
                    const f32x4 v0 = acc[ai][bj][m][0] * s, v1 = acc[ai][bj][m][1] * s;
                    u32x4 w; w.x = cvtpk(v0.x, v0.y); w.y = cvtpk(v0.z, v0.w); w.z = cvtpk(v1.x, v1.y); w.w = cvtpk(v1.z, v1.w);
                    *(u32x4*)(O + (size_t)row * ldc + c0) = w;
                }
            }
    }
};

struct ACtx { int tid, lane, wid, r32, hi, r32p; LAS unsigned char* lds; };
#define MFMA32(a, b, c) __builtin_amdgcn_mfma_f32_32x32x16_bf16((a), (b), (c), 0, 0, 0)

template <int ROWS, int CH> struct Stage {
    static constexpr int N = ROWS * CH / 512;
    u32x4 r[N];
    __device__ __forceinline__ void load(const bf16_t* g, size_t pitch, int tid) {
#pragma unroll
        for (int i = 0; i < N; ++i) { const int idx = tid + i * 512, rl = idx & 7, c = (idx >> 3) & (CH - 1), rh = idx / (8 * CH); r[i] = *(const u32x4*)(g + (size_t)(rh * 8 + rl) * pitch + c * 8); }
    }
    __device__ __forceinline__ void store(LAS unsigned char* dst, int tid) const {
#pragma unroll
        for (int i = 0; i < N; ++i) { const int idx = tid + i * 512, rl = idx & 7, c = (idx >> 3) & (CH - 1), rh = idx / (8 * CH); *(LAS u32x4*)(dst + c * (ROWS * 16) + (rh * 8 + rl) * 16) = r[i]; }
    }
};
template <int ROWS, int CH> __device__ __forceinline__ void stage_glds(const bf16_t* g, size_t pitch, LAS unsigned char* dst, const ACtx& c) {
    constexpr int RB = ROWS / 64, NP = RB * CH / 8;
#pragma unroll
    for (int i = 0; i < NP; ++i) {
        const int p = c.wid + 8 * i, chunk = p / RB, rb = p % RB;
        __builtin_amdgcn_global_load_lds((const unsigned*)(g + (size_t)(rb * 64 + c.lane) * pitch + chunk * 8), (LAS unsigned*)(dst + chunk * (ROWS * 16) + rb * 1024), 16, 0, 0);
    }
}
__device__ __forceinline__ bf16x8 pack8(float a0, float a1, float a2, float a3, float a4, float a5, float a6, float a7) {
    u32x4 w; w.x = cvtpk(a0, a1); w.y = cvtpk(a2, a3); w.z = cvtpk(a4, a5); w.w = cvtpk(a6, a7); return __builtin_bit_cast(bf16x8, w);
}
template <int NK, int KSTR = 1024> __device__ __forceinline__ void qk_tile(f32x16& p0, f32x16& p1, const LAS unsigned char* Ks, int cb, const bf16x8* qr, const ACtx& c) {
    f32x16 z;
#pragma unroll
    for (int r = 0; r < 16; ++r) z[r] = 0.f;
    p0 = z; p1 = z;
    __builtin_amdgcn_s_setprio(1);
#pragma unroll
    for (int d0 = 0; d0 < NK; ++d0) {
        const LAS unsigned char* a = Ks + (cb + 2 * d0 + c.hi) * KSTR + c.r32p * 16;
        const bf16x8 k0 = *(const LAS bf16x8*)a, k1 = *(const LAS bf16x8*)(a + 512);
        p0 = MFMA32(k0, qr[d0], p0); p1 = MFMA32(k1, qr[d0], p1);
    }
    __builtin_amdgcn_s_setprio(0);
}
template <int DVB, int VSTR = 512 * DVB> __device__ __forceinline__ void pv_tile(f32x16* o, const LAS unsigned char* Vs, const f32x16& p0, const f32x16& p1, const ACtx& c) {
    bf16x8 pf[4];
    pf[0] = pack8(p0[0], p0[1], p0[2], p0[3], p0[4], p0[5], p0[6], p0[7]); pf[1] = pack8(p0[8], p0[9], p0[10], p0[11], p0[12], p0[13], p0[14], p0[15]);
    pf[2] = pack8(p1[0], p1[1], p1[2], p1[3], p1[4], p1[5], p1[6], p1[7]); pf[3] = pack8(p1[8], p1[9], p1[10], p1[11], p1[12], p1[13], p1[14], p1[15]);
#pragma unroll
    for (int s = 0; s < 4; ++s)
#pragma unroll
        for (int d0 = 0; d0 < DVB; ++d0) {
            const bf16x8 v = *(const LAS bf16x8*)(Vs + (2 * s + c.hi) * VSTR + (32 * d0 + c.r32) * 16);
            o[d0] = MFMA32(v, pf[s], o[d0]);
        }
}
__device__ __forceinline__ float softmax_step(f32x16& p0, f32x16& p1, float& m, float& l) {
    float mx = fmaxf(p0[0], p1[0]);
#pragma unroll
    for (int r = 1; r < 16; ++r) mx = fmaxf(mx, fmaxf(p0[r], p1[r]));
    mx = fmaxf(mx, __shfl_xor(mx, 32));
    const float mn = fmaxf(m, mx), alpha = ex2(m - mn); m = mn;
    float rs = 0.f;
#pragma unroll
    for (int r = 0; r < 16; ++r) { p0[r] = ex2(p0[r] - mn); p1[r] = ex2(p1[r] - mn); rs += p0[r] + p1[r]; }
    l = l * alpha + rs;
    return alpha;
}
__device__ __forceinline__ void scale_o(f32x16& o, float a) {
#pragma unroll
    for (int r = 0; r < 16; ++r) o[r] *= a;
}
__device__ __forceinline__ void zero16(f32x16& o) {
#pragma unroll
    for (int r = 0; r < 16; ++r) o[r] = 0.f;
}
__device__ __forceinline__ void xhalf(float v, float& lo, float& hi) { auto r = __builtin_amdgcn_permlane32_swap(__float_as_uint(v), __float_as_uint(v), false, false); lo = __uint_as_float(r[0]); hi = __uint_as_float(r[1]); }
__device__ __forceinline__ float xhalf_partner(float v, int hi_lane) { float lo, hi; xhalf(v, lo, hi); return hi_lane ? lo : hi; }
__device__ __forceinline__ unsigned xhalf_or(unsigned v) { auto r = __builtin_amdgcn_permlane32_swap(v, v, false, false); return r[0] | r[1]; }
struct Soft { float m; int zm; float l; };
__device__ __forceinline__ void soft_init(Soft& s) { s.m = 0.f; s.zm = 1; s.l = 0.f; }
__device__ __forceinline__ float max3f(float a, float b, float c) { float r; asm("v_max3_f32 %0, %1, %2, %3" : "=v"(r) : "v"(a), "v"(b), "v"(c)); return r; }
template <int NO> __device__ __forceinline__ void soft_step(Soft& s, f32x16& p0, f32x16& p1, f32x16* o, bool first) {
    float a = max3f(p0[0], p0[1], p1[0]), b = max3f(p0[2], p0[3], p1[1]); a = max3f(a, p1[2], p1[3]);
#pragma unroll
    for (int r = 4; r < 16; r += 4) { a = max3f(a, p0[r], p0[r + 1]); b = max3f(b, p0[r + 2], p0[r + 3]); a = max3f(a, p1[r], p1[r + 1]); b = max3f(b, p1[r + 2], p1[r + 3]); }
    float mx = max3f(a, b, b);
    { float lo_, hi_; xhalf(mx, lo_, hi_); mx = max3f(lo_, hi_, hi_); }
    const float d = mx - s.m;
    const bool up = d > 32.f, dn = first && (d < -32.f) && (mx > -1.0e29f);
    if (__any(up || dn)) {
        const float mn = (up || dn) ? mx : s.m; const float alpha = ex2(s.m - mn); s.m = mn;
        s.l *= alpha;
#pragma unroll
        for (int i = 0; i < NO; ++i) scale_o(o[i], alpha);
        s.zm = __all(s.m == 0.f);
    }
    if (s.zm) {
#pragma unroll
        for (int r = 0; r < 16; ++r) { p0[r] = ex2(p0[r]); p1[r] = ex2(p1[r]); }
    } else {
        const float m = s.m;
#pragma unroll
        for (int r = 0; r < 16; ++r) { p0[r] = ex2(p0[r] - m); p1[r] = ex2(p1[r] - m); }
    }
}
__device__ __forceinline__ bf16x8 ones8() { u32x4 w; w.x = 0x3F803F80u; w.y = 0x3F803F80u; w.z = 0x3F803F80u; w.w = 0x3F803F80u; return __builtin_bit_cast(bf16x8, w); }
template <int DVB, int VSTR> __device__ __forceinline__ void pv_tile_l(f32x16* o, float& l, const LAS unsigned char* Vs, const f32x16& p0, const f32x16& p1, const ACtx& c) {
    bf16x8 pf[4];
    pf[0] = pack8(p0[0], p0[1], p0[2], p0[3], p0[4], p0[5], p0[6], p0[7]); pf[1] = pack8(p0[8], p0[9], p0[10], p0[11], p0[12], p0[13], p0[14], p0[15]);
    pf[2] = pack8(p1[0], p1[1], p1[2], p1[3], p1[4], p1[5], p1[6], p1[7]); pf[3] = pack8(p1[8], p1[9], p1[10], p1[11], p1[12], p1[13], p1[14], p1[15]);
    const bf16x8 one = ones8();
    f32x16 la; zero16(la);
    __builtin_amdgcn_s_setprio(1);
#pragma unroll
    for (int s = 0; s < 4; ++s) {
        la = MFMA32(one, pf[s], la);
#pragma unroll
        for (int d0 = 0; d0 < DVB; ++d0) {
            const bf16x8 v = *(const LAS bf16x8*)(Vs + (2 * s + c.hi) * VSTR + (32 * d0 + c.r32) * 16);
            o[d0] = MFMA32(v, pf[s], o[d0]);
        }
    }
    __builtin_amdgcn_s_setprio(0);
    l += la[0];
}
template <bool STRICT> __device__ __forceinline__ void mask_causal(f32x16& p0, f32x16& p1, int kbase, int q, int hi) {
#pragma unroll
    for (int r = 0; r < 16; ++r) {
        const int key = kbase + 16 * (r >> 3) + 8 * hi + (r & 7);
        const bool v0 = STRICT ? (key < q) : (key <= q), v1 = STRICT ? (key + 32 < q) : (key + 32 <= q);
        p0[r] = v0 ? p0[r] : NEGF; p1[r] = v1 ? p1[r] : NEGF;
    }
}
__device__ __forceinline__ void top3_insert(float& t1, float& t2, float& t3, float v) {
    const float a = fmaxf(t1, v), b = fminf(t1, v); t1 = a; const float c = fmaxf(t2, b), d = fminf(t2, b); t2 = c; t3 = fmaxf(t3, d);
}

__device__ __forceinline__ void store_gated_rows(const ACtx& c, LAS unsigned char* stg, const f32x16* o, const bf16_t* Gp0, bf16_t* Op0, size_t gpitch) {
#pragma unroll
    for (int d0 = 0; d0 < 2; ++d0)
#pragma unroll
        for (int r4 = 0; r4 < 4; ++r4) {
            u32x2 w; w.x = cvtpk(o[d0][4 * r4], o[d0][4 * r4 + 1]); w.y = cvtpk(o[d0][4 * r4 + 2], o[d0][4 * r4 + 3]);
            *(LAS u32x2*)(stg + c.r32 * 128 + (((4 * d0 + r4) ^ (c.r32 & 7)) * 16) + c.hi * 8) = w;
        }
    asm volatile("s_waitcnt lgkmcnt(0)" ::: "memory");
#pragma unroll
    for (int i = 0; i < 4; ++i) {
        const int row = i * 8 + (c.lane >> 3), ch = c.lane & 7;
        const u32x4 v = *(const LAS u32x4*)(stg + row * 128 + ((ch ^ (row & 7)) * 16));
        const u32x4 g = *(const u32x4*)(Gp0 + (size_t)row * gpitch + ch * 8);
        u32x4 w; w.x = cvtpk(bflo(v.x) * bflo(g.x), bfhi(v.x) * bfhi(g.x)); w.y = cvtpk(bflo(v.y) * bflo(g.y), bfhi(v.y) * bfhi(g.y));
        w.z = cvtpk(bflo(v.z) * bflo(g.z), bfhi(v.z) * bfhi(g.z)); w.w = cvtpk(bflo(v.w) * bflo(g.w), bfhi(v.w) * bfhi(g.w));
        *(u32x4*)(Op0 + (size_t)row * DM + ch * 8) = w;
    }
    asm volatile("s_waitcnt lgkmcnt(0)" ::: "memory");
}
constexpr int MOBA_PART = 32768, MOBA_REC = 136;
template <int NP> __device__ __forceinline__ void stage_linear(const bf16_t* g, LAS unsigned char* dst, const ACtx& c) {
#pragma unroll
    for (int i = 0; i < NP; ++i) { const int p = c.wid + 8 * i; __builtin_amdgcn_global_load_lds((const unsigned*)(g + (size_t)p * 512 + c.lane * 8), (LAS unsigned*)(dst + p * 1024), 16, 0, 0); }
}
__device__ __forceinline__ void moba_unit(const ACtx& c, int b, int h, int qb, const bf16_t* P, const bf16_t* Kimg, const bf16_t* Vimg, const float* kpart, bf16_t* merged) {
    const size_t tok0 = (size_t)b * SEQ;
    const int qrel = c.wid * 32 + c.r32;
    const size_t qtok = tok0 + qb * 256 + qrel;
    const bf16_t* Kg = Kimg + (size_t)(b * 6 + h) * 128 * 4096;
    const bf16_t* Vg = Vimg + (size_t)(b * 6 + h) * 128 * 4096;
    const bf16_t* Qp = P + qtok * PW + h * 64;
    unsigned sel = 0u;
    if (qb > 0) {
        {
            bf16x8 qr[4];
#pragma unroll
            for (int d0 = 0; d0 < 4; ++d0) qr[d0] = *(const bf16x8*)(Qp + d0 * 16 + c.hi * 8);
            f32x16 g; zero16(g);
            const float* km = kpart + ((size_t)(b * 6 + h) * 32 + c.r32) * 128;
#pragma unroll
            for (int d0 = 0; d0 < 4; ++d0) {
                const float* kq = km + d0 * 16 + c.hi * 8;
                const f32x4 a0 = *(const f32x4*)kq + *(const f32x4*)(kq + 64), a1 = *(const f32x4*)(kq + 4) + *(const f32x4*)(kq + 68);
                const float sc = 1.f / 256.f;
                const bf16x8 kf = pack8(a0.x * sc, a0.y * sc, a0.z * sc, a0.w * sc, a1.x * sc, a1.y * sc, a1.z * sc, a1.w * sc); g = MFMA32(kf, qr[d0], g);
            }
            float t1 = NEGF, t2 = NEGF, t3 = NEGF;
#pragma unroll
            for (int r = 0; r < 16; ++r) { const int blk = (r & 3) + 8 * (r >> 2) + 4 * c.hi; const float v = (blk < qb) ? g[r] : NEGF; g[r] = v; top3_insert(t1, t2, t3, v); }
            const float u1 = xhalf_partner(t1, c.hi), u2 = xhalf_partner(t2, c.hi), u3 = xhalf_partner(t3, c.hi);
            top3_insert(t1, t2, t3, u1); top3_insert(t1, t2, t3, u2); top3_insert(t1, t2, t3, u3);
            unsigned seq = 0u;
#pragma unroll
            for (int r = 0; r < 16; ++r) { const int blk = (r & 3) + 8 * (r >> 2) + 4 * c.hi; if (blk < qb) { if (g[r] > t3) sel |= 1u << blk; else if (g[r] == t3) seq |= 1u << blk; } }
            sel = xhalf_or(sel); seq = xhalf_or(seq);
            { const int need = 3 - __popc(sel); while (__popc(seq) > need) seq &= ~(0x80000000u >> __clz((int)seq)); }
            sel |= seq;
        }
        LAS int* cnt = (LAS int*)c.lds; LAS unsigned short* list = (LAS unsigned short*)(c.lds + 1024);
        if (c.tid < 32) cnt[c.tid] = 0;
        __syncthreads();
        if (c.hi == 0) {
            unsigned s = sel; int slot = 0;
            while (s) { const int blk = __ffs((int)s) - 1; s &= s - 1u; const int pos = __hip_atomic_fetch_add(cnt + blk, 1, __ATOMIC_RELAXED, __HIP_MEMORY_SCOPE_WORKGROUP); list[blk * 256 + pos] = (unsigned short)(qrel | (slot << 8)); ++slot; }
        }
        __syncthreads();
        int item = 0;
#pragma unroll 1
        for (int j = 0; j < qb; ++j) {
            const int n = __builtin_amdgcn_readfirstlane(cnt[j]); const int ntile = (n + 31) >> 5;
#pragma unroll 1
            for (int tl = 0; tl < ntile; ++tl, ++item) {
                if ((item & 7) != c.wid) continue;
                const int idx = 32 * tl + c.r32; const bool valid = idx < n;
                const unsigned e = list[j * 256 + (valid ? idx : 0)]; const int ql = e & 255, slot = e >> 8;
                const bf16_t* Qg = P + (tok0 + qb * 256 + ql) * PW + h * 64;
                bf16x8 qg[4];
#pragma unroll
                for (int d0 = 0; d0 < 4; ++d0) qg[d0] = *(const bf16x8*)(Qg + d0 * 16 + c.hi * 8);
                Soft s2; soft_init(s2); f32x16 o2[2]; zero16(o2[0]); zero16(o2[1]);
                const bf16_t* kp = Kg + (size_t)(j * 4) * 4096 + (c.hi * 64 + c.r32p) * 8;
                const bf16_t* vp = Vg + (size_t)(j * 4) * 4096 + (c.hi * 64 + c.r32) * 8;
                bf16x8 kc[8];
#pragma unroll
                for (int i = 0; i < 4; ++i) { kc[2 * i] = *(const bf16x8*)(kp + i * 1024); kc[2 * i + 1] = *(const bf16x8*)(kp + i * 1024 + 256); }
#pragma unroll 1
                for (int kt = 0; kt < 4; ++kt) {
                    bf16x8 vc[8];
                    { const bf16_t* vq = vp + (size_t)kt * 4096;
#pragma unroll
                      for (int i = 0; i < 4; ++i) { vc[2 * i] = *(const bf16x8*)(vq + i * 1024); vc[2 * i + 1] = *(const bf16x8*)(vq + i * 1024 + 256); } }
                    f32x16 p0, p1; zero16(p0); zero16(p1);
#pragma unroll
                    for (int d0 = 0; d0 < 4; ++d0) { p0 = MFMA32(kc[2 * d0], qg[d0], p0); p1 = MFMA32(kc[2 * d0 + 1], qg[d0], p1); }
                    if (kt < 3) {
                        const bf16_t* kq = kp + (size_t)(kt + 1) * 4096;
#pragma unroll
                        for (int i = 0; i < 4; ++i) { kc[2 * i] = *(const bf16x8*)(kq + i * 1024); kc[2 * i + 1] = *(const bf16x8*)(kq + i * 1024 + 256); }
                    }
                    soft_step<2>(s2, p0, p1, o2, kt == 0);
                    bf16x8 pf[4]; const bf16x8 one = ones8(); f32x16 la; zero16(la);
                    pf[0] = pack8(p0[0], p0[1], p0[2], p0[3], p0[4], p0[5], p0[6], p0[7]); pf[1] = pack8(p0[8], p0[9], p0[10], p0[11], p0[12], p0[13], p0[14], p0[15]);
                    pf[2] = pack8(p1[0], p1[1], p1[2], p1[3], p1[4], p1[5], p1[6], p1[7]); pf[3] = pack8(p1[8], p1[9], p1[10], p1[11], p1[12], p1[13], p1[14], p1[15]);
#pragma unroll
                    for (int s = 0; s < 4; ++s) {
                        o2[0] = MFMA32(vc[2 * s], pf[s], o2[0]); o2[1] = MFMA32(vc[2 * s + 1], pf[s], o2[1]);
                    }
                    { float sa_ = 0.f;
#pragma unroll
                      for (int r = 0; r < 16; ++r) sa_ += p0[r] + p1[r];
                      s2.l += sa_; }
                }
                float l2; { float lo_, hi_; xhalf(s2.l, lo_, hi_); l2 = lo_ + hi_; } const float m2 = s2.m;
                if (valid) {
                    LAS unsigned char* rec = c.lds + MOBA_PART + (ql * 3 + slot) * MOBA_REC;
#pragma unroll
                    for (int d0 = 0; d0 < 2; ++d0)
#pragma unroll
                        for (int r4 = 0; r4 < 4; ++r4) { u32x2 w; w.x = cvtpk(o2[d0][4 * r4], o2[d0][4 * r4 + 1]); w.y = cvtpk(o2[d0][4 * r4 + 2], o2[d0][4 * r4 + 3]); *(LAS u32x2*)(rec + (32 * d0 + 8 * r4 + 4 * c.hi) * 2) = w; }
                    if (c.hi == 0) { *(LAS float*)(rec + 128) = m2; *(LAS float*)(rec + 132) = l2; }
                }
            }
        }
        __syncthreads();
    }
    Soft sm; soft_init(sm); f32x16 o[2]; zero16(o[0]); zero16(o[1]);
    {
        bf16x8 qr[4];
#pragma unroll
        for (int d0 = 0; d0 < 4; ++d0) qr[d0] = *(const bf16x8*)(Qp + d0 * 16 + c.hi * 8);
        const bf16_t* kp = Kg + (size_t)(qb * 4) * 4096 + (c.hi * 64 + c.r32p) * 8;
        const bf16_t* vp = Vg + (size_t)(qb * 4) * 4096 + (c.hi * 64 + c.r32) * 8;
        const int ntl = ((32 * c.wid + 31) >> 6) + 1;
        bf16x8 kc[8];
#pragma unroll
        for (int i = 0; i < 4; ++i) { kc[2 * i] = *(const bf16x8*)(kp + i * 1024); kc[2 * i + 1] = *(const bf16x8*)(kp + i * 1024 + 256); }
#pragma unroll 1
        for (int kt = 0; kt < ntl; ++kt) {
            bf16x8 vc[8];
            { const bf16_t* vq = vp + (size_t)kt * 4096;
#pragma unroll
              for (int i = 0; i < 4; ++i) { vc[2 * i] = *(const bf16x8*)(vq + i * 1024); vc[2 * i + 1] = *(const bf16x8*)(vq + i * 1024 + 256); } }
            f32x16 p0, p1; zero16(p0); zero16(p1);
#pragma unroll
            for (int d0 = 0; d0 < 4; ++d0) { p0 = MFMA32(kc[2 * d0], qr[d0], p0); p1 = MFMA32(kc[2 * d0 + 1], qr[d0], p1); }
            if (kt + 1 < ntl) {
                const bf16_t* kq = kp + (size_t)(kt + 1) * 4096;
#pragma unroll
                for (int i = 0; i < 4; ++i) { kc[2 * i] = *(const bf16x8*)(kq + i * 1024); kc[2 * i + 1] = *(const bf16x8*)(kq + i * 1024 + 256); }
            }
            if (64 * kt + 63 > 32 * c.wid) mask_causal<false>(p0, p1, 64 * kt, qrel, c.hi);
            soft_step<2>(sm, p0, p1, o, kt == 0);
            bf16x8 pf[4]; const bf16x8 one = ones8(); f32x16 la; zero16(la);
            pf[0] = pack8(p0[0], p0[1], p0[2], p0[3], p0[4], p0[5], p0[6], p0[7]); pf[1] = pack8(p0[8], p0[9], p0[10], p0[11], p0[12], p0[13], p0[14], p0[15]);
            pf[2] = pack8(p1[0], p1[1], p1[2], p1[3], p1[4], p1[5], p1[6], p1[7]); pf[3] = pack8(p1[8], p1[9], p1[10], p1[11], p1[12], p1[13], p1[14], p1[15]);
#pragma unroll
            for (int s = 0; s < 4; ++s) { o[0] = MFMA32(vc[2 * s], pf[s], o[0]); o[1] = MFMA32(vc[2 * s + 1], pf[s], o[1]); }
            { float sa_ = 0.f;
#pragma unroll
              for (int r = 0; r < 16; ++r) sa_ += p0[r] + p1[r];
              sm.l += sa_; }
        }
    }
    float l; { float lo_, hi_; xhalf(sm.l, lo_, hi_); l = lo_ + hi_; }
    if (qb > 0) {
        const float m = sm.m;
        const int nsel = __popc(sel);
        const LAS unsigned char* rec0 = c.lds + MOBA_PART + (qrel * 3) * MOBA_REC;
        float ms0 = NEGF, ms1 = NEGF, ms2 = NEGF;
        if (nsel > 0) ms0 = *(const LAS float*)(rec0 + 128);
        if (nsel > 1) ms1 = *(const LAS float*)(rec0 + MOBA_REC + 128);
        if (nsel > 2) ms2 = *(const LAS float*)(rec0 + 2 * MOBA_REC + 128);
        const float M = fmaxf(fmaxf(m, ms0), fmaxf(ms1, ms2));
        const float w0 = ex2(m - M); l *= w0; scale_o(o[0], w0); scale_o(o[1], w0);
#pragma unroll
        for (int s = 0; s < 3; ++s) {
            if (s < nsel) {
                const LAS unsigned char* rec = rec0 + s * MOBA_REC;
                const float ws = ex2((s == 0 ? ms0 : (s == 1 ? ms1 : ms2)) - M);
                l += ws * *(const LAS float*)(rec + 132);
#pragma unroll
                for (int d0 = 0; d0 < 2; ++d0)
#pragma unroll
                    for (int r4 = 0; r4 < 4; ++r4) { const u32x2 v = *(const LAS u32x2*)(rec + (32 * d0 + 8 * r4 + 4 * c.hi) * 2);
                        o[d0][4 * r4] += ws * bflo(v.x); o[d0][4 * r4 + 1] += ws * bfhi(v.x); o[d0][4 * r4 + 2] += ws * bflo(v.y); o[d0][4 * r4 + 3] += ws * bfhi(v.y); }
            }
        }
    }
    const float inv = 1.f / l;
    scale_o(o[0], inv); scale_o(o[1], inv);
    { const size_t qt0 = tok0 + qb * 256 + c.wid * 32;
      store_gated_rows(c, c.lds + c.wid * 4096, o, P + qt0 * PW + 768 + h * 64, merged + qt0 * DM + h * 64, PW); }
    __syncthreads();
}

__device__ __forceinline__ void diff_sub(const bool MASK, const ACtx& c, const LAS unsigned char* Ks, const LAS unsigned char* Vs, const bf16x8 (&qr)[2][2], int kbase, int qabs,
                                                             Soft& s0, Soft& s1, f32x16* oa, f32x16* ob, bool first) {
    f32x16 p0, p1, r0, r1;
    qk_tile<2, 1024>(p0, p1, Ks, 0, qr[0], c);
    qk_tile<2, 1024>(r0, r1, Ks, 4, qr[1], c);
    if (MASK) { mask_causal<false>(p0, p1, kbase, qabs, c.hi); mask_causal<false>(r0, r1, kbase, qabs, c.hi); }
    soft_step<2>(s0, p0, p1, oa, first);
    { float sa = 0.f;
#pragma unroll
      for (int r = 0; r < 16; ++r) sa += p0[r] + p1[r];
      s0.l += sa; }
    pv_tile<2, 1024>(oa, Vs, p0, p1, c);
    soft_step<2>(s1, r0, r1, ob, first);
    { float sb = 0.f;
#pragma unroll
      for (int r = 0; r < 16; ++r) sb += r0[r] + r1[r];
      s1.l += sb; }
    pv_tile<2, 1024>(ob, Vs, r0, r1, c);
}
__device__ __forceinline__ void diff_pair(const ACtx& c, const LAS unsigned char* Kb, const LAS unsigned char* Vb, const bf16x8 (&qr)[2][2], int kbase0, int qabs, int q0w,
                                          Soft& s0, Soft& s1, f32x16* oa, f32x16* ob, bool first) {
    const bool do0 = kbase0 <= q0w + 31, do1 = kbase0 + 64 <= q0w + 31, mk0 = kbase0 + 63 > q0w, mk1 = kbase0 + 127 > q0w;
    f32x16 p0, p1, r0, r1, p2, p3, r2, r3;
    if (do0) {
        qk_tile<2, 1024>(p0, p1, Kb, 0, qr[0], c);
        qk_tile<2, 1024>(r0, r1, Kb, 4, qr[1], c);
        if (mk0) { mask_causal<false>(p0, p1, kbase0, qabs, c.hi); mask_causal<false>(r0, r1, kbase0, qabs, c.hi); }
        soft_step<2>(s0, p0, p1, oa, first);
        { float sa = 0.f;
#pragma unroll
          for (int r = 0; r < 16; ++r) sa += p0[r] + p1[r];
          s0.l += sa; }
        pv_tile<2, 1024>(oa, Vb, p0, p1, c);
    }
    if (do1) {
        qk_tile<2, 1024>(p2, p3, Kb + 8192, 0, qr[0], c);
        qk_tile<2, 1024>(r2, r3, Kb + 8192, 4, qr[1], c);
        if (mk1) { mask_causal<false>(p2, p3, kbase0 + 64, qabs, c.hi); mask_causal<false>(r2, r3, kbase0 + 64, qabs, c.hi); }
    }
    if (do0) {
        soft_step<2>(s1, r0, r1, ob, first);
        { float sb = 0.f;
#pragma unroll
          for (int r = 0; r < 16; ++r) sb += r0[r] + r1[r];
          s1.l += sb; }
        pv_tile<2, 1024>(ob, Vb, r0, r1, c);
    }
    if (do1) {
        soft_step<2>(s0, p2, p3, oa, false);
        { float sa = 0.f;
#pragma unroll
          for (int r = 0; r < 16; ++r) sa += p2[r] + p3[r];
          s0.l += sa; }
        pv_tile<2, 1024>(oa, Vb + 8192, p2, p3, c);
        soft_step<2>(s1, r2, r3, ob, false);
        { float sb = 0.f;
#pragma unroll
          for (int r = 0; r < 16; ++r) sb += r2[r] + r3[r];
          s1.l += sb; }
        pv_tile<2, 1024>(ob, Vb + 8192, r2, r3, c);
    }
}
__device__ __forceinline__ void diff_unit(const ACtx& c, int b, int h, int qb, const bf16_t* P, const bf16_t* Kdf, const bf16_t* Vdf, bf16_t* merged, float lam, float one_m_li, const float* hng) {
    const size_t tok0 = (size_t)b * SEQ;
    const int q0w = qb * 256 + c.wid * 32, qabs = q0w + c.r32;
    const size_t qtok = tok0 + qabs;
    const bf16_t* Qp = P + qtok * PW + 1152 + h * 64;
    bf16x8 qr[2][2];
#pragma unroll
    for (int sh = 0; sh < 2; ++sh)
#pragma unroll
        for (int d0 = 0; d0 < 2; ++d0) qr[sh][d0] = *(const bf16x8*)(Qp + sh * 32 + d0 * 16 + c.hi * 8);
    const int NT = 2 * qb + 2;
    const bf16_t* Kg = Kdf + (size_t)(b * 4 + h) * 128 * 4096;
    const bf16_t* Vg = Vdf + (size_t)(b * 4 + h) * 128 * 4096;
    stage_linear<2>(Kg, c.lds, c); stage_linear<2>(Vg, c.lds + 32768, c);
    __syncthreads();
    Soft s0, s1; soft_init(s0); soft_init(s1); f32x16 oa[2], ob[2]; zero16(oa[0]); zero16(oa[1]); zero16(ob[0]); zero16(ob[1]);
#pragma unroll 1
    for (int t = 0; t < NT; ++t) {
        const int cur = t & 1;
        if (t + 1 < NT) { stage_linear<2>(Kg + (size_t)(2 * t + 2) * 4096, c.lds + (cur ^ 1) * 16384, c); stage_linear<2>(Vg + (size_t)(2 * t + 2) * 4096, c.lds + 32768 + (cur ^ 1) * 16384, c); }
        diff_pair(c, c.lds + cur * 16384, c.lds + 32768 + cur * 16384, qr, 128 * t, qabs, q0w, s0, s1, oa, ob, t == 0);
        __syncthreads();
    }
    { float lo_, hi_; xhalf(s0.l, lo_, hi_); s0.l = lo_ + hi_; xhalf(s1.l, lo_, hi_); s1.l = lo_ + hi_; }
    const float a0 = 1.f / s0.l, a1 = lam / s1.l;
    float ss = 0.f;
#pragma unroll
    for (int d0 = 0; d0 < 2; ++d0)
#pragma unroll
        for (int r = 0; r < 16; ++r) { const float f = oa[d0][r] * a0 - ob[d0][r] * a1; oa[d0][r] = f; ss += f * f; }
    { float lo_, hi_; xhalf(ss, lo_, hi_); ss = lo_ + hi_; }
    const float rn = __builtin_amdgcn_rsqf(ss * (1.f / 64.f) + RMS_EPS) * one_m_li;
#pragma unroll
    for (int d0 = 0; d0 < 2; ++d0)
#pragma unroll
        for (int r4 = 0; r4 < 4; ++r4) {
            const int d = 32 * d0 + 8 * r4 + 4 * c.hi; const f32x4 hg = *(const f32x4*)(hng + d);
            oa[d0][4 * r4] *= rn * hg.x; oa[d0][4 * r4 + 1] *= rn * hg.y; oa[d0][4 * r4 + 2] *= rn * hg.z; oa[d0][4 * r4 + 3] *= rn * hg.w;
        }
    { const size_t qt0 = tok0 + q0w;
      store_gated_rows(c, c.lds + c.wid * 4096, oa, P + qt0 * PW + 1664 + h * 64, merged + qt0 * DM + 384 + h * 64, PW); }
    __syncthreads();
}

__device__ __forceinline__ void sb_elem(float z, bool valid, float& a, float& lb) {
    const float e = ex2(-fabsf(z)); const float sp = fmaxf(z, 0.f) + lg2(1.f + e);
    a = valid ? -sp : 0.f; lb = valid ? (z - sp) : NEGF;
}
__device__ __forceinline__ void sb_unit(const ACtx& c, int b, int h, int qb, const bf16_t* P, const bf16_t* Ksb, const bf16_t* Vsb, bf16_t* merged) {
    const size_t tok0 = (size_t)b * SEQ;
    const int q0w = qb * 256 + c.wid * 32, qabs = q0w + c.r32;
    const size_t qtok = tok0 + qabs;
    const bf16_t* Qp = P + qtok * PW + 1920 + h * 64;
    bf16x8 qr[4];
#pragma unroll
    for (int d0 = 0; d0 < 4; ++d0) qr[d0] = *(const bf16x8*)(Qp + d0 * 16 + c.hi * 8);
    const bf16_t* kp = Ksb + (size_t)(b * 6 + h) * 128 * 4096 + (c.hi * 64 + c.r32p) * 8;
    const bf16_t* vp = Vsb + (size_t)(b * 6 + h) * 128 * 4096 + (c.hi * 64 + c.r32) * 8;
    float R = 0.f; f32x16 o[2]; zero16(o[0]); zero16(o[1]);
    int t = (q0w + 30) >> 6;
    {
        bf16x8 kc[8];
#pragma unroll
        for (int i = 0; i < 4; ++i) { kc[2 * i] = *(const bf16x8*)(kp + (size_t)t * 4096 + i * 1024); kc[2 * i + 1] = *(const bf16x8*)(kp + (size_t)t * 4096 + i * 1024 + 256); }
#pragma unroll 1
        for (;;) {
            bf16x8 vc[8];
#pragma unroll
            for (int i = 0; i < 4; ++i) { vc[2 * i] = *(const bf16x8*)(vp + (size_t)t * 4096 + i * 1024); vc[2 * i + 1] = *(const bf16x8*)(vp + (size_t)t * 4096 + i * 1024 + 256); }
            f32x16 p0, p1; zero16(p0); zero16(p1);
#pragma unroll
            for (int d0 = 0; d0 < 4; ++d0) { p0 = MFMA32(kc[2 * d0], qr[d0], p0); p1 = MFMA32(kc[2 * d0 + 1], qr[d0], p1); }
            if (t > 0) {
#pragma unroll
                for (int i = 0; i < 4; ++i) { kc[2 * i] = *(const bf16x8*)(kp + (size_t)(t - 1) * 4096 + i * 1024); kc[2 * i + 1] = *(const bf16x8*)(kp + (size_t)(t - 1) * 4096 + i * 1024 + 256); }
            }
            const bool needmask = (64 * t + 63 >= q0w);
            f32x16 a0, a1;
#pragma unroll
            for (int r = 0; r < 16; ++r) {
                const int key = 64 * t + 16 * (r >> 3) + 8 * c.hi + (r & 7);
                float a, lb;
                sb_elem(p0[r], !needmask || (key < qabs), a, lb); a0[r] = a; p0[r] = lb;
                sb_elem(p1[r], !needmask || (key + 32 < qabs), a, lb); a1[r] = a; p1[r] = lb;
            }
            float gs0 = 0.f, gs1 = 0.f, gs2 = 0.f, gs3 = 0.f;
#pragma unroll
            for (int i = 0; i < 8; ++i) { gs0 += a0[i]; gs1 += a0[8 + i]; gs2 += a1[i]; gs3 += a1[8 + i]; }
            const float pg0 = xhalf_partner(gs0, c.hi), pg1 = xhalf_partner(gs1, c.hi), pg2 = xhalf_partner(gs2, c.hi), pg3 = xhalf_partner(gs3, c.hi);
            const float so2 = gs3, so1 = so2 + gs2, so0 = so1 + gs1;
            const float pe2 = pg3, pe1 = pe2 + pg2, pe0 = pe1 + pg1;
            const float totO = so0 + gs0, totP = pe0 + pg0;
            float base0 = R + so0 + (c.hi ? pe0 : totP);
            float base1 = R + so1 + (c.hi ? pe1 : pe0);
            float base2 = R + so2 + (c.hi ? pe2 : pe1);
            float base3 = R + (c.hi ? 0.f : pe2);
#pragma unroll
            for (int i = 7; i >= 0; --i) {
                p0[i] = ex2(p0[i] + base0); base0 += a0[i];
                p0[8 + i] = ex2(p0[8 + i] + base1); base1 += a0[8 + i];
                p1[i] = ex2(p1[i] + base2); base2 += a1[i];
                p1[8 + i] = ex2(p1[8 + i] + base3); base3 += a1[8 + i];
            }
            R += c.hi ? (totP + totO) : (totO + totP);
            bf16x8 pf[4];
            pf[0] = pack8(p0[0], p0[1], p0[2], p0[3], p0[4], p0[5], p0[6], p0[7]); pf[1] = pack8(p0[8], p0[9], p0[10], p0[11], p0[12], p0[13], p0[14], p0[15]);
            pf[2] = pack8(p1[0], p1[1], p1[2], p1[3], p1[4], p1[5], p1[6], p1[7]); pf[3] = pack8(p1[8], p1[9], p1[10], p1[11], p1[12], p1[13], p1[14], p1[15]);
#pragma unroll
            for (int s = 0; s < 4; ++s) { o[0] = MFMA32(vc[2 * s], pf[s], o[0]); o[1] = MFMA32(vc[2 * s + 1], pf[s], o[1]); }
            if (t == 0 || __all(R < -150.f)) break;
            --t;
        }
    }
    { const size_t qt0 = tok0 + q0w;
      store_gated_rows(c, c.lds + c.wid * 4096, o, P + qt0 * PW + 2688 + h * 64, merged + qt0 * DM + 640 + h * 64, PW); }
}

__device__ __forceinline__ void xattn_unit(const ACtx& c, int b, int hx, int qb, const bf16_t* QX, const bf16_t* KX, const bf16_t* VXT, bf16_t* OX) {
    const size_t qtok = (size_t)b * SEQ + qb * 256 + c.wid * 32 + c.r32;
    const bf16_t* Qp = QX + qtok * 512 + hx * 128;
    bf16x8 qr[8];
#pragma unroll
    for (int d0 = 0; d0 < 8; ++d0) qr[d0] = *(const bf16x8*)(Qp + d0 * 16 + c.hi * 8);
    const bf16_t* Kg = KX + (size_t)(b * MEML) * 512 + hx * 128;
    const bf16_t* Vg = VXT + (size_t)(hx * 128) * 1024 + b * MEML;
    stage_glds<256, 16>(Kg, 512, c.lds, c); stage_glds<128, 32>(Vg, 1024, c.lds + 65536, c);
    __syncthreads();
    Soft sm; soft_init(sm); f32x16 o[4]; zero16(o[0]); zero16(o[1]); zero16(o[2]); zero16(o[3]);
#pragma unroll 1
    for (int t = 0; t < 4; ++t) {
        f32x16 p0, p1; qk_tile<8, 4096>(p0, p1, c.lds + t * 1024, 0, qr, c);
        soft_step<4>(sm, p0, p1, o, t == 0);
        pv_tile_l<4, 2048>(o, sm.l, c.lds + 65536 + t * 16384, p0, p1, c);
    }
    __syncthreads();
    const float inv = 1.f / sm.l;
    bf16_t* Op = OX + qtok * 512 + hx * 128;
#pragma unroll
    for (int d0 = 0; d0 < 4; ++d0)
#pragma unroll
        for (int r4 = 0; r4 < 4; ++r4) {
            const int d = 32 * d0 + 8 * r4 + 4 * c.hi;
            u32x2 w; w.x = cvtpk(o[d0][4 * r4] * inv, o[d0][4 * r4 + 1] * inv); w.y = cvtpk(o[d0][4 * r4 + 2] * inv, o[d0][4 * r4 + 3] * inv);
            *(u32x2*)(Op + d) = w;
        }
}

__device__ __forceinline__ float wave_sum(float v) {
#pragma unroll
    for (int o = 1; o < 64; o <<= 1) v += __shfl_xor(v, o);
    return v;
}
__device__ __forceinline__ void kmean_item(int item, const bf16_t* Kimg, bf16_t* kmean, int lane) {
    const int blk = item & 31, bh = item >> 5;
    const bf16_t* img = Kimg + ((size_t)bh * 128 + blk * 4) * 4096;
    const int kl = lane >> 3, cc = lane & 7;
    float s0 = 0.f, s1 = 0.f, s2 = 0.f, s3 = 0.f, s4 = 0.f, s5 = 0.f, s6 = 0.f, s7 = 0.f;
#pragma unroll 8
    for (int it = 0; it < 32; ++it) {
        const int key = it * 8 + kl;
        const u32x4 v = *(const u32x4*)(img + ((size_t)((key >> 6) * 8 + cc) * 64 + (key & 63)) * 8);
        s0 += bflo(v.x); s1 += bfhi(v.x); s2 += bflo(v.y); s3 += bfhi(v.y); s4 += bflo(v.z); s5 += bfhi(v.z); s6 += bflo(v.w); s7 += bfhi(v.w);
    }
#pragma unroll
    for (int o = 8; o < 64; o <<= 1) { s0 += __shfl_xor(s0, o); s1 += __shfl_xor(s1, o); s2 += __shfl_xor(s2, o); s3 += __shfl_xor(s3, o); s4 += __shfl_xor(s4, o); s5 += __shfl_xor(s5, o); s6 += __shfl_xor(s6, o); s7 += __shfl_xor(s7, o); }
    if (lane < 8) { const float k = 1.f / 256.f; u32x4 w; w.x = cvtpk(s0 * k, s1 * k); w.y = cvtpk(s2 * k, s3 * k); w.z = cvtpk(s4 * k, s5 * k); w.w = cvtpk(s6 * k, s7 * k); *(u32x4*)(kmean + (size_t)item * 64 + cc * 8) = w; }
}
__device__ __forceinline__ int src_main(int n) {
    int base, j, kind;
    if (n < 384) { base = 0; j = n; kind = 1; } else if (n < 768) { base = 384; j = n - 384; kind = 1; } else if (n < 1152) { base = 1152; j = n - 768; kind = 0; }
    else if (n < 1408) { base = 1536; j = n - 1152; kind = 2; } else if (n < 1664) { base = 1792; j = n - 1408; kind = 2; } else if (n < 1920) { base = 2304; j = n - 1664; kind = 0; }
    else if (n < 2304) { base = 2560; j = n - 1920; kind = 0; } else if (n < 2688) { base = 2944; j = n - 2304; kind = 0; } else { base = 3712; j = n - 2688; kind = 0; }
    if (kind == 1) { const int d = j & 63; if (d < 16) j = (j & ~63) + ((d & 1) ? 8 + (d >> 1) : (d >> 1)); }
    else if (kind == 2) { const int d = j & 31; if (d < 8) j = (j & ~31) + ((d & 1) ? 4 + (d >> 1) : (d >> 1)); }
    return base + j;
}
__device__ __forceinline__ int src_v(int n) { return n < 384 ? 768 + n : (n < 640 ? 2048 + (n - 384) : 3328 + (n - 640)); }
__device__ __forceinline__ void transpose_item(const float* W, int K, int Nsrc, bf16_t* WT, int Ndst, int mode, int coloff, LAS float* scr, int item, int lane, const float* gain) {
    const int nblk = Ndst / 32, kb = item / nblk, nb = item % nblk, k0 = 64 * kb, n0 = 32 * nb;
    const int nn = n0 + (lane & 31); const int sc = (mode == 1) ? src_main(nn) : ((mode == 2) ? src_v(nn) : coloff + nn);
#pragma unroll 16
    for (int i = 0; i < 32; ++i) { const int kk = 2 * i + (lane >> 5); const float gk = gain ? gain[k0 + kk] : 1.f; scr[kk * 33 + (lane & 31)] = W[(size_t)(k0 + kk) * Nsrc + sc] * gk; }
    asm volatile("s_waitcnt lgkmcnt(0)" ::: "memory");
    const int cc = lane & 7;
#pragma unroll
    for (int j = 0; j < 4; ++j) { const int n = (lane >> 3) + 8 * j; const LAS float* s = scr + (8 * cc) * 33 + n;
        u32x4 o; o.x = cvtpk(s[0 * 33], s[1 * 33]); o.y = cvtpk(s[2 * 33], s[3 * 33]); o.z = cvtpk(s[4 * 33], s[5 * 33]); o.w = cvtpk(s[6 * 33], s[7 * 33]);
        *(u32x4*)(WT + (size_t)(n0 + n) * K + k0 + 8 * cc) = o; }
    asm volatile("s_waitcnt lgkmcnt(0)" ::: "memory");
}
__device__ __forceinline__ void rope_cs(float pos, float chi, float clo, float& cs, float& sn) {
    const float h = pos * chi; float lo = fmaf(pos, chi, -h); lo = fmaf(pos, clo, lo);
    const float fr = (h - floorf(h)) + lo;
    cs = __builtin_amdgcn_cosf(fr); sn = __builtin_amdgcn_sinf(fr);
}

struct Args { const float* in[17]; float* out; unsigned char* ws; int ph_lo, ph_hi; };

__device__ __forceinline__ void prologue(const Args& a, LAS unsigned char* lds, int tid, int lane, int wid) {
    unsigned char* ws = a.ws;
    const int G = gridDim.x, gw = blockIdx.x * 8 + wid, NGW = G * 8;
    LAS float* scr = (LAS float*)(lds + wid * 16384);
    bf16_t* Wb = (bf16_t*)(ws + WS_W);
    constexpr int I_MAIN = 16 * 96, I_V = 16 * 32, I_OUT = 16 * 32, I_XQ = 16 * 16, I_XK = 16 * 16, I_XV = 16 * 16, I_XO = 8 * 32, I_L = I_MAIN + I_V + I_OUT + I_XQ + I_XK + I_XV + I_XO;
    for (int it = gw; it < 2 * I_L; it += NGW) {
        const int l = it / I_L; int r = it % I_L; bf16_t* W = Wb + (size_t)l * W_LAYER;
        const float* w_in = a.in[4] + (size_t)l * 1024 * 4096; const float* w_out = a.in[5] + (size_t)l * 1024 * 1024;
        const float* w_xq = a.in[13] + (size_t)l * 1024 * 512; const float* w_xkv = a.in[14] + (size_t)l * 1024 * 1024; const float* w_xo = a.in[15] + (size_t)l * 512 * 1024;
        if (r < I_MAIN) { transpose_item(w_in, 1024, 4096, W + W_MAIN, 3072, 1, 0, scr, r, lane, a.in[3] + l * DM); continue; } r -= I_MAIN;
        if (r < I_V) { transpose_item(w_in, 1024, 4096, W + W_V, 1024, 2, 0, scr, r, lane, a.in[3] + l * DM); continue; } r -= I_V;
        if (r < I_OUT) { transpose_item(w_out, 1024, 1024, W + W_OUT, 1024, 0, 0, scr, r, lane, nullptr); continue; } r -= I_OUT;
        if (r < I_XQ) { transpose_item(w_xq, 1024, 512, W + W_XQ, 512, 0, 0, scr, r, lane, a.in[11] + l * DM); continue; } r -= I_XQ;
        if (r < I_XK) { transpose_item(w_xkv, 1024, 1024, W + W_XK, 512, 0, 0, scr, r, lane, nullptr); continue; } r -= I_XK;
        if (r < I_XV) { transpose_item(w_xkv, 1024, 1024, W + W_XV, 512, 0, 512, scr, r, lane, nullptr); continue; } r -= I_XV;
        transpose_item(w_xo, 512, 1024, W + W_XO, 1024, 0, 0, scr, r, lane, nullptr);
    }
    {
        const float* x = a.in[0]; bf16_t* hb = (bf16_t*)(ws + WS_HB); float* ssq = (float*)(ws + WS_SSQ);
        for (int row = gw; row < TT; row += 2 * NGW) {
            const int row2 = row + NGW;
            const f32x4* xr = (const f32x4*)(x + (size_t)row * DM) + lane; const f32x4* xr2 = (const f32x4*)(x + (size_t)row2 * DM) + lane;
            f32x4 v[4], v2[4];
#pragma unroll
            for (int j = 0; j < 4; ++j) { v[j] = xr[64 * j]; v2[j] = xr2[64 * j]; }
            float s = 0.f, s2 = 0.f; u32x2* o8 = (u32x2*)(hb + (size_t)row * DM) + lane; u32x2* o82 = (u32x2*)(hb + (size_t)row2 * DM) + lane;
#pragma unroll
            for (int j = 0; j < 4; ++j) {
                u32x2 w; w.x = cvtpk(v[j].x, v[j].y); w.y = cvtpk(v[j].z, v[j].w); o8[64 * j] = w;
                { const float r0 = bflo(w.x), r1 = bfhi(w.x), r2 = bflo(w.y), r3 = bfhi(w.y); s += (r0 * r0 + r1 * r1) + (r2 * r2 + r3 * r3); }
                u32x2 w2; w2.x = cvtpk(v2[j].x, v2[j].y); w2.y = cvtpk(v2[j].z, v2[j].w); o82[64 * j] = w2;
                { const float r0 = bflo(w2.x), r1 = bfhi(w2.x), r2 = bflo(w2.y), r3 = bfhi(w2.y); s2 += (r0 * r0 + r1 * r1) + (r2 * r2 + r3 * r3); }
            }
            s = wave_sum(s); s2 = wave_sum(s2);
            if (lane < 4) { ssq[(size_t)row * 4 + lane] = (lane == 0) ? s : 0.f; ssq[(size_t)row2 * 4 + lane] = (lane == 0) ? s2 : 0.f; }
        }
    }
    for (int it = gw; it < 2 * 1024; it += NGW) {
        const int l = it >> 10, row = it & 1023; const float* g = a.in[12] + l * DM; bf16_t* mo = (bf16_t*)(ws + WS_MEMN) + (size_t)l * 1024 * 1024 + (size_t)row * DM;
        const f32x4* xr = (const f32x4*)(a.in[1] + (size_t)row * DM) + lane; f32x4 v[4]; float s = 0.f;
#pragma unroll
        for (int j = 0; j < 4; ++j) { v[j] = xr[64 * j]; s += (v[j].x * v[j].x + v[j].y * v[j].y) + (v[j].z * v[j].z + v[j].w * v[j].w); }
        const float ri = __builtin_amdgcn_rsqf(wave_sum(s) * (1.f / 1024.f) + RMS_EPS);
#pragma unroll
        for (int j = 0; j < 4; ++j) { const f32x4 gg = *((const f32x4*)g + lane + 64 * j); u32x2 w; w.x = cvtpk(v[j].x * ri * gg.x, v[j].y * ri * gg.y); w.y = cvtpk(v[j].z * ri * gg.z, v[j].w * ri * gg.w); *((u32x2*)mo + lane + 64 * j) = w; }
    }
    {
        const int gt = blockIdx.x * 512 + tid;
        constexpr float ROPE64_HI[8] = {1.591549367e-01f, 3.086376376e-02f, 5.985185504e-03f, 1.160663669e-03f, 2.250790858e-04f, 4.364795313e-05f, 8.464330676e-06f, 1.641426252e-06f};
        constexpr float ROPE64_LO[8] = {6.420638327e-09f, -3.597993882e-10f, 2.087540496e-10f, -2.775752479e-11f, -6.755000964e-12f, -3.416928741e-13f, 1.318804142e-13f, 1.098673667e-14f};
        for (int tk = gt; tk < TT; tk += G * 512) {
            const float pos = (float)((const int*)a.in[2])[tk]; float* c64 = (float*)(ws + WS_CS64) + (size_t)tk * 16; float* c32 = (float*)(ws + WS_CS32) + (size_t)tk * 8;
#pragma unroll
            for (int i = 0; i < 8; ++i) { float cs, sn; rope_cs(pos, ROPE64_HI[i], ROPE64_LO[i], cs, sn); c64[2 * i] = cs; c64[2 * i + 1] = sn; }
#pragma unroll
            for (int i = 0; i < 4; ++i) { float cs, sn; rope_cs(pos, ROPE64_HI[2 * i], ROPE64_LO[2 * i], cs, sn); c32[2 * i] = cs; c32[2 * i + 1] = sn; }
        }
    }
    if (blockIdx.x == 0 && wid == 0) {
        int* ctl = (int*)(ws + WS_CTL);
        if (lane < 16) ctl[lane] = 0;
#pragma unroll
        for (int l = 0; l < 2; ++l) {
            float p1 = 0.f, p2 = 0.f;
            if (lane < 32) { p1 = a.in[6][l * 32 + lane] * a.in[7][l * 32 + lane]; p2 = a.in[8][l * 32 + lane] * a.in[9][l * 32 + lane]; }
            p1 = wave_sum(p1); p2 = wave_sum(p2);
            const float li = 0.8f - 0.6f * expf(-0.3f * (float)l);
            if (lane == 0) { ((float*)ctl)[16 + 2 * l] = expf(p1) - expf(p2) + li; ((float*)ctl)[17 + 2 * l] = 1.f - li; }
        }
    }
}

__device__ __forceinline__ void final_norm(const Args& a, int lane, int wid) {
    const int gw = blockIdx.x * 8 + wid, NGW = gridDim.x * 8; const float* ssq = (const float*)(a.ws + WS_SSQ); const float* g = a.in[16]; const bf16_t* hb = (const bf16_t*)(a.ws + WS_HB);
    f32x4 gv[2][2];
#pragma unroll
    for (int j = 0; j < 2; ++j) { gv[j][0] = *(const f32x4*)(g + 512 * j + lane * 8); gv[j][1] = *(const f32x4*)(g + 512 * j + lane * 8 + 4); }
    for (int row0 = gw; row0 < TT; row0 += 2 * NGW) {
        u32x4 v[2][2]; float ri[2];
#pragma unroll
        for (int q = 0; q < 2; ++q) { const int row = row0 + q * NGW; ri[q] = rinv_row(ssq, row);
#pragma unroll
            for (int j = 0; j < 2; ++j) v[q][j] = *(const u32x4*)(hb + (size_t)row * DM + 512 * j + lane * 8); }
#pragma unroll
        for (int q = 0; q < 2; ++q)
#pragma unroll
            for (int j = 0; j < 2; ++j) {
                const u32x4 w = v[q][j];
                f32x4 o0, o1; o0.x = bflo(w.x); o0.y = bfhi(w.x); o0.z = bflo(w.y); o0.w = bfhi(w.y); o1.x = bflo(w.z); o1.y = bfhi(w.z); o1.z = bflo(w.w); o1.w = bfhi(w.w);
                float* op = a.out + (size_t)(row0 + q * NGW) * DM + 512 * j + lane * 8;
                *(f32x4*)op = o0 * ri[q] * gv[j][0]; *(f32x4*)(op + 4) = o1 * ri[q] * gv[j][1];
            }
    }
}

__device__ __forceinline__ int pi32(int r) { return (r & ~12) | ((r & 4) << 1) | ((r & 8) >> 1); }
constexpr int N_PHASES = 12;
#ifndef PROBE_MIX
#define PROBE_MIX 0
#endif
#ifndef PH_MASK
#define PH_MASK 0x1FF
#endif
__device__ __forceinline__ bf16_t* wlayer(const Args& a, int l) { return (bf16_t*)(a.ws + WS_W) + (size_t)l * W_LAYER; }
__device__ __forceinline__ void make_ctx(ACtx& c, LAS unsigned char* lds) {
    const int tid = tid_opaque(), lane = tid & 63;
    c.tid = tid; c.lane = lane; c.wid = __builtin_amdgcn_readfirstlane(tid >> 6); c.r32 = lane & 31; c.hi = lane >> 5; c.r32p = pi32(lane & 31); c.lds = lds;
}
__device__ __forceinline__ void phase_in(const Args& a, LAS unsigned char* lds, int l) {
    const int G = grid_opaque(), bid = bid_opaque(); unsigned char* ws = a.ws;
    { pg8::Gemm g{(const bf16_t*)(ws + WS_HB), wlayer(a, l) + W_MAIN, TT, 3072, 1024}; pg8::StaticOrder S; S.init(TT, 3072, G, bid);
      EpiIn E{(bf16_t*)(ws + WS_P), (const float*)(ws + WS_SSQ), (const float*)(ws + WS_CS64), (const float*)(ws + WS_CS32), (bf16_t*)(ws + WS_KIMG), (float*)(ws + WS_KMEAN), (bf16_t*)a.out, (bf16_t*)a.out + (size_t)16 * 1024 * 1024};
      pg8::gemm_phase<EpiIn, pg8::StaticOrder, true, true>(lds, g, S, E); }
    { pg8::Gemm g{wlayer(a, l) + W_V, (const bf16_t*)(ws + WS_HB), 1024, TT, 1024}; pg8::StaticOrder S; S.init(1024, TT, G, bid);
      EpiVt E{(bf16_t*)(ws + WS_VT), (const float*)(ws + WS_SSQ)};
      pg8::gemm_phase<EpiVt, pg8::StaticOrder, true, true>(lds, g, S, E); }
}
__device__ __forceinline__ void phase_kmean(const Args& a, LAS unsigned char* lds, int l) {
    const int G = grid_opaque(), bid = bid_opaque(), tid_ = tid_opaque(), lane = tid_ & 63, wid = __builtin_amdgcn_readfirstlane(tid_ >> 6); unsigned char* ws = a.ws;
    for (int it = bid * 8 + wid; it < 768; it += G * 8) kmean_item(it, (const bf16_t*)(ws + WS_KIMG), (bf16_t*)(ws + WS_KMEAN), lane);
    bf16_t* memn = (bf16_t*)(ws + WS_MEMN) + (size_t)l * 1024 * 1024; bf16_t* kx = (bf16_t*)(ws + WS_KX) + (size_t)l * 1024 * 512; bf16_t* vxt = (bf16_t*)(ws + WS_VXT) + (size_t)l * 512 * 1024;
#pragma unroll 1
    for (int j = 0; j < 2; ++j) {
        pg8::Gemm g; g.A = j ? (wlayer(a, l) + W_XV) : memn; g.Bt = j ? memn : (wlayer(a, l) + W_XK); g.M = j ? 512 : 1024; g.N = j ? 1024 : 512; g.K = 1024;
        pg8::StaticOrder S; S.init(g.M, g.N, G, (bid + G - 8 - 16 * j) % G); EpiB16 E{j ? vxt : kx, j ? 1024 : 512, nullptr, 1.f};
        pg8::gemm_phase<EpiB16, pg8::StaticOrder, true, true>(lds, g, S, E);
    }
}
struct OneUnit {
    Unit u;
    __device__ __forceinline__ bool next(int i, Unit& o) const { if (i) return false; o = u; return true; }
    __device__ __forceinline__ void a_ready(const Unit&) const {}
    __device__ __forceinline__ void done(const Unit&) const {}
};
#ifndef MIX_TYPES
#define MIX_TYPES 7
#endif
__device__ __forceinline__ void phase_mix(const Args& a, LAS unsigned char* lds, int l, int rep, int types) {
    volatile LAS int* wq = (volatile LAS int*)(lds + LDS_MISC);
    const int x0 = (int)((unsigned)__builtin_amdgcn_s_getreg((3 << 11) | 20) & 7u);
    int nq = 0;
    for (;;) {
        unsigned char* ws = a.ws; asm volatile("" : "+s"(ws));
        int* ctl = (int*)(ws + WS_CTL);
        const bf16_t* P = (const bf16_t*)(ws + WS_P); const bf16_t* Vt = (const bf16_t*)(ws + WS_VT); bf16_t* mrg = (bf16_t*)(ws + WS_MRG);
        ACtx c; make_ctx(c, lds);
        const int q = (x0 + nq) & 7;
        if (c.tid == 0) *wq = __hip_atomic_fetch_add(ctl + 32 + (l * 2 + rep) * 8 + q, 1, __ATOMIC_RELAXED, __HIP_MEMORY_SCOPE_AGENT);
        __syncthreads();
        const int i = __builtin_amdgcn_readfirstlane(*wq);
        __syncthreads();
        if (i >= 258) { if (++nq >= 8) break; continue; }
        if (i >= 256) {
            const int it = (i - 256) + 2 * q, j = it >> 3, uu = it & 7;
            bf16_t* memn = (bf16_t*)(ws + WS_MEMN) + (size_t)l * 1024 * 1024;
            pg8::Gemm g; g.A = j ? (wlayer(a, l) + W_XV) : memn; g.Bt = j ? memn : (wlayer(a, l) + W_XK); g.M = j ? 512 : 1024; g.N = j ? 1024 : 512; g.K = 1024;
            OneUnit S; S.u.pm = j ? (uu & 1) : (uu & 3); S.u.pn = j ? (uu >> 1) : (uu >> 2);
            EpiB16 E{j ? ((bf16_t*)(ws + WS_VXT) + (size_t)l * 512 * 1024) : ((bf16_t*)(ws + WS_KX) + (size_t)l * 1024 * 512), j ? 1024 : 512, nullptr, 1.f};
            pg8::gemm_phase<EpiB16, OneUnit, true, true>(lds, g, S, E);
            __syncthreads();
            continue;
        }
        int type, bh, qb;
        if (i < 56) { type = 0; qb = 31 - (i >> 1); bh = q + 8 * (i & 1); }
        else if (i < 152) { const int j = i - 56; type = 1; qb = 31 - j / 3; bh = q + 8 * (j % 3); }
        else if (i < 160) { const int j = i - 152; type = 0; qb = 3 - (j >> 1); bh = q + 8 * (j & 1); }
        else { const int j = i - 160; type = 2; qb = 31 - j / 3; bh = q + 8 * (j % 3); }
        if (type == 0) { if (types & 1) diff_unit(c, bh >> 2, bh & 3, qb, P, (const bf16_t*)a.out + (size_t)16 * 1024 * 1024, Vt + (size_t)384 * TT, mrg, ((const float*)ctl)[16 + 2 * l], ((const float*)ctl)[17 + 2 * l], a.in[10] + l * 64); }
        else if (type == 1) { if (types & 2) moba_unit(c, bh / 6, bh % 6, qb, P, (const bf16_t*)(ws + WS_KIMG), Vt, (const float*)(ws + WS_KMEAN), mrg); }
        else if (types & 4) sb_unit(c, bh / 6, bh % 6, qb, P, (const bf16_t*)a.out, Vt + (size_t)640 * TT, mrg);
    }
}
__device__ __forceinline__ void phase_res(const Args& a, LAS unsigned char* lds, int l, bool o) {
    unsigned char* ws = a.ws;
    pg8::Gemm g; g.A = (const bf16_t*)(ws + (o ? WS_MRG : WS_OX)); g.Bt = wlayer(a, l) + (o ? W_OUT : W_XO); g.M = TT; g.N = 1024; g.K = o ? 1024 : 512;
    pg8::StaticOrder S; S.init(TT, 1024, grid_opaque(), bid_opaque());
    EpiRes E; E.h = (bf16_t*)(ws + WS_HB); E.ssq = (float*)(ws + WS_SSQ);
    E.red = (LAS float*)(lds + LDS_RED); E.tid = tid_opaque();
    pg8::gemm_phase<EpiRes, pg8::StaticOrder, true, true>(lds, g, S, E);
}
__device__ __forceinline__ void phase_xq(const Args& a, LAS unsigned char* lds, int l) {
    unsigned char* ws = a.ws;
    pg8::Gemm g{(const bf16_t*)(ws + WS_HB), wlayer(a, l) + W_XQ, TT, 512, 1024}; pg8::StaticOrder S; S.init(TT, 512, grid_opaque(), bid_opaque());
    EpiB16 E{(bf16_t*)(ws + WS_QX), 512, (const float*)(ws + WS_SSQ), 0.08838834764831845f * LOG2E};
    pg8::gemm_phase<EpiB16, pg8::StaticOrder, true, true>(lds, g, S, E);
    asm volatile("s_waitcnt vmcnt(0)" ::: "memory");
    __syncthreads();
    Unit u;
    if (S.next(0, u)) {
        ACtx c; make_ctx(c, lds);
        const bf16_t* kx = (const bf16_t*)(ws + WS_KX) + (size_t)l * 1024 * 512; const bf16_t* vxt = (const bf16_t*)(ws + WS_VXT) + (size_t)l * 512 * 1024;
#pragma unroll 1
        for (int hh = 0; hh < 2; ++hh) xattn_unit(c, u.pm >> 5, 2 * u.pn + hh, u.pm & 31, (const bf16_t*)(ws + WS_QX), kx, vxt, (bf16_t*)(ws + WS_OX));
    }
}
__device__ __forceinline__ void phase_xattn(const Args& a, LAS unsigned char* lds, int l) {
    unsigned char* ws = a.ws; ACtx c; make_ctx(c, lds);
    const bf16_t* kx = (const bf16_t*)(ws + WS_KX) + (size_t)l * 1024 * 512; const bf16_t* vxt = (const bf16_t*)(ws + WS_VXT) + (size_t)l * 512 * 1024;
    for (int i = bid_opaque(); i < 512; i += grid_opaque()) { const int qb = i & 31, bh = i >> 5; xattn_unit(c, bh >> 2, bh & 3, qb, (const bf16_t*)(ws + WS_QX), kx, vxt, (bf16_t*)(ws + WS_OX)); }
}
#define XB_TMO      128
#define XB_XCNT(j)  (256  + 64 * (j))
#define XB_XSUB(j)  (1280 + 64 * (j))
#define XB_XGEN(j)  (2304 + 64 * (j))
#define XB_TOP      3328
#define XB_TOPGEN   3392
#define XCD_BAR_WORDS 3456
#define XB_SPIN_CAP (1u << 18)

__device__ __forceinline__ unsigned xb_ld(unsigned* p)              { return __hip_atomic_load(p, __ATOMIC_RELAXED, __HIP_MEMORY_SCOPE_AGENT); }
__device__ __forceinline__ unsigned xb_add(unsigned* p, unsigned v) { return __hip_atomic_fetch_add(p, v, __ATOMIC_RELAXED, __HIP_MEMORY_SCOPE_AGENT); }
__device__ __forceinline__ unsigned xb_xcc_id() { return (unsigned)__builtin_amdgcn_s_getreg((3 << 11) | 20) & 0xFu; }
#define XB_SPIN(cond, bar) do { unsigned _sp = 0; while (cond) { __builtin_amdgcn_s_sleep(1); \
    if ((++_sp & 255u) == 0u) { if (xb_ld(&(bar)[XB_TMO])) break; if (_sp > XB_SPIN_CAP) { atomicAdd(&(bar)[XB_TMO], 1u); break; } } } } while (0)

struct XcdBarrier {
    unsigned* bar; unsigned x;
    volatile LAS unsigned* st;
};

__device__ __forceinline__ XcdBarrier xcd_barrier_post(unsigned* bar, volatile LAS unsigned* st) {
    XcdBarrier b; b.bar = bar; b.x = xb_xcc_id(); b.st = st;
    if (threadIdx.x == 0) (void)xb_add(&bar[XB_XCNT(b.x)], 1u);
    return b;
}
__device__ __forceinline__ void xcd_barrier_complete(unsigned* bar, unsigned x, unsigned& nloc, unsigned& nx) {
    const unsigned G = gridDim.x * gridDim.y * gridDim.z;
    unsigned sum, cnt, mine, sp = 0u;
    for (;;) {
        sum = 0u; cnt = 0u; mine = 0u;
#pragma unroll
        for (unsigned j = 0; j < 16; ++j) { const unsigned c = xb_ld(&bar[XB_XCNT(j)]); sum += c; cnt += (c > 0u) ? 1u : 0u; mine = (j == x) ? c : mine; }
        if (sum == G) break;
        __builtin_amdgcn_s_sleep(1);
        if ((++sp & 255u) == 0u) { if (xb_ld(&bar[XB_TMO])) break; if (sp > XB_SPIN_CAP) { atomicAdd(&bar[XB_TMO], 1u); break; } }
    }
    nloc = mine > 0u ? mine : 1u; nx = cnt > 0u ? cnt : 1u;
}

__device__ __forceinline__ void xcd_barrier(const XcdBarrier& b) {
    asm volatile("s_waitcnt vmcnt(0)" ::: "memory");
    __syncthreads();
    if (threadIdx.x == 0) {
        unsigned* bar = b.bar;
        __builtin_amdgcn_s_waitcnt(0);
        unsigned nloc = b.st[0], nx = b.st[1];
        if (nloc == 0u) { xcd_barrier_complete(bar, b.x, nloc, nx); b.st[0] = nloc; b.st[1] = nx; }
        const unsigned old = xb_add(&bar[XB_XSUB(b.x)], 1u);
        const unsigned gen = old / nloc;
        if (old + 1u == (gen + 1u) * nloc) {
            __builtin_amdgcn_fence(__ATOMIC_RELEASE, "agent");
            asm volatile("s_waitcnt vmcnt(0)" ::: "memory");
            const unsigned og = xb_add(&bar[XB_TOP], 1u);
            const unsigned tg = og / nx;
            if (og + 1u == (tg + 1u) * nx) xb_add(&bar[XB_TOPGEN], 1u);
            else XB_SPIN(xb_ld(&bar[XB_TOPGEN]) == tg, bar);
            __builtin_amdgcn_fence(__ATOMIC_ACQUIRE, "agent");
            xb_add(&bar[XB_XGEN(b.x)], 1u);
            asm volatile("s_waitcnt vmcnt(0)" ::: "memory");
        } else {
            XB_SPIN(xb_ld(&bar[XB_XGEN(b.x)]) == gen, bar);
            __builtin_amdgcn_fence(__ATOMIC_ACQUIRE, "agent");
            asm volatile("s_waitcnt vmcnt(0)" ::: "memory");
        }
    }
    __syncthreads();
}


__device__ __forceinline__ void grid_bar(unsigned* bar, unsigned k) {
    asm volatile("s_waitcnt vmcnt(0)" ::: "memory");
    __syncthreads();
    if (threadIdx.x == 0) {
        __builtin_amdgcn_fence(__ATOMIC_RELEASE, "agent");
        asm volatile("s_waitcnt vmcnt(0)" ::: "memory");
        const unsigned G = gridDim.x, g = blockIdx.x & 7u, ng = (G - g + 7u) >> 3;
        unsigned* sub = bar + 64 * (1 + g); unsigned* gen = bar + 64 * (9 + g); unsigned* top = bar + 64 * 17;
        const unsigned old = __hip_atomic_fetch_add(sub, 1u, __ATOMIC_RELAXED, __HIP_MEMORY_SCOPE_AGENT);
        if (old + 1u == k * ng) {
            const unsigned oldt = __hip_atomic_fetch_add(top, 1u, __ATOMIC_RELAXED, __HIP_MEMORY_SCOPE_AGENT);
            if (oldt + 1u == k * 8u) {
#pragma unroll
                for (int gg = 0; gg < 8; ++gg) __hip_atomic_store(bar + 64 * (9 + gg), k, __ATOMIC_RELAXED, __HIP_MEMORY_SCOPE_AGENT);
            }
        }
        while (__hip_atomic_load(gen, __ATOMIC_RELAXED, __HIP_MEMORY_SCOPE_AGENT) < k) __builtin_amdgcn_s_sleep(2);
        __builtin_amdgcn_fence(__ATOMIC_ACQUIRE, "agent");
        asm volatile("s_waitcnt vmcnt(0)" ::: "memory");
    }
    __syncthreads();
}
__global__ void __launch_bounds__(512, 2) fwd_kernel(Args a) {
    extern __shared__ __attribute__((aligned(16))) unsigned char lds_raw[];
    LAS unsigned char* lds = (LAS unsigned char*)lds_raw;
    volatile LAS unsigned* xst = (volatile LAS unsigned*)(lds + LDS_MISC + 256);
    if (threadIdx.x == 0) { xst[0] = 0u; xst[1] = 0u; }
    __syncthreads();
    XcdBarrier xbar = xcd_barrier_post((unsigned*)(a.ws + WS_CTL) + 1024, xst);
#pragma unroll 1
    for (int ph = a.ph_lo; ph < a.ph_hi; ++ph) {
        if (ph == 0) { const int t_ = tid_opaque(); prologue(a, lds, t_, t_ & 63, __builtin_amdgcn_readfirstlane(t_ >> 6)); }
        else if (ph == N_PHASES - 1) { const int t_ = tid_opaque(); final_norm(a, t_ & 63, __builtin_amdgcn_readfirstlane(t_ >> 6)); }
        else {
            const int l = (ph - 1) / 5, r = (ph - 1) % 5;
            if (r == 0) { if (PH_MASK & 1) phase_in(a, lds, l); }
            else if (r == 1) { phase_mix(a, lds, l, 0, MIX_TYPES);
#if PROBE_MIX
                __syncthreads(); phase_mix(a, lds, l, 1, PROBE_MIX);
#endif
            }
            else if (r == 2 || r == 4) { if (PH_MASK & 8) phase_res(a, lds, l, r == 2); }
            else { if (PH_MASK & 16) phase_xq(a, lds, l); }
        }
        if (ph + 1 < a.ph_hi) {
            if (a.ph_hi > 4096) cg::this_grid().sync();
            xcd_barrier(xbar);
        }
    }
}

#ifndef MK_PER_PHASE
#define MK_PER_PHASE 0
#endif
extern "C" void kernel_launch(void* const* d_in, const int* in_sizes, int n_in, void* d_out, int out_size, void* d_ws, size_t ws_size, hipStream_t stream) {
    static int grid = 0;
    if (grid == 0) {
        if (n_in != 17 || out_size != TT * DM || ws_size < WS_END) { fprintf(stderr, "kernel_launch: unexpected shapes (n_in %d out %d ws %zu)\n", n_in, out_size, ws_size); grid = -1; return; }
        int dev = 0, cus = 0, per_cu = 0;
        if (hipGetDevice(&dev) != hipSuccess || hipDeviceGetAttribute(&cus, hipDeviceAttributeMultiprocessorCount, dev) != hipSuccess) { grid = -1; return; }
        if (hipFuncSetAttribute((const void*)fwd_kernel, hipFuncAttributeMaxDynamicSharedMemorySize, LDS_BYTES) != hipSuccess) { fprintf(stderr, "kernel_launch: hipFuncSetAttribute failed\n"); grid = -1; return; }
        if (hipOccupancyMaxActiveBlocksPerMultiprocessor(&per_cu, (const void*)fwd_kernel, 512, LDS_BYTES) != hipSuccess || per_cu < 1) { fprintf(stderr, "kernel_launch: occupancy query says %d\n", per_cu); (void)hipGetLastError(); }
        grid = cus;
    }
    if (grid < 0) return;
    Args a{};
    for (int i = 0; i < 17; ++i) a.in[i] = (const float*)d_in[i];
    a.out = (float*)d_out; a.ws = (unsigned char*)d_ws;
#if MK_PER_PHASE
    for (int ph = 0; ph < N_PHASES; ++ph) { a.ph_lo = ph; a.ph_hi = ph + 1; hipLaunchKernelGGL(fwd_kernel, dim3(grid), dim3(512), LDS_BYTES, stream, a); }
#else
    a.ph_lo = 0; a.ph_hi = N_PHASES;
    (void)hipMemsetAsync(d_ws, 0, 32768, stream);
    void* args[] = {&a};
    hipError_t e = hipLaunchCooperativeKernel((const void*)fwd_kernel, dim3(grid), dim3(512), args, LDS_BYTES, stream);
    if (e != hipSuccess) fprintf(stderr, "kernel_launch: cooperative launch failed: %s (grid %d)\n", hipGetErrorString(e), grid);
#endif
}
```
